# Optimizing an MI355X kernel written in HIP

```python
import jax, jax.numpy as jnp
from jax import lax
import numpy as np

D_MODEL = 1024
BATCH = 2
SEQ = 8192
DEPTH = 1

CHUNK = 64
QBLK = 128
EPS = 1e-6

REC_HEADS = 4
REC_DK = 128
REC_DV = 128
REC_W = REC_HEADS * REC_DV
ATT_HEADS = 8
ATT_DH = 64
ATT_W = ATT_HEADS * ATT_DH
IDX_HEADS = 8
IDX_DIM = 64
TOPK_MAX = 256
NUM_BUCKETS = 32
MAX_DISTANCE = 128
N_GROUPS = 4
EXPERTS_PER_GROUP = 4
N_EXPERTS = N_GROUPS * EXPERTS_PER_GROUP
TOP_K_EXPERTS = 2
D_EXPERT = 512

MIX_W = REC_W + ATT_W
IN_SIZES = (REC_HEADS * REC_DK,
            REC_HEADS * REC_DK,
            REC_W,
            REC_W,
            ATT_W, ATT_W, ATT_W,
            IDX_HEADS * IDX_DIM,
            IDX_DIM,
            IDX_HEADS)
D_IN = int(sum(IN_SIZES))
IN_OFFSETS = tuple(int(o) for o in np.cumsum(IN_SIZES)[:-1])

kernel_name = 'hymba_hgrn2_dsa_hmoe_block'


def _rms(x, g):
    xf = x.astype(jnp.float32)
    y = xf * lax.rsqrt(jnp.mean(xf * xf, axis=-1, keepdims=True) + EPS)
    return (y * g.astype(jnp.float32)).astype(x.dtype)


def _layernorm(x, g, b):
    xf = x.astype(jnp.float32)
    mu = jnp.mean(xf, axis=-1, keepdims=True)
    var = jnp.mean(jnp.square(xf - mu), axis=-1, keepdims=True)
    y = (xf - mu) * lax.rsqrt(var + EPS)
    return (y * g.astype(jnp.float32) + b.astype(jnp.float32)).astype(x.dtype)


def _t5_bucket(rel):
    nb = NUM_BUCKETS // 2
    max_exact = nb // 2
    ret = jnp.where(rel > 0, nb, 0)
    n = jnp.abs(rel)
    nf = jnp.maximum(n, 1).astype(jnp.float32)
    large = max_exact + (jnp.log(nf / max_exact) / np.log(MAX_DISTANCE / max_exact)
                         * (nb - max_exact)).astype(jnp.int32)
    large = jnp.minimum(large, nb - 1)
    return ret + jnp.where(n < max_exact, n, large)


def _hgrn2(q_raw, f_raw, i_raw, g_raw, lb, out_g):
    B, S, _ = q_raw.shape
    nc = S // CHUNK
    f32 = jnp.float32
    q = jax.nn.silu(q_raw.astype(f32))
    f = lb + (1.0 - lb) * jax.nn.sigmoid(f_raw.astype(f32))
    k = 1.0 - f
    lf = jnp.log(f)
    v = i_raw.astype(f32)

    def to_chunks(a, d):
        return a.reshape(B, nc, CHUNK, REC_HEADS, d).transpose(1, 0, 3, 2, 4)

    tril = jnp.tril(jnp.ones((CHUNK, CHUNK), bool))[:, :, None]

    def step(state, inp):
        qc, kc, vc, lfc = inp
        b = jnp.cumsum(lfc, axis=2)
        diff = b[:, :, :, None, :] - b[:, :, None, :, :]
        decay = jnp.where(tril, jnp.exp(jnp.where(tril, diff, 0.0)), 0.0)
        attn = jnp.einsum('bhtk,bhsk,bhtsk->bhts', qc, kc, decay)
        o = (jnp.einsum('bhts,bhsv->bhtv', attn, vc)
             + jnp.einsum('bhtk,bhkv->bhtv', qc * jnp.exp(b), state))
        b_end = b[:, :, -1:, :]
        state = (jnp.exp(b_end[:, :, 0, :])[..., None] * state
                 + jnp.einsum('bhsk,bhsv->bhkv', kc * jnp.exp(b_end - b), vc))
        return state, o

    s0 = jnp.zeros((B, REC_HEADS, REC_DK, REC_DV), f32)
    _, o = lax.scan(step, s0, (to_chunks(q, REC_DK), to_chunks(k, REC_DK),
                               to_chunks(v, REC_DV), to_chunks(lf, REC_DK)))
    o = o.transpose(1, 0, 3, 2, 4).reshape(B, S, REC_HEADS, REC_DV)
    o = _rms(o, out_g.reshape(REC_HEADS, REC_DV))
    gate = jax.nn.silu(g_raw.astype(f32)).reshape(B, S, REC_HEADS, REC_DV)
    return (o * gate).reshape(B, S, REC_W).astype(q_raw.dtype)


def _dsa_attention(q, k, v, iq, ik, iw, rel_bias):
    B, S = q.shape[0], q.shape[1]
    nb = S // QBLK
    k_sel = min(TOPK_MAX, S // 4)
    key_chunk = jnp.arange(S) // CHUNK
    ikf = ik.astype(jnp.float32)

    def blocks(a):
        return a.reshape((B, nb, QBLK) + a.shape[2:]).swapaxes(0, 1)

    def one_block(args):
        bi, qb, iqb, iwb = args
        t = bi * QBLK + jnp.arange(QBLK)
        t_chunk = t // CHUNK
        sc = jnp.einsum('bqhd,bsd->bqhs', iqb.astype(jnp.float32), ikf) * IDX_DIM ** -0.5
        score = jnp.einsum('bqhs,bqh->bqs', jax.nn.relu(sc), iwb.astype(jnp.float32))
        adm = key_chunk[None, :] <= t_chunk[:, None]
        score = jnp.where(adm[None], score, -jnp.inf)
        _, idx = lax.top_k(score, k_sel)
        valid = (idx // CHUNK) <= t_chunk[None, :, None]
        kg = jax.vmap(lambda a, j: a[j])(k, idx)
        vg = jax.vmap(lambda a, j: a[j])(v, idx)
        logits = jnp.einsum('bqhd,bqkhd->bqhk', qb, kg).astype(jnp.float32) * ATT_DH ** -0.5
        bias = rel_bias[_t5_bucket(idx - t[None, :, None])]
        logits = logits + jnp.swapaxes(bias, 2, 3).astype(jnp.float32)
        logits = jnp.where(valid[:, :, None, :], logits, -jnp.inf)
        p = jax.nn.softmax(logits, axis=-1).astype(vg.dtype)
        return jnp.einsum('bqhk,bqkhd->bqhd', p, vg)

    out = lax.map(one_block, (jnp.arange(nb), blocks(q), blocks(iq), blocks(iw)))
    return out.swapaxes(0, 1).reshape(B, S, ATT_HEADS, ATT_DH)


def _hier_moe(h, w_rg, b_rg, w_re, b_re, w1, w3, w2):
    B, S, D = h.shape
    hf = h.reshape(B * S, D)
    g_logits = (hf @ w_rg + b_rg).astype(jnp.float32)
    p_group = jax.nn.softmax(g_logits, axis=-1)
    g_top = jnp.argmax(g_logits, axis=-1)
    gate_g = jnp.take_along_axis(p_group, g_top[:, None], axis=-1)
    e_logits = (hf @ w_re + b_re).astype(jnp.float32).reshape(-1, N_GROUPS, EXPERTS_PER_GROUP)
    e_in = jnp.take_along_axis(e_logits, g_top[:, None, None], axis=1)[:, 0]
    top_v, top_j = lax.top_k(e_in, TOP_K_EXPERTS)
    w_sel = jax.nn.softmax(top_v, axis=-1) * gate_g
    e_id = g_top[:, None] * EXPERTS_PER_GROUP + top_j
    combine = jnp.einsum('nk,nke->ne', w_sel,
                         jax.nn.one_hot(e_id, N_EXPERTS, dtype=jnp.float32)).astype(h.dtype)
    y = jnp.zeros_like(hf)
    for e in range(N_EXPERTS):
        he = jax.nn.silu(hf @ w1[e]) * (hf @ w3[e])
        y = y + combine[:, e:e + 1] * (he @ w2[e])
    return y.reshape(B, S, D)


def setup_inputs(seed: int = 0) -> dict:
    key = jax.random.key(seed)
    ks = jax.random.split(key, 24)
    f32 = jnp.float32

    def nrm(k, shape, s):
        return jax.random.normal(k, shape, f32) * s

    D = D_MODEL
    return {
        'x': nrm(ks[0], (BATCH, SEQ, D), 1.0),
        'c': nrm(ks[1], (BATCH, D), 1.0),
        'w_ada': nrm(ks[2], (DEPTH, D, 6 * D), 0.5 * D ** -0.5),
        'b_ada': nrm(ks[3], (DEPTH, 6 * D), 0.02),
        'norm1_g': 1.0 + nrm(ks[4], (DEPTH, D), 0.02),
        'norm2_g': 1.0 + nrm(ks[5], (DEPTH, D), 0.02),
        'w_in': nrm(ks[6], (DEPTH, D, D_IN), D ** -0.5),
        'lb_logits': nrm(ks[7], (DEPTH + 1, REC_HEADS * REC_DK), 0.5),
        'rec_out_g': 1.0 + nrm(ks[8], (DEPTH, REC_W), 0.02),
        'q_norm_g': 1.0 + nrm(ks[9], (DEPTH, ATT_DH), 0.02),
        'k_norm_g': 1.0 + nrm(ks[10], (DEPTH, ATT_DH), 0.02),
        'idx_k_norm_g': 1.0 + nrm(ks[11], (DEPTH, IDX_DIM), 0.02),
        'idx_k_norm_b': nrm(ks[12], (DEPTH, IDX_DIM), 0.02),
        'attn_out_g': 1.0 + nrm(ks[13], (DEPTH, ATT_W), 0.02),
        'rel_bias': nrm(ks[14], (NUM_BUCKETS, ATT_HEADS), 0.5),
        'w_out': nrm(ks[15], (DEPTH, MIX_W, D), MIX_W ** -0.5),
        'w_rg': nrm(ks[16], (DEPTH, D, N_GROUPS), D ** -0.5),
        'b_rg': nrm(ks[17], (DEPTH, N_GROUPS), 0.01),
        'w_re': nrm(ks[18], (DEPTH, D, N_EXPERTS), D ** -0.5),
        'b_re': nrm(ks[19], (DEPTH, N_EXPERTS), 0.01),
        'w1': nrm(ks[20], (DEPTH, N_EXPERTS, D, D_EXPERT), D ** -0.5),
        'w3': nrm(ks[21], (DEPTH, N_EXPERTS, D, D_EXPERT), D ** -0.5),
        'w2': nrm(ks[22], (DEPTH, N_EXPERTS, D_EXPERT, D), D_EXPERT ** -0.5),
    }


def reference(x, c, w_ada, b_ada, norm1_g, norm2_g, w_in, lb_logits, rec_out_g,
              q_norm_g, k_norm_g, idx_k_norm_g, idx_k_norm_b, attn_out_g, rel_bias,
              w_out, w_rg, b_rg, w_re, b_re, w1, w3, w2):
    B, S, D = x.shape
    lb_all = jnp.cumsum(jax.nn.softmax(lb_logits.astype(jnp.float32), axis=0), axis=0)
    for l in range(DEPTH):
        mod = jax.nn.silu(c) @ w_ada[l] + b_ada[l]
        sh1, sc1, g1, sh2, sc2, g2 = jnp.split(mod, 6, axis=-1)

        h = _rms(x, norm1_g[l]) * (1.0 + sc1[:, None, :]) + sh1[:, None, :]
        z = h @ w_in[l]
        rq, rf, ri, rg, aq, ak, av, iq, ik, iw = jnp.split(z, IN_OFFSETS, axis=-1)

        rec = _hgrn2(rq, rf, ri, rg, lb_all[l], rec_out_g[l])

        aq = _rms(aq.reshape(B, S, ATT_HEADS, ATT_DH), q_norm_g[l])
        ak = _rms(ak.reshape(B, S, ATT_HEADS, ATT_DH), k_norm_g[l])
        av = av.reshape(B, S, ATT_HEADS, ATT_DH)
        iq = iq.reshape(B, S, IDX_HEADS, IDX_DIM)
        ik = _layernorm(ik, idx_k_norm_g[l], idx_k_norm_b[l])
        iw = iw * IDX_HEADS ** -0.5
        att = _dsa_attention(aq, ak, av, iq, ik, iw, rel_bias)
        att = _rms(att, attn_out_g[l].reshape(ATT_HEADS, ATT_DH)).reshape(B, S, ATT_W)

        mix = jnp.concatenate([rec, att.astype(rec.dtype)], axis=-1) @ w_out[l]
        x = x + g1[:, None, :] * mix

        h2 = _rms(x, norm2_g[l]) * (1.0 + sc2[:, None, :]) + sh2[:, None, :]
        x = x + g2[:, None, :] * _hier_moe(h2, w_rg[l], b_rg[l], w_re[l], b_re[l],
                                           w1[l], w3[l], w2[l])
    return x
```

```cpp
#include <hip/hip_runtime.h>
#include <cstdio>
#include <cstdint>
namespace pg8 {
#define PG8_LAS __attribute__((address_space(3)))
typedef unsigned short bf16_t;
typedef short bf16x8 __attribute__((ext_vector_type(8)));
typedef float f32x4 __attribute__((ext_vector_type(4)));
typedef unsigned u32x4 __attribute__((ext_vector_type(4)));
constexpr int BM = 256, BK = 64, HALF = 128, HTB = HALF * BK * 2  , STAGE_BYTES = 8 * HTB, NXCD = 8, WGM = 8;

__host__ __device__ __forceinline__ int lds_byte(int r, int c) { const int st = (r >> 4) * 2 + (c >> 5), rr = r & 15, cc = c & 31, ob = rr * 64 + cc * 2; return st * 1024 + (ob ^ (((ob >> 9) & 1) << 5)); }
__host__ __device__ __forceinline__ void stage_rc(int b, int& R, int& C) { const int st = b / 1024, sb = b % 1024, swz = sb ^ (((sb >> 9) & 1) << 5); R = (st >> 1) * 16 + swz / 64; C = (st & 1) * 32 + (swz % 64) / 2; }
__host__ __device__ __forceinline__ int perm32(int rho) { const int n = rho >> 4, i = rho & 15; return 8 * (i >> 2) + 4 * n + (i & 3); }

struct Unit { int pm, pn, aux, cont; };
struct Gemm { const bf16_t* A; const bf16_t* Bt; int M, N, K; };

struct StaticOrder {
    int nM, nN, nwg, G, c;
    __host__ __device__ void init(int M, int N, int G_, int c_) { nM = M / BM; nN = N / BM; nwg = nM * nN; G = G_; c = c_; }
    __host__ __device__ bool next(int i, Unit& u) const {
        const long L = (long)i * G + c; if (L >= nwg) return false;
        int wgid = (int)L; { const int q = nwg / NXCD, r = nwg % NXCD, xcd = wgid % NXCD, off = wgid / NXCD; wgid = (xcd < r ? xcd * (q + 1) : r * (q + 1) + (xcd - r) * q) + off; }
        const int nig = WGM * nN, gid = wgid / nig, fm = gid * WGM, gsz = (nM - fm) < WGM ? (nM - fm) : WGM;
        u.pm = fm + ((wgid % nig) % gsz); u.pn = (wgid % nig) / gsz; u.aux = 0; u.cont = 0; return true;
    }
    __device__ __forceinline__ void a_ready(const Unit&) const {}
    __device__ __forceinline__ void done(const Unit&) const {}
};

__device__ __forceinline__ unsigned cvt_pk_bf16(float lo, float hi) { unsigned r; asm volatile("v_cvt_pk_bf16_f32 %0, %1, %2" : "=v"(r) : "v"(lo), "v"(hi)); return r; }
typedef float f32x2 __attribute__((ext_vector_type(2)));

template <class Epi, class Sched, bool ALIGN_EPI = false, bool SP2 = false>
__device__ __forceinline__ void gemm_phase(PG8_LAS unsigned char* lds, const Gemm g, const Sched& S, const Epi& E) {
    const int tid = threadIdx.x, wid = __builtin_amdgcn_readfirstlane(tid >> 6), lane = tid & 63, wr = wid >> 2, wc = wid & 3, fr = lane & 15, fq = lane >> 4;
    const int K = g.K, nt = K / BK;
    unsigned voffA[2], voffB[2];
#pragma unroll
    for (int i = 0; i < 2; ++i) { int R, C; stage_rc(tid * 16 + i * 8192, R, C); const int Rb = Epi::PERM ? ((R & ~31) + perm32(R & 31)) : R;
        voffA[i] = (unsigned)(R * K + C) * 2u; voffB[i] = (unsigned)(Rb * K + C) * 2u; }
    const size_t kstep = (size_t)(BK * 2);
    const size_t hstep = (size_t)HALF * K * 2;
    const size_t tstep = 2 * hstep;
    const unsigned ldsw = (unsigned)wid * 1024u;
    const int aoff = lds_byte(wr * 64 + fr, fq * 8), boff = lds_byte(wc * 32 + fr, fq * 8);
#define PG8_SA(b, h) (((b) * 2 + (h)) * HTB)
#define PG8_SB(b, h) ((4 + (b) * 2 + (h)) * HTB)
#define PG8_STAGE(bufoff, gbase, voff) do { _Pragma("unroll") for (int _i = 0; _i < 2; ++_i) \
        __builtin_amdgcn_global_load_lds((const unsigned*)((const char*)(gbase) + (voff)[_i]), (PG8_LAS unsigned*)(lds + (bufoff) + ldsw + _i * 8192), 16, 0, 0); } while (0)
#define PG8_LDA(dst, b, h) do { _Pragma("unroll") for (int m = 0; m < 4; ++m) _Pragma("unroll") for (int k = 0; k < 2; ++k) dst[m][k] = *(const PG8_LAS bf16x8*)(lds + PG8_SA(b, h) + aoff + m * 2048 + k * 1024); } while (0)
#define PG8_LDB(dst, b, h) do { _Pragma("unroll") for (int n = 0; n < 2; ++n) _Pragma("unroll") for (int k = 0; k < 2; ++k) dst[n][k] = *(const PG8_LAS bf16x8*)(lds + PG8_SB(b, h) + boff + n * 2048 + k * 1024); } while (0)
#define PG8_MMA(ai, bj, At, Bt) do { __builtin_amdgcn_s_setprio(1); _Pragma("unroll") for (int m = 0; m < 4; ++m) _Pragma("unroll") for (int n = 0; n < 2; ++n) _Pragma("unroll") for (int k = 0; k < 2; ++k) \
        acc[ai][bj][m][n] = __builtin_amdgcn_mfma_f32_16x16x32_bf16(Bt[n][k], At[m][k], acc[ai][bj][m][n], 0, 0, 0); __builtin_amdgcn_s_setprio(0); } while (0)
#define PG8_WAIT_V(n) asm volatile("s_waitcnt vmcnt(" #n ")" ::: "memory")
#define PG8_WAIT_L(n) asm volatile("s_waitcnt lgkmcnt(" #n ")" ::: "memory")
#define PG8_BAR __builtin_amdgcn_s_barrier()
#define PG8_SCHED __builtin_amdgcn_sched_barrier(0)
    Unit cur, nxt; int ui = 0;
    if (!S.next(0, cur)) return;
    f32x4 acc[2][2][4][2];
#pragma unroll
    for (int a = 0; a < 2; ++a)
#pragma unroll
        for (int b = 0; b < 2; ++b)
#pragma unroll
            for (int m = 0; m < 4; ++m)
#pragma unroll
                for (int n = 0; n < 2; ++n) acc[a][b][m][n] = (f32x4){0.f, 0.f, 0.f, 0.f};
    bf16x8 At[4][2], B0[2][2], B1[2][2];
    const char* cA = (const char*)g.A + (size_t)cur.pm * tstep; const char* cB = (const char*)g.Bt + (size_t)cur.pn * tstep;
    S.a_ready(cur);
    if constexpr (SP2) {
        PG8_STAGE(PG8_SB(0, 0), cB, voffB); PG8_STAGE(PG8_SB(0, 1), cB + hstep, voffB); PG8_STAGE(PG8_SA(0, 0), cA, voffA); PG8_STAGE(PG8_SA(0, 1), cA + hstep, voffA);
        if (wr == 1) PG8_BAR;
        PG8_WAIT_V(2); PG8_BAR;
        PG8_STAGE(PG8_SB(1, 0), cB + kstep, voffB); PG8_STAGE(PG8_SA(1, 0), cA + kstep, voffA); PG8_STAGE(PG8_SB(1, 1), cB + hstep + kstep, voffB);
        PG8_WAIT_V(6); PG8_BAR;
    } else {
        PG8_STAGE(PG8_SB(0, 0), cB, voffB); PG8_STAGE(PG8_SA(0, 0), cA, voffA); PG8_STAGE(PG8_SB(0, 1), cB + hstep, voffB); PG8_STAGE(PG8_SA(0, 1), cA + hstep, voffA);
        if (wr == 1) PG8_BAR;
        PG8_WAIT_V(4); PG8_BAR;
        PG8_STAGE(PG8_SB(1, 0), cB + kstep, voffB); PG8_STAGE(PG8_SA(1, 0), cA + kstep, voffA); PG8_STAGE(PG8_SB(1, 1), cB + hstep + kstep, voffB);
        PG8_WAIT_V(6); PG8_BAR;
    }
    for (;;) {
        const bool has_next = S.next(ui + 1, nxt);
        const char* nA = has_next ? (const char*)g.A + (size_t)nxt.pm * tstep : cA; const char* nB = has_next ? (const char*)g.Bt + (size_t)nxt.pn * tstep : cB;
        for (int t = 0; t < nt; t += 2) {
            const bool last = (t == nt - 2);
            const char* a1 = cA + (size_t)(t + 1) * kstep;
            const char* a2 = last ? nA : cA + (size_t)(t + 2) * kstep; const char* b2 = last ? nB : cB + (size_t)(t + 2) * kstep;
            const char* a3 = a2 + kstep; const char* b3 = b2 + kstep;
            if (last && has_next) S.a_ready(nxt);
            if constexpr (SP2) {
            PG8_LDB(B0, 0, 0); PG8_LDB(B1, 0, 1); PG8_SCHED; PG8_LDA(At, 0, 0); PG8_STAGE(PG8_SA(1, 1), a1 + hstep, voffA);
            PG8_WAIT_V(8); PG8_WAIT_L(0); PG8_BAR; PG8_MMA(0, 0, At, B0); PG8_MMA(0, 1, At, B1); PG8_BAR; PG8_SCHED;
            PG8_LDA(At, 0, 1); PG8_STAGE(PG8_SB(0, 0), b2, voffB); PG8_STAGE(PG8_SB(0, 1), b2 + hstep, voffB); PG8_STAGE(PG8_SA(0, 0), a2, voffA);
            PG8_WAIT_V(8); PG8_WAIT_L(0); PG8_BAR; PG8_MMA(1, 0, At, B0); PG8_MMA(1, 1, At, B1); PG8_BAR; PG8_SCHED;
            PG8_LDB(B0, 1, 0); PG8_LDB(B1, 1, 1); PG8_SCHED; PG8_LDA(At, 1, 0); PG8_STAGE(PG8_SA(0, 1), a2 + hstep, voffA);
            PG8_WAIT_V(8); PG8_WAIT_L(0); PG8_BAR; PG8_MMA(0, 0, At, B0); PG8_MMA(0, 1, At, B1); PG8_BAR; PG8_SCHED;
            PG8_LDA(At, 1, 1); PG8_STAGE(PG8_SB(1, 0), b3, voffB); PG8_STAGE(PG8_SB(1, 1), b3 + hstep, voffB); PG8_STAGE(PG8_SA(1, 0), a3, voffA);
            PG8_WAIT_V(8); PG8_WAIT_L(0); PG8_BAR; PG8_MMA(1, 0, At, B0); PG8_MMA(1, 1, At, B1); PG8_BAR; PG8_SCHED;
            } else {
            PG8_LDB(B0, 0, 0); PG8_SCHED; PG8_LDA(At, 0, 0); PG8_STAGE(PG8_SA(1, 1), a1 + hstep, voffA);
            PG8_WAIT_L(8); PG8_BAR; PG8_WAIT_L(0); PG8_MMA(0, 0, At, B0); PG8_BAR; PG8_SCHED;
            PG8_LDB(B1, 0, 1); PG8_STAGE(PG8_SB(0, 0), b2, voffB);
            PG8_BAR; PG8_WAIT_L(0); PG8_MMA(0, 1, At, B1); PG8_BAR;
            PG8_LDA(At, 0, 1); PG8_STAGE(PG8_SA(0, 0), a2, voffA);
            PG8_BAR; PG8_WAIT_L(0); PG8_MMA(1, 0, At, B0); PG8_BAR; PG8_SCHED;
            PG8_STAGE(PG8_SB(0, 1), b2 + hstep, voffB);
            PG8_WAIT_V(6); PG8_BAR; PG8_MMA(1, 1, At, B1); PG8_BAR;
            PG8_LDB(B0, 1, 0); PG8_SCHED; PG8_LDA(At, 1, 0); PG8_STAGE(PG8_SA(0, 1), a2 + hstep, voffA);
            PG8_WAIT_L(8); PG8_BAR; PG8_WAIT_L(0); PG8_MMA(0, 0, At, B0); PG8_BAR; PG8_SCHED;
            PG8_LDB(B1, 1, 1); PG8_STAGE(PG8_SB(1, 0), b3, voffB);
            PG8_BAR; PG8_WAIT_L(0); PG8_MMA(0, 1, At, B1); PG8_BAR;
            PG8_LDA(At, 1, 1); PG8_STAGE(PG8_SA(1, 0), a3, voffA);
            PG8_BAR; PG8_WAIT_L(0); PG8_MMA(1, 0, At, B0); PG8_BAR; PG8_SCHED;
            PG8_STAGE(PG8_SB(1, 1), b3 + hstep, voffB);
            PG8_WAIT_V(6); PG8_BAR; PG8_MMA(1, 1, At, B1); PG8_BAR;
            }
        }
        if constexpr (ALIGN_EPI) { if (wr == 0) PG8_BAR; }
        if constexpr (!Epi::AFTER_DRAIN) { if (!cur.cont) E(acc, cur, wr, wc, fr, fq); S.done(cur); }
        if (!has_next) break;
        if (!cur.cont)
#pragma unroll
        for (int a = 0; a < 2; ++a)
#pragma unroll
            for (int b = 0; b < 2; ++b)
#pragma unroll
                for (int m = 0; m < 4; ++m)
#pragma unroll
                    for (int n = 0; n < 2; ++n) acc[a][b][m][n] = (f32x4){0.f, 0.f, 0.f, 0.f};
        cur = nxt; cA = nA; cB = nB; ++ui;
        if constexpr (ALIGN_EPI) { if (wr == 1) PG8_BAR; }
    }
    PG8_WAIT_V(0);
    if constexpr (!ALIGN_EPI) { if (wr == 0) PG8_BAR; }
    PG8_BAR;
    if constexpr (Epi::AFTER_DRAIN) { E.fused(acc, cur, wr, wc, fr, fq, lds, wid, lane); S.done(cur); }
#undef PG8_SA
#undef PG8_SB
#undef PG8_STAGE
#undef PG8_LDA
#undef PG8_LDB
#undef PG8_MMA
#undef PG8_WAIT_V
#undef PG8_WAIT_L
#undef PG8_BAR
#undef PG8_SCHED
}
}

#define GAS __attribute__((address_space(1)))
#define LAS __attribute__((address_space(3)))
typedef unsigned short bf16;
typedef unsigned v4u __attribute__((ext_vector_type(4)));
typedef float f32x4 __attribute__((ext_vector_type(4)));
typedef short bf16x8 __attribute__((ext_vector_type(8)));
typedef GAS unsigned gu32;
typedef GAS unsigned long long gu64;
#define RLX_AGENT __ATOMIC_RELAXED, __HIP_MEMORY_SCOPE_AGENT
#define LDS_WAIT() asm volatile("s_waitcnt lgkmcnt(0)" ::: "memory")
#define VM_WAIT() asm volatile("s_waitcnt vmcnt(0)" ::: "memory")
__device__ __forceinline__ unsigned long long rt() { return __builtin_amdgcn_s_memrealtime(); }
__device__ __forceinline__ unsigned f2bf(float f) { unsigned u = __builtin_bit_cast(unsigned, f); return (u + 0x7fffu + ((u >> 16) & 1u)) >> 16; }
__device__ __forceinline__ unsigned pk2(float lo, float hi) { return f2bf(lo) | (f2bf(hi) << 16); }

#define XB_TMO      128
#define XB_XCNT(j)  (256  + 64 * (j))
#define XB_XSUB(j)  (1280 + 64 * (j))
#define XB_XGEN(j)  (2304 + 64 * (j))
#define XB_TOP      3328
#define XB_TOPGEN   3392
#define XCD_BAR_WORDS 3456
#define XB_SPIN_CAP (1u << 18)

__device__ __forceinline__ unsigned xb_ld(unsigned* p)              { return __hip_atomic_load(p, __ATOMIC_RELAXED, __HIP_MEMORY_SCOPE_AGENT); }
__device__ __forceinline__ unsigned xb_add(unsigned* p, unsigned v) { return __hip_atomic_fetch_add(p, v, __ATOMIC_RELAXED, __HIP_MEMORY_SCOPE_AGENT); }
__device__ __forceinline__ unsigned xb_xcc_id() { return (unsigned)__builtin_amdgcn_s_getreg((3 << 11) | 20) & 0xFu; }
#define XB_SPIN(cond, bar) do { unsigned _sp = 0; while (cond) { __builtin_amdgcn_s_sleep(1); \
    if ((++_sp & 255u) == 0u) { if (xb_ld(&(bar)[XB_TMO])) break; if (_sp > XB_SPIN_CAP) { atomicAdd(&(bar)[XB_TMO], 1u); break; } } } } while (0)

struct XcdBarrier {
    unsigned* bar; unsigned x;
    volatile LAS unsigned* st;
};

__device__ __forceinline__ XcdBarrier xcd_barrier_post(unsigned* bar, volatile LAS unsigned* st) {
    XcdBarrier b; b.bar = bar; b.x = xb_xcc_id(); b.st = st;
    if (threadIdx.x == 0) (void)xb_add(&bar[XB_XCNT(b.x)], 1u);
    return b;
}
__device__ __forceinline__ void xcd_barrier_complete(unsigned* bar, unsigned x, unsigned& nloc, unsigned& nx) {
    const unsigned G = gridDim.x * gridDim.y * gridDim.z;
    unsigned sum, cnt, mine, sp = 0u;
    for (;;) {
        sum = 0u; cnt = 0u; mine = 0u;
#pragma unroll
        for (unsigned j = 0; j < 16; ++j) { const unsigned c = xb_ld(&bar[XB_XCNT(j)]); sum += c; cnt += (c > 0u) ? 1u : 0u; mine = (j == x) ? c : mine; }
        if (sum == G) break;
        __builtin_amdgcn_s_sleep(1);
        if ((++sp & 255u) == 0u) { if (xb_ld(&bar[XB_TMO])) break; if (sp > XB_SPIN_CAP) { atomicAdd(&bar[XB_TMO], 1u); break; } }
    }
    nloc = mine > 0u ? mine : 1u; nx = cnt > 0u ? cnt : 1u;
}

__device__ __forceinline__ void xcd_barrier(const XcdBarrier& b) {
    asm volatile("s_waitcnt vmcnt(0)" ::: "memory");
    __syncthreads();
    if (threadIdx.x == 0) {
        unsigned* bar = b.bar;
        __builtin_amdgcn_s_waitcnt(0);
        unsigned nloc = b.st[0], nx = b.st[1];
        if (nloc == 0u) { xcd_barrier_complete(bar, b.x, nloc, nx); b.st[0] = nloc; b.st[1] = nx; }
        const unsigned old = xb_add(&bar[XB_XSUB(b.x)], 1u);
        const unsigned gen = old / nloc;
        if (old + 1u == (gen + 1u) * nloc) {
            __builtin_amdgcn_fence(__ATOMIC_RELEASE, "agent");
            asm volatile("s_waitcnt vmcnt(0)" ::: "memory");
            const unsigned og = xb_add(&bar[XB_TOP], 1u);
            const unsigned tg = og / nx;
            if (og + 1u == (tg + 1u) * nx) xb_add(&bar[XB_TOPGEN], 1u);
            else XB_SPIN(xb_ld(&bar[XB_TOPGEN]) == tg, bar);
            __builtin_amdgcn_fence(__ATOMIC_ACQUIRE, "agent");
            xb_add(&bar[XB_XGEN(b.x)], 1u);
            asm volatile("s_waitcnt vmcnt(0)" ::: "memory");
        } else {
            XB_SPIN(xb_ld(&bar[XB_XGEN(b.x)]) == gen, bar);
            __builtin_amdgcn_fence(__ATOMIC_ACQUIRE, "agent");
            asm volatile("s_waitcnt vmcnt(0)" ::: "memory");
        }
    }
    __syncthreads();
}


constexpr int NB = 2, SEQ = 8192, MTOK = NB * SEQ, DM = 1024, DIN = 4168, NINP = 4352;
constexpr int NCOMBO = 24, NROWBLK = 88, NSROWS = NROWBLK * 256;
constexpr float EPS = 1e-6f, LOG2E = 1.4426950408889634f, LN2 = 0.6931471805599453f, QSCALE = 0.125f * 1.4426950408889634f;
enum { IN_X = 0, IN_C, IN_WADA, IN_BADA, IN_N1G, IN_N2G, IN_WIN, IN_LBL, IN_RECG, IN_QG, IN_KG, IN_IKG, IN_IKB, IN_ATTG, IN_RELB, IN_WOUT, IN_WRG, IN_BRG, IN_WRE, IN_BRE, IN_W1, IN_W3, IN_W2, N_IN };

constexpr size_t MiB = 1u << 20;
constexpr size_t WS_CTL = 0, CTL_ZERO_BYTES = 1 * MiB;
constexpr size_t WS_MODP = 1 * MiB;
constexpr size_t WS_MODF = 1 * MiB + 512 * 1024;
constexpr size_t WS_WIN = 2 * MiB;
constexpr size_t WS_WOUT = 11 * MiB;
constexpr size_t WS_W13 = 13 * MiB;
constexpr size_t WS_W2 = 45 * MiB;
constexpr size_t WS_LS = 13 * MiB;
constexpr size_t WS_MASK = 45 * MiB;
constexpr size_t WS_H = 61 * MiB;
constexpr size_t WS_QR = 93 * MiB, WS_LF = 109 * MiB, WS_VR = 141 * MiB, WS_GR = 157 * MiB, WS_AQ = 173 * MiB, WS_AK = 189 * MiB, WS_AV = 205 * MiB, WS_IQ = 221 * MiB;
constexpr size_t WS_IK = 237 * MiB, WS_IW = 239 * MiB, WS_DEC = 239 * MiB + 512 * 1024;
constexpr size_t WS_ROUTE = 240 * MiB;
constexpr size_t WS_STOK = 241 * MiB;
constexpr size_t WS_WSORT = 242 * MiB;
constexpr size_t WS_H2S = 93 * MiB;
constexpr size_t WS_HE = 141 * MiB;
constexpr size_t WS_END = 256 * MiB;
static_assert(WS_H2S + (size_t)NSROWS * 1024 * 2 <= WS_HE && WS_HE + (size_t)NSROWS * 1024 * 2 <= WS_ROUTE && WS_WSORT + NSROWS * 8 <= WS_END, "ws map");
constexpr int CW_FAIL = 16;
constexpr int CW_BAR = 4096;
constexpr int CW_CNT = 8192, CW_CUR = 8192 + 64;

constexpr int RING_OFF = 0, RING_BYTES = 131072, MISC_OFF = RING_BYTES, LDS_BYTES = 147456;
constexpr int NWAVES = 8, NPH = 11;

typedef float f32x16 __attribute__((ext_vector_type(16)));
typedef float f32x2 __attribute__((ext_vector_type(2)));
typedef unsigned v2u __attribute__((ext_vector_type(2)));
typedef short v4i16_t __attribute__((ext_vector_type(4)));
typedef short s16x4 __attribute__((ext_vector_type(4)));

struct Args { const float* in[N_IN]; float* out; unsigned char* ws; int ph_lo, ph_hi; };

__device__ __forceinline__ float wave_sum(float v) {
#pragma unroll
    for (int o = 1; o < 64; o <<= 1) v += __shfl_xor(v, o);
    return v;
}
__device__ __forceinline__ float bf2f(unsigned short h) { return __uint_as_float((unsigned)h << 16); }
__device__ __forceinline__ float bflo(unsigned w) { return __uint_as_float(w << 16); }
__device__ __forceinline__ float bfhi(unsigned w) { return __uint_as_float(w & 0xffff0000u); }
__device__ __forceinline__ unsigned cvtpk(float lo, float hi) { unsigned r; asm volatile("v_cvt_pk_bf16_f32 %0, %1, %2" : "=v"(r) : "v"(lo), "v"(hi)); return r; }
__device__ __forceinline__ float fexp2(float x) { return __builtin_amdgcn_exp2f(x); }
__device__ __forceinline__ float fexp(float x) { return __builtin_amdgcn_exp2f(x * LOG2E); }
__device__ __forceinline__ float flog(float x) { return __builtin_amdgcn_logf(x) * LN2; }
__device__ __forceinline__ float frcp(float x) { return __builtin_amdgcn_rcpf(x); }
__device__ __forceinline__ float frsq(float x) { return __builtin_amdgcn_rsqf(x); }
__device__ __forceinline__ float silu_f(float v) { return v * frcp(1.f + fexp(-v)); }
__device__ __forceinline__ float sigm_f(float v) { return frcp(1.f + fexp(-v)); }
__device__ __forceinline__ int crow(int r, int hi) { return (r & 3) + 8 * (r >> 2) + 4 * hi; }
#define MFMA32(a, b, c) __builtin_amdgcn_mfma_f32_32x32x16_bf16((a), (b), (c), 0, 0, 0)

struct WinMap { __device__ __forceinline__ int operator()(int n) const {
    if (n < 2048) return n;
    if (n < 3072) { const int j = (n - 2048) & 511, seg = (n - 2048) >> 9, h = j >> 6, d = j & 63; return (8 + seg * 2 + (h >> 2)) * 256 + 128 * (d >> 5) + 32 * (h & 3) + (d & 31); }
    if (n < 4096) return n;
    if (n < 4160) { const int d = n - 4096; return 16 * 256 + 128 * (d >> 5) + (d & 31); }
    return 16 * 256 + 32 + (n - 4160); } };
struct OffMap { int off; __device__ __forceinline__ int operator()(int n) const { return off + n; } };
struct W13Map { int base; __device__ __forceinline__ int operator()(int n) const { return base + (n >> 7) * 256 + (n & 127); } };

template <class Map>
__device__ __forceinline__ void transpose_item(const float* W, int N, bf16* WT, int ldt, const Map map, LAS float* scr, int item, int lane) {
    const int nblk = (N + 31) / 32, kb = item / nblk, nb = item % nblk, k0 = 64 * kb, n0 = 32 * nb;
    const bool inb = (n0 + (lane & 31)) < N;
#pragma unroll 8
    for (int i = 0; i < 32; ++i) { const int kk = 2 * i + (lane >> 5); scr[kk * 33 + (lane & 31)] = inb ? W[(size_t)(k0 + kk) * N + n0 + (lane & 31)] : 0.f; }
    LDS_WAIT(); asm volatile("" ::: "memory");
    const int c = lane & 7;
#pragma unroll
    for (int j = 0; j < 4; ++j) { const int n = (lane >> 3) + 8 * j; const LAS float* s = scr + (8 * c) * 33 + n;
        v4u o; o.x = pk2(s[0 * 33], s[1 * 33]); o.y = pk2(s[2 * 33], s[3 * 33]); o.z = pk2(s[4 * 33], s[5 * 33]); o.w = pk2(s[6 * 33], s[7 * 33]);
        if (n0 + n < N) *(GAS v4u*)(WT + (size_t)map(n0 + n) * ldt + k0 + 8 * c) = o; }
    LDS_WAIT(); asm volatile("" ::: "memory");
}

__device__ __forceinline__ void phase0(const Args& a, LAS unsigned char* lds, int tid, int lane, int wave, int G) {
    const float* wada = a.in[IN_WADA]; const float* cvec = a.in[IN_C]; float* modp = (float*)(a.ws + WS_MODP);
    for (int it = blockIdx.x; it < 192; it += G) {
        const int ks = it / 24, cg = it % 24, k0 = ks * 128 + wave * 16, col = cg * 256 + 4 * lane;
        f32x4 a0 = {0.f, 0.f, 0.f, 0.f}, a1 = {0.f, 0.f, 0.f, 0.f};
#pragma unroll 4
        for (int r = 0; r < 16; ++r) { const int k = k0 + r; const float s0 = silu_f(cvec[k]), s1 = silu_f(cvec[1024 + k]);
            const f32x4 w = *(const GAS f32x4*)(wada + (size_t)k * 6144 + col); a0 += w * s0; a1 += w * s1; }
        LAS float* red = (LAS float*)lds;
        *(LAS f32x4*)(red + wave * 512 + 4 * lane) = a0; *(LAS f32x4*)(red + wave * 512 + 256 + 4 * lane) = a1;
        __syncthreads();
        { float s = 0.f;
#pragma unroll
          for (int w = 0; w < 8; ++w) s += red[w * 512 + tid];
          const int b = tid >> 8, cc = tid & 255; modp[(size_t)(ks * 2 + b) * 6144 + cg * 256 + cc] = s; }
        __syncthreads();
    }
    LAS float* scr = (LAS float*)(lds + wave * 16384);
    const int gw = blockIdx.x * NWAVES + wave, NGW = G * NWAVES;
    constexpr int I_IN = 16 * 131, I_OUT = 16 * 32, I_Z = 256;
    bf16* win = (bf16*)(a.ws + WS_WIN); bf16* wout = (bf16*)(a.ws + WS_WOUT);
    for (int it = gw; it < I_IN + I_OUT + I_Z; it += NGW) {
        int r = it;
        if (r < I_IN) { transpose_item(a.in[IN_WIN], DIN, win, 1024, WinMap{}, scr, r, lane); continue; } r -= I_IN;
        if (r < I_OUT) { transpose_item(a.in[IN_WOUT], 1024, wout, 1024, OffMap{0}, scr, r, lane); continue; } r -= I_OUT;
        { const bool valid = (r < 40) || (r >= 128 && r < 160);
          if (!valid) { GAS v4u* p = (GAS v4u*)(win + (size_t)(16 * 256 + r) * 1024) + lane; const v4u z = {0u, 0u, 0u, 0u}; p[0] = z; p[64] = z; } }
    }
}

__device__ __forceinline__ void moe_weight_items(const Args& a, LAS float* scr, int gw, int NGW, int lane) {
    bf16* w13 = (bf16*)(a.ws + WS_W13); bf16* w2t = (bf16*)(a.ws + WS_W2);
    constexpr int I_1 = 16 * 16, I_2 = 8 * 32;
    for (int it = gw; it < 16 * (2 * I_1 + I_2); it += NGW) {
        const int e = it / (2 * I_1 + I_2); int r = it % (2 * I_1 + I_2);
        if (r < I_1) { transpose_item(a.in[IN_W1] + (size_t)e * 1024 * 512, 512, w13, 1024, W13Map{e * 1024}, scr, r, lane); continue; } r -= I_1;
        if (r < I_1) { transpose_item(a.in[IN_W3] + (size_t)e * 1024 * 512, 512, w13, 1024, W13Map{e * 1024 + 128}, scr, r, lane); continue; } r -= I_1;
        transpose_item(a.in[IN_W2] + (size_t)e * 512 * 1024, 1024, w2t, 512, OffMap{e * 1024}, scr, r, lane);
    }
}

__device__ __forceinline__ void phase1(const Args& a, LAS unsigned char* lds, int tid, int lane, int wave, int G) {
    LAS float* A1 = (LAS float*)lds; LAS float* S1 = A1 + 2048;
    const float* modp = (const float*)(a.ws + WS_MODP); const float* bada = a.in[IN_BADA]; const float* g = a.in[IN_N1G];
    for (int idx = tid; idx < 2048; idx += 512) { const int b = idx >> 10, i = idx & 1023; float sh = bada[i], sc = bada[1024 + i];
#pragma unroll
        for (int ks = 0; ks < 8; ++ks) { sh += modp[(size_t)(ks * 2 + b) * 6144 + i]; sc += modp[(size_t)(ks * 2 + b) * 6144 + 1024 + i]; }
        A1[idx] = g[i] * (1.f + sc); S1[idx] = sh; }
    float* modf = (float*)(a.ws + WS_MODF);
    for (int idx = blockIdx.x * 512 + tid; idx < 12288; idx += G * 512) { const int b = idx / 6144, j = idx % 6144; float s = bada[j];
#pragma unroll
        for (int ks = 0; ks < 8; ++ks) s += modp[(size_t)(ks * 2 + b) * 6144 + j];
        modf[idx] = s; }
    __syncthreads();
    const int gw = blockIdx.x * NWAVES + wave, NGW = G * NWAVES;
    const float* x = a.in[IN_X]; bf16* H = (bf16*)(a.ws + WS_H);
    for (int m = gw; m < MTOK; m += NGW) {
        const int b = m >> 13; const GAS f32x4* xr = (const GAS f32x4*)(x + (size_t)m * DM) + lane;
        f32x4 v[4]; float s = 0.f;
#pragma unroll
        for (int j = 0; j < 4; ++j) { v[j] = xr[64 * j]; s += (v[j].x * v[j].x + v[j].y * v[j].y) + (v[j].z * v[j].z + v[j].w * v[j].w); }
        const float r = frsq(wave_sum(s) * (1.f / DM) + EPS);
        GAS v2u* o8 = (GAS v2u*)(H + (size_t)m * DM) + lane;
#pragma unroll
        for (int j = 0; j < 4; ++j) { const f32x4 aa = *(LAS f32x4*)(A1 + b * 1024 + 256 * j + 4 * lane), ss = *(LAS f32x4*)(S1 + b * 1024 + 256 * j + 4 * lane);
            const f32x4 h = v[j] * r * aa + ss; v2u w; w.x = cvtpk(h.x, h.y); w.y = cvtpk(h.z, h.w); o8[64 * j] = w; }
    }
}

struct EpiInProj {
    static constexpr bool PERM = true, AFTER_DRAIN = false;
    unsigned char* ws; const float *lbl, *qg, *kg, *ikg, *ikb;
    __device__ __forceinline__ void operator()(const pg8::f32x4 (&acc)[2][2][4][2], const pg8::Unit& u, int wr, int wc, int fr, int fq) const {
        const int pn = u.pn, row0 = u.pm * 256 + wr * 64 + fr;
        if (pn < 2 || (pn >= 4 && pn < 8) || (pn >= 12 && pn < 16)) {
            size_t off; int ct; bool act;
            if (pn < 2) { off = WS_QR; ct = pn; act = true; } else if (pn < 6) { off = WS_VR; ct = pn - 4; act = false; } else if (pn < 8) { off = WS_GR; ct = pn - 6; act = true; }
            else if (pn < 14) { off = WS_AV; ct = pn - 12; act = false; } else { off = WS_IQ; ct = pn - 14; act = false; }
            bf16* dst = (bf16*)(ws + off); const int col0 = ct * 256 + wc * 32 + 8 * fq;
#pragma unroll
            for (int ai = 0; ai < 2; ++ai)
#pragma unroll
                for (int m = 0; m < 4; ++m) { bf16* rowp = dst + (size_t)(row0 + ai * 128 + m * 16) * 512 + col0;
#pragma unroll
                    for (int bj = 0; bj < 2; ++bj) { pg8::f32x4 v0 = acc[ai][bj][m][0], v1 = acc[ai][bj][m][1];
                        if (act) { v0 = (pg8::f32x4){silu_f(v0[0]), silu_f(v0[1]), silu_f(v0[2]), silu_f(v0[3])}; v1 = (pg8::f32x4){silu_f(v1[0]), silu_f(v1[1]), silu_f(v1[2]), silu_f(v1[3])}; }
                        v4u w; w.x = cvtpk(v0[0], v0[1]); w.y = cvtpk(v0[2], v0[3]); w.z = cvtpk(v1[0], v1[1]); w.w = cvtpk(v1[2], v1[3]);
                        *(GAS v4u*)(rowp + bj * 128) = w; } }
        } else if (pn < 4) {
            float* dst = (float*)(ws + WS_LF); const int col0 = (pn - 2) * 256 + wc * 32 + 8 * fq;
            float lb[2][8];
#pragma unroll
            for (int bj = 0; bj < 2; ++bj)
#pragma unroll
                for (int j = 0; j < 8; ++j) { const int c = col0 + bj * 128 + j; lb[bj][j] = frcp(1.f + fexp(lbl[512 + c] - lbl[c])); }
#pragma unroll
            for (int ai = 0; ai < 2; ++ai)
#pragma unroll
                for (int m = 0; m < 4; ++m) { float* rowp = dst + (size_t)(row0 + ai * 128 + m * 16) * 512 + col0;
#pragma unroll
                    for (int bj = 0; bj < 2; ++bj) { f32x4 o0, o1;
#pragma unroll
                        for (int j = 0; j < 4; ++j) { const float l0 = lb[bj][j], l1 = lb[bj][4 + j];
                            o0[j] = flog(l0 + (1.f - l0) * sigm_f(acc[ai][bj][m][0][j])); o1[j] = flog(l1 + (1.f - l1) * sigm_f(acc[ai][bj][m][1][j])); }
                        *(GAS f32x4*)(rowp + bj * 128) = o0; *(GAS f32x4*)(rowp + bj * 128 + 4) = o1; } }
        } else if (pn < 12) {
            const int seg = (pn - 8) >> 1, head = ((pn - 8) & 1) * 4 + wc; const float* gs = seg ? kg : qg; const float sc = seg ? 1.f : QSCALE;
            bf16* dst = (bf16*)(ws + (seg ? WS_AK : WS_AQ));
            f32x4 gv[2][2];
#pragma unroll
            for (int bj = 0; bj < 2; ++bj)
#pragma unroll
                for (int n = 0; n < 2; ++n) gv[bj][n] = *(const f32x4*)(gs + 32 * bj + 8 * fq + 4 * n) * sc;
#pragma unroll
            for (int ai = 0; ai < 2; ++ai)
#pragma unroll
                for (int m = 0; m < 4; ++m) { float ss = 0.f;
#pragma unroll
                    for (int bj = 0; bj < 2; ++bj)
#pragma unroll
                        for (int n = 0; n < 2; ++n) { const pg8::f32x4 v = acc[ai][bj][m][n]; ss += (v[0] * v[0] + v[1] * v[1]) + (v[2] * v[2] + v[3] * v[3]); }
                    ss += __shfl_xor(ss, 16); ss += __shfl_xor(ss, 32);
                    const float ri = frsq(ss * (1.f / 64.f) + EPS);
                    bf16* rowp = dst + (size_t)(row0 + ai * 128 + m * 16) * 512 + head * 64 + 8 * fq;
#pragma unroll
                    for (int bj = 0; bj < 2; ++bj) { const f32x4 v0 = acc[ai][bj][m][0] * ri * gv[bj][0], v1 = acc[ai][bj][m][1] * ri * gv[bj][1];
                        v4u w; w.x = cvtpk(v0[0], v0[1]); w.y = cvtpk(v0[2], v0[3]); w.z = cvtpk(v1[0], v1[1]); w.w = cvtpk(v1[2], v1[3]);
                        *(GAS v4u*)(rowp + bj * 32) = w; } }
        } else {
            if (wc == 0) {
                bf16* dst = (bf16*)(ws + WS_IK); f32x4 gv[2][2], bv[2][2];
#pragma unroll
                for (int bj = 0; bj < 2; ++bj)
#pragma unroll
                    for (int n = 0; n < 2; ++n) { gv[bj][n] = *(const f32x4*)(ikg + 32 * bj + 8 * fq + 4 * n); bv[bj][n] = *(const f32x4*)(ikb + 32 * bj + 8 * fq + 4 * n); }
#pragma unroll
                for (int ai = 0; ai < 2; ++ai)
#pragma unroll
                    for (int m = 0; m < 4; ++m) { float s = 0.f;
#pragma unroll
                        for (int bj = 0; bj < 2; ++bj)
#pragma unroll
                            for (int n = 0; n < 2; ++n) { const pg8::f32x4 v = acc[ai][bj][m][n]; s += (v[0] + v[1]) + (v[2] + v[3]); }
                        s += __shfl_xor(s, 16); s += __shfl_xor(s, 32);
                        const float mu = s * (1.f / 64.f); float q = 0.f;
#pragma unroll
                        for (int bj = 0; bj < 2; ++bj)
#pragma unroll
                            for (int n = 0; n < 2; ++n) { const pg8::f32x4 d = acc[ai][bj][m][n] - mu; q += (d[0] * d[0] + d[1] * d[1]) + (d[2] * d[2] + d[3] * d[3]); }
                        q += __shfl_xor(q, 16); q += __shfl_xor(q, 32);
                        const float rs = frsq(q * (1.f / 64.f) + EPS);
                        bf16* rowp = dst + (size_t)(row0 + ai * 128 + m * 16) * 64 + 8 * fq;
#pragma unroll
                        for (int bj = 0; bj < 2; ++bj) { const f32x4 v0 = (acc[ai][bj][m][0] - mu) * rs * gv[bj][0] + bv[bj][0], v1 = (acc[ai][bj][m][1] - mu) * rs * gv[bj][1] + bv[bj][1];
                            v4u w; w.x = cvtpk(v0[0], v0[1]); w.y = cvtpk(v0[2], v0[3]); w.z = cvtpk(v1[0], v1[1]); w.w = cvtpk(v1[2], v1[3]);
                            *(GAS v4u*)(rowp + bj * 32) = w; } }
            } else if (wc == 1 && fq == 0) {
                float* dst = (float*)(ws + WS_IW);
#pragma unroll
                for (int ai = 0; ai < 2; ++ai)
#pragma unroll
                    for (int m = 0; m < 4; ++m) { float* rowp = dst + (size_t)(row0 + ai * 128 + m * 16) * 8;
                        *(GAS f32x4*)(rowp) = acc[ai][0][m][0] * 0.35355339059327373f; *(GAS f32x4*)(rowp + 4) = acc[ai][0][m][1] * 0.35355339059327373f; }
            }
        }
    }
};

constexpr int IDX_CAP = 768, IDX_KT_STRIDE = 144, IDX_KT_BYTES = 64 * IDX_KT_STRIDE;
constexpr int IDX_CAND_OFF = 0, IDX_KT_OFF = NWAVES * 4 * IDX_CAP * 4;
static_assert(IDX_KT_OFF + 2 * IDX_KT_BYTES <= RING_BYTES, "indexer LDS");

__device__ __forceinline__ unsigned mono_pack(float s, int kidx) {
    const unsigned u = __float_as_uint(s); const unsigned m = u ^ ((unsigned)((int)u >> 31) | 0x80000000u);
    return (m & 0xFFFFE000u) | (unsigned)(8191 - kidx);
}
__device__ __forceinline__ int lane_prefix(unsigned long long bal) { return __builtin_amdgcn_mbcnt_hi((unsigned)(bal >> 32), __builtin_amdgcn_mbcnt_lo((unsigned)bal, 0u)); }

__device__ __forceinline__ unsigned idx_prune(LAS unsigned* buf, int cnt, int lane) {
    constexpr int NV = IDX_CAP / 64; unsigned v[NV];
#pragma unroll
    for (int j = 0; j < NV; ++j) { const int idx = j * 64 + lane; v[j] = idx < cnt ? buf[idx] : 0u; }
    unsigned T = 0u;
    for (int bit = 31; bit >= 0; --bit) { const unsigned cand = T | (1u << bit); int c = 0;
#pragma unroll
        for (int j = 0; j < NV; ++j) c += __popcll(__ballot(v[j] >= cand));
        if (c >= 256) T = cand; }
    LDS_WAIT();
    int base = 0;
#pragma unroll
    for (int j = 0; j < NV; ++j) { const bool p = v[j] >= T; const unsigned long long bal = __ballot(p); const int pre = lane_prefix(bal);
        if (p) buf[base + pre] = v[j]; base += __popcll(bal); }
    LDS_WAIT();
    return T;
}

__device__ __forceinline__ void idx_item(const Args& a, LAS unsigned char* lds, int b, int qblk, int tid, int lane, int wave) {
    const bf16* IQ = (const bf16*)(a.ws + WS_IQ); const bf16* IK = (const bf16*)(a.ws + WS_IK); const float* IW = (const float*)(a.ws + WS_IW); unsigned* MASK = (unsigned*)(a.ws + WS_MASK);
    const int t0 = qblk * 32 + wave * 4, nkb = (qblk >> 1) + 1;
    const int hi = lane >> 5, m = lane & 31;
    bf16x8 af[4];
    { const int qa = 2 * ((m >> 2) & 1) + ((m >> 4) & 1), ha = 4 * ((m >> 3) & 1) + (m & 3); const size_t tok = (size_t)b * SEQ + t0 + qa;
      const float wsc = IW[tok * 8 + ha] * 0.125f;
#pragma unroll
      for (int ks = 0; ks < 4; ++ks) { const v4u raw = *(const GAS v4u*)(IQ + tok * 512 + ha * 64 + 16 * ks + 8 * hi); v4u o;
          o.x = cvtpk(bflo(raw.x) * wsc, bfhi(raw.x) * wsc); o.y = cvtpk(bflo(raw.y) * wsc, bfhi(raw.y) * wsc); o.z = cvtpk(bflo(raw.z) * wsc, bfhi(raw.z) * wsc); o.w = cvtpk(bflo(raw.w) * wsc, bfhi(raw.w) * wsc);
          af[ks] = __builtin_bit_cast(bf16x8, o); } }
    float cinf[16];
#pragma unroll
    for (int i = 0; i < 16; ++i) { const float w = IW[((size_t)b * SEQ + t0 + 2 * hi + (i >> 3)) * 8 + (i & 7)]; cinf[i] = w >= 0.f ? __builtin_inff() : -__builtin_inff(); }
    LAS unsigned* cb = (LAS unsigned*)(lds + IDX_CAND_OFF) + wave * 4 * IDX_CAP;
    LAS unsigned* cb0 = cb + (2 * hi) * IDX_CAP; LAS unsigned* cb1 = cb0 + IDX_CAP;
    int cnt0 = 0, cnt1 = 0; unsigned thr0 = 0u, thr1 = 0u;
    const int skey = tid >> 3, sch = tid & 7;
    const bf16* ksrc = IK + ((size_t)b * SEQ + skey) * 64 + sch * 8;
    LAS unsigned char* kt = lds + IDX_KT_OFF; const int kdst = skey * IDX_KT_STRIDE + sch * 16;
    v4u kreg = *(const GAS v4u*)ksrc;
    *(LAS v4u*)(kt + kdst) = kreg;
    __syncthreads();
    for (int kb = 0; kb < nkb; ++kb) {
        if (kb + 1 < nkb) kreg = *(const GAS v4u*)(ksrc + (size_t)(kb + 1) * 64 * 64);
        const LAS unsigned char* kcur = kt + (kb & 1) * IDX_KT_BYTES;
#pragma unroll
        for (int sub = 0; sub < 2; ++sub) {
            f32x16 acc = {0.f, 0.f, 0.f, 0.f, 0.f, 0.f, 0.f, 0.f, 0.f, 0.f, 0.f, 0.f, 0.f, 0.f, 0.f, 0.f};
#pragma unroll
            for (int ks = 0; ks < 4; ++ks) { const bf16x8 bfr = *(const LAS bf16x8*)(kcur + (sub * 32 + m) * IDX_KT_STRIDE + (16 * ks + 8 * hi) * 2); acc = MFMA32(af[ks], bfr, acc); }
            float s0 = 0.f, s1 = 0.f;
#pragma unroll
            for (int j = 0; j < 8; ++j) { s0 += __builtin_amdgcn_fmed3f(acc[j], 0.f, cinf[j]); s1 += __builtin_amdgcn_fmed3f(acc[8 + j], 0.f, cinf[8 + j]); }
            const int kidx = kb * 64 + sub * 32 + m;
            const unsigned p0 = mono_pack(s0, kidx), p1 = mono_pack(s1, kidx);
            { const bool ps = p0 > thr0; const unsigned long long bal = __ballot(ps); const unsigned lo = (unsigned)bal, hh = (unsigned)(bal >> 32);
              const int pre = hi ? __builtin_amdgcn_mbcnt_hi(hh, 0u) : __builtin_amdgcn_mbcnt_lo(lo, 0u);
              if (ps) cb0[cnt0 + pre] = p0; cnt0 += hi ? __popc(hh) : __popc(lo); }
            { const bool ps = p1 > thr1; const unsigned long long bal = __ballot(ps); const unsigned lo = (unsigned)bal, hh = (unsigned)(bal >> 32);
              const int pre = hi ? __builtin_amdgcn_mbcnt_hi(hh, 0u) : __builtin_amdgcn_mbcnt_lo(lo, 0u);
              if (ps) cb1[cnt1 + pre] = p1; cnt1 += hi ? __popc(hh) : __popc(lo); }
        }
        { const int c00 = __builtin_amdgcn_readlane(cnt0, 0), c01 = __builtin_amdgcn_readlane(cnt1, 0), c10 = __builtin_amdgcn_readlane(cnt0, 32), c11 = __builtin_amdgcn_readlane(cnt1, 32);
          constexpr int LIM = IDX_CAP - 64;
          if (c00 > LIM || c01 > LIM || c10 > LIM || c11 > LIM) {
              LDS_WAIT();
              if (c00 > LIM) { const unsigned T = idx_prune(cb, c00, lane); if (!hi) { thr0 = T; cnt0 = 256; } }
              if (c01 > LIM) { const unsigned T = idx_prune(cb + IDX_CAP, c01, lane); if (!hi) { thr1 = T; cnt1 = 256; } }
              if (c10 > LIM) { const unsigned T = idx_prune(cb + 2 * IDX_CAP, c10, lane); if (hi) { thr0 = T; cnt0 = 256; } }
              if (c11 > LIM) { const unsigned T = idx_prune(cb + 3 * IDX_CAP, c11, lane); if (hi) { thr1 = T; cnt1 = 256; } }
          } }
        if (kb + 1 < nkb) *(LAS v4u*)(kt + ((kb + 1) & 1) * IDX_KT_BYTES + kdst) = kreg;
        __syncthreads();
    }
    LDS_WAIT();
#pragma unroll
    for (int q = 0; q < 4; ++q) {
        int cq = __builtin_amdgcn_readlane((q & 1) ? cnt1 : cnt0, (q >> 1) * 32);
        LAS unsigned* buf = cb + q * IDX_CAP;
        if (cq > 256) { (void)idx_prune(buf, cq, lane); cq = 256; }
        LAS unsigned* mrow = buf + 256;
#pragma unroll
        for (int j = 0; j < 4; ++j) mrow[j * 64 + lane] = 0u;
        LDS_WAIT();
#pragma unroll
        for (int j = 0; j < 4; ++j) { const int idx = j * 64 + lane; if (idx < cq) { const unsigned v = buf[idx]; const unsigned key = 8191u - (v & 8191u);
            __hip_atomic_fetch_or(mrow + (key >> 5), 1u << (key & 31u), __ATOMIC_RELAXED, __HIP_MEMORY_SCOPE_WORKGROUP); } }
        LDS_WAIT();
        const v4u o = *(const LAS v4u*)(mrow + 4 * lane);
        *(GAS v4u*)(MASK + ((size_t)b * SEQ + t0 + q) * 256 + 4 * lane) = o;
    }
    __syncthreads();
}

constexpr int HL_STRIDE = 144;
__device__ __forceinline__ void hgrn_local_item(const Args& a, LAS unsigned char* lds, int item, int tid, int lane, int wave) {
    const int bh = item >> 7, c = item & 127, b = bh >> 2, h = bh & 3;
    const float* LF = (const float*)(a.ws + WS_LF); const bf16* VR = (const bf16*)(a.ws + WS_VR);
    unsigned* LS = (unsigned*)(a.ws + WS_LS); float* DEC = (float*)(a.ws + WS_DEC);
    LAS unsigned char* kct = lds; LAS unsigned char* vt = lds + 128 * HL_STRIDE; LAS float* seg = (LAS float*)(lds + 2 * 128 * HL_STRIDE);
    const int k = tid & 127, sg = tid >> 7;
    const size_t row0 = (size_t)b * SEQ + c * 64 + sg * 16;
    float lf[16], vv[16];
#pragma unroll
    for (int j = 0; j < 16; ++j) { lf[j] = LF[(row0 + j) * 512 + h * 128 + k]; vv[j] = bf2f(VR[(row0 + j) * 512 + h * 128 + k]); }
    float run = 0.f, bl[16];
#pragma unroll
    for (int j = 0; j < 16; ++j) { run += lf[j]; bl[j] = run; }
    seg[sg * 128 + k] = run;
    __syncthreads();
    float off = 0.f, tot = 0.f;
#pragma unroll
    for (int s = 0; s < 4; ++s) { const float x = seg[s * 128 + k]; tot += x; if (s < sg) off += x; }
    { unsigned pk[8], pv[8];
#pragma unroll
      for (int j = 0; j < 8; ++j) { const float k0 = (1.f - fexp(lf[2 * j])) * fexp(tot - off - bl[2 * j]), k1 = (1.f - fexp(lf[2 * j + 1])) * fexp(tot - off - bl[2 * j + 1]);
          pk[j] = cvtpk(k0, k1); pv[j] = cvtpk(vv[2 * j], vv[2 * j + 1]); }
      *(LAS v4u*)(kct + k * HL_STRIDE + sg * 32) = (v4u){pk[0], pk[1], pk[2], pk[3]}; *(LAS v4u*)(kct + k * HL_STRIDE + sg * 32 + 16) = (v4u){pk[4], pk[5], pk[6], pk[7]};
      *(LAS v4u*)(vt + k * HL_STRIDE + sg * 32) = (v4u){pv[0], pv[1], pv[2], pv[3]}; *(LAS v4u*)(vt + k * HL_STRIDE + sg * 32 + 16) = (v4u){pv[4], pv[5], pv[6], pv[7]}; }
    if (sg == 0) DEC[(size_t)item * 128 + k] = fexp(tot);
    __syncthreads();
    { const int hi = lane >> 5, m = lane & 31, mt = wave >> 1, np = wave & 1;
      f32x16 acc0 = {0.f, 0.f, 0.f, 0.f, 0.f, 0.f, 0.f, 0.f, 0.f, 0.f, 0.f, 0.f, 0.f, 0.f, 0.f, 0.f}, acc1 = acc0;
#pragma unroll
      for (int ks = 0; ks < 4; ++ks) { const bf16x8 av = *(const LAS bf16x8*)(vt + (32 * mt + m) * HL_STRIDE + (16 * ks + 8 * hi) * 2);
          const bf16x8 b0 = *(const LAS bf16x8*)(kct + (64 * np + 2 * m) * HL_STRIDE + (16 * ks + 8 * hi) * 2), b1 = *(const LAS bf16x8*)(kct + (64 * np + 2 * m + 1) * HL_STRIDE + (16 * ks + 8 * hi) * 2);
          acc0 = MFMA32(av, b0, acc0); acc1 = MFMA32(av, b1, acc1); }
#pragma unroll
      for (int i = 0; i < 16; ++i) { const int v = 32 * mt + crow(i, hi); LS[((size_t)item * 128 + v) * 64 + 32 * np + m] = cvtpk(acc0[i], acc1[i]); } }
    __syncthreads();
}

__device__ __forceinline__ void phase4(const Args& a, int tid, int G) {
    unsigned* LS = (unsigned*)(a.ws + WS_LS); const float* DEC = (const float*)(a.ws + WS_DEC);
    for (int gid = blockIdx.x * 512 + tid; gid < 65536; gid += G * 512) {
        const int bh = gid >> 13, v = (gid >> 6) & 127, kp = gid & 63;
        float s0 = 0.f, s1 = 0.f;
#pragma unroll 8
        for (int c = 0; c < 128; ++c) { const size_t item = (size_t)bh * 128 + c; unsigned* p = LS + (item * 128 + v) * 64 + kp;
            const unsigned w = *p; const f32x2 d = *(const f32x2*)(DEC + item * 128 + 2 * kp);
            s0 = d.x * s0 + bflo(w); s1 = d.y * s1 + bfhi(w); *p = cvtpk(s0, s1); }
    }
}

constexpr int AT_KSTRIDE = 144, AT_KBYTES = 64 * AT_KSTRIDE, AT_VBYTES = 8192;
constexpr int AT_K_OFF = 0, AT_V_OFF = 2 * AT_KBYTES, AT_TAB_OFF = AT_V_OFF + 2 * AT_VBYTES, AT_L_OFF = AT_TAB_OFF + 1024, AT_OST_OFF = AT_L_OFF + NWAVES * 128, AT_OST_STRIDE = 68;
static_assert(AT_OST_OFF + NWAVES * 32 * AT_OST_STRIDE * 4 <= RING_BYTES, "attention LDS");

__device__ __forceinline__ int t5_bucket_neg(int n) {
    return n < 8 ? n : n < 12 ? 8 : n < 16 ? 9 : n < 23 ? 10 : n < 32 ? 11 : n < 46 ? 12 : n < 64 ? 13 : n < 91 ? 14 : 15;
}
__device__ __forceinline__ s16x4 vtr(const LAS unsigned char* p) { return __builtin_bit_cast(s16x4, __builtin_amdgcn_ds_read_tr16_b64_v4i16((LAS v4i16_t*)p)); }

__device__ __forceinline__ void attn_item(const Args& a, LAS unsigned char* lds, int b, int h, int qb, int tid, int lane, int wave) {
    const bf16* AQ = (const bf16*)(a.ws + WS_AQ); const bf16* AK = (const bf16*)(a.ws + WS_AK); const bf16* AV = (const bf16*)(a.ws + WS_AV);
    const unsigned* MASK = (const unsigned*)(a.ws + WS_MASK); bf16* MIX = (bf16*)(a.ws + WS_H);
    const int hi = lane >> 5, r32 = lane & 31, q0 = qb * 256, qw = q0 + wave * 32, NT = (q0 + 256) >> 6, jmax = (qw + 31) >> 6;
    LAS float* tab = (LAS float*)(lds + AT_TAB_OFF);
    if (tid < 192) {
        const float* qg = a.in[IN_QG]; const float* kg = a.in[IN_KG]; const float* rb = a.in[IN_RELB];
        float mq = 0.f, mk = 0.f, mb = -3.0e38f;
        for (int i = 0; i < 64; ++i) { mq = fmaxf(mq, fabsf(qg[i])); mk = fmaxf(mk, fabsf(kg[i])); }
        for (int i = 0; i < 32; ++i) mb = fmaxf(mb, rb[i * 8 + h]);
        const float bound = 8.f * mq * mk + mb; const int rel = tid - 128, n = rel < 0 ? -rel : rel;
        const int bk = (rel > 0 ? 16 : 0) + t5_bucket_neg(n);
        tab[tid] = (rb[bk * 8 + h] - bound) * LOG2E;
    }
    bf16x8 qr[4];
    { const bf16* qp = AQ + ((size_t)b * SEQ + qw + r32) * 512 + h * 64 + 8 * hi;
#pragma unroll
      for (int d0 = 0; d0 < 4; ++d0) qr[d0] = *(const GAS bf16x8*)(qp + 16 * d0); }
    const int skey = tid >> 3, sch = tid & 7;
    const size_t srow = ((size_t)b * SEQ + skey) * 512 + h * 64 + sch * 8;
    const int kdst = skey * AT_KSTRIDE + sch * 16, vdst = ((sch >> 2) * 4 + (skey >> 4)) * 1024 + (skey & 15) * 64 + (sch & 3) * 16;
    LAS unsigned char* kt = lds + AT_K_OFF; LAS unsigned char* vtb = lds + AT_V_OFF;
    v4u kreg = *(const GAS v4u*)(AK + srow), vreg = *(const GAS v4u*)(AV + srow);
    *(LAS v4u*)(kt + kdst) = kreg; *(LAS v4u*)(vtb + vdst) = vreg;
    const unsigned* mrow = MASK + ((size_t)b * SEQ + qw + r32) * 256;
    v2u mw = *(const GAS v2u*)(mrow);
    f32x16 o0 = {0.f, 0.f, 0.f, 0.f, 0.f, 0.f, 0.f, 0.f, 0.f, 0.f, 0.f, 0.f, 0.f, 0.f, 0.f, 0.f}, o1 = o0;
    float lsum = 0.f;
    __syncthreads();
    const float cfar = tab[0];
    const int vb = ((lane >> 4) & 1) * 32 + (lane & 3) * 8 + (4 * hi + ((lane & 15) >> 2)) * 64;
    for (int j = 0; j < NT; ++j) {
        v2u mwn = mw;
        if (j + 1 < NT) { kreg = *(const GAS v4u*)(AK + srow + (size_t)(j + 1) * 64 * 512); vreg = *(const GAS v4u*)(AV + srow + (size_t)(j + 1) * 64 * 512); mwn = *(const GAS v2u*)(mrow + 2 * (j + 1)); }
        if (j <= jmax) {
            const LAS unsigned char* kcur = kt + (j & 1) * AT_KBYTES; const LAS unsigned char* vcur = vtb + (j & 1) * AT_VBYTES + vb;
            const bool far = (64 * j + 63 - qw) <= -91;
#pragma unroll
            for (int sub = 0; sub < 2; ++sub) {
                f32x16 s;
                if (far) {
#pragma unroll
                    for (int r = 0; r < 16; ++r) s[r] = cfar;
                } else {
                    const int base = 64 * j + 32 * sub + 4 * hi - qw - r32 + 128;
#pragma unroll
                    for (int r = 0; r < 16; ++r) { int ix = base + (r & 3) + 8 * (r >> 2); ix = ix < 0 ? 0 : ix; s[r] = tab[ix]; }
                }
#pragma unroll
                for (int d0 = 0; d0 < 4; ++d0) { const bf16x8 kf = *(const LAS bf16x8*)(kcur + (sub * 32 + r32) * AT_KSTRIDE + (16 * d0 + 8 * hi) * 2); s = MFMA32(kf, qr[d0], s); }
                const unsigned wsh = (sub ? mw.y : mw.x) >> (4 * hi);
                float p[16];
#pragma unroll
                for (int r = 0; r < 16; ++r) { const int mk = __builtin_amdgcn_sbfe((int)wsh, (r & 3) + 8 * (r >> 2), 1);
                    p[r] = __uint_as_float(__float_as_uint(fexp2(s[r])) & (unsigned)mk); lsum += p[r]; }
                const v4u pa0 = {cvtpk(p[0], p[1]), cvtpk(p[2], p[3]), cvtpk(p[4], p[5]), cvtpk(p[6], p[7])}, pa1 = {cvtpk(p[8], p[9]), cvtpk(p[10], p[11]), cvtpk(p[12], p[13]), cvtpk(p[14], p[15])};
#pragma unroll
                for (int kk = 0; kk < 2; ++kk) { const int kg = 2 * sub + kk; const bf16x8 pa = __builtin_bit_cast(bf16x8, kk ? pa1 : pa0);
#pragma unroll
                    for (int dh = 0; dh < 2; ++dh) { const s16x4 lo = vtr(vcur + dh * 4096 + kg * 1024), hh = vtr(vcur + dh * 4096 + kg * 1024 + 512);
                        const bf16x8 vf = {lo[0], lo[1], lo[2], lo[3], hh[0], hh[1], hh[2], hh[3]};
                        if (dh == 0) o0 = MFMA32(pa, vf, o0); else o1 = MFMA32(pa, vf, o1); } }
            }
        }
        if (j + 1 < NT) { *(LAS v4u*)(kt + ((j + 1) & 1) * AT_KBYTES + kdst) = kreg; *(LAS v4u*)(vtb + ((j + 1) & 1) * AT_VBYTES + vdst) = vreg; }
        mw = mwn;
        __syncthreads();
    }
    lsum += __shfl_xor(lsum, 32);
    LAS float* lw = (LAS float*)(lds + AT_L_OFF) + wave * 32; LAS float* ost = (LAS float*)(lds + AT_OST_OFF) + wave * 32 * AT_OST_STRIDE;
    if (hi == 0) lw[r32] = lsum;
    LDS_WAIT();
#pragma unroll
    for (int r = 0; r < 16; ++r) { const int q = crow(r, hi); const float rl = frcp(lw[q]); ost[q * AT_OST_STRIDE + r32] = o0[r] * rl; ost[q * AT_OST_STRIDE + 32 + r32] = o1[r] * rl; }
    LDS_WAIT();
    { const int q = lane >> 1, hf = lane & 1; const LAS float* src = ost + q * AT_OST_STRIDE + hf * 32; const float* g = a.in[IN_ATTG] + h * 64 + hf * 32;
      float v[32], ss = 0.f;
#pragma unroll
      for (int i = 0; i < 8; ++i) { const f32x4 t = *(const LAS f32x4*)(src + 4 * i); v[4 * i] = t.x; v[4 * i + 1] = t.y; v[4 * i + 2] = t.z; v[4 * i + 3] = t.w; ss += (t.x * t.x + t.y * t.y) + (t.z * t.z + t.w * t.w); }
      ss += __shfl_xor(ss, 1);
      const float ri = frsq(ss * (1.f / 64.f) + EPS);
      bf16* dst = MIX + ((size_t)b * SEQ + qw + q) * 1024 + 512 + h * 64 + hf * 32;
#pragma unroll
      for (int i = 0; i < 4; ++i) { v4u w;
          w.x = cvtpk(v[8 * i] * ri * g[8 * i], v[8 * i + 1] * ri * g[8 * i + 1]); w.y = cvtpk(v[8 * i + 2] * ri * g[8 * i + 2], v[8 * i + 3] * ri * g[8 * i + 3]);
          w.z = cvtpk(v[8 * i + 4] * ri * g[8 * i + 4], v[8 * i + 5] * ri * g[8 * i + 5]); w.w = cvtpk(v[8 * i + 6] * ri * g[8 * i + 6], v[8 * i + 7] * ri * g[8 * i + 7]);
          *(GAS v4u*)(dst + 8 * i) = w; } }
    __syncthreads();
}

constexpr int HO_QSTRIDE = 272, HO_QBYTES = 64 * HO_QSTRIDE;
constexpr int HO_QD = 0, HO_KD = HO_QBYTES, HO_QE = 2 * HO_QBYTES, HO_VT = 3 * HO_QBYTES, HO_SEG = HO_VT + 128 * HL_STRIDE, HO_RB = HO_SEG + 2048, HO_OST = HO_RB + 512, HO_OSTRIDE = 132;
static_assert(HO_OST + 64 * HO_OSTRIDE * 4 <= RING_BYTES, "hgrn-out LDS");
__device__ __forceinline__ void hgrn_out_item(const Args& a, LAS unsigned char* lds, int item, int tid, int lane, int wave) {
    const int bh = item >> 7, c = item & 127, b = bh >> 2, h = bh & 3;
    const float* LF = (const float*)(a.ws + WS_LF); const bf16* VR = (const bf16*)(a.ws + WS_VR); const bf16* QR = (const bf16*)(a.ws + WS_QR); const bf16* GR = (const bf16*)(a.ws + WS_GR);
    const bf16* LSb = (const bf16*)(a.ws + WS_LS); bf16* MIX = (bf16*)(a.ws + WS_H);
    LAS unsigned short* qd = (LAS unsigned short*)(lds + HO_QD); LAS unsigned short* kd = (LAS unsigned short*)(lds + HO_KD); LAS unsigned short* qe = (LAS unsigned short*)(lds + HO_QE);
    LAS unsigned char* vt = lds + HO_VT; LAS float* seg = (LAS float*)(lds + HO_SEG); LAS float* rbuf = (LAS float*)(lds + HO_RB); LAS float* ost = (LAS float*)(lds + HO_OST);
    const int k = tid & 127, sg = tid >> 7;
    const size_t row0 = (size_t)b * SEQ + c * 64 + sg * 16;
    float lf[16], qq[16], vv[16];
#pragma unroll
    for (int j = 0; j < 16; ++j) { const size_t ix = (row0 + j) * 512 + h * 128 + k; lf[j] = LF[ix]; qq[j] = bf2f(QR[ix]); vv[j] = bf2f(VR[ix]); }
    float run = 0.f, bl[16];
#pragma unroll
    for (int j = 0; j < 16; ++j) { run += lf[j]; bl[j] = run; }
    seg[sg * 128 + k] = run;
    __syncthreads();
    float off = 0.f;
#pragma unroll
    for (int s = 0; s < 4; ++s) { const float x = seg[s * 128 + k]; if (s < sg) off += x; }
    if (sg == 1) rbuf[k] = off + bl[15];
    __syncthreads();
    const float rr = rbuf[k];
    { unsigned pv[8];
#pragma unroll
      for (int j = 0; j < 16; ++j) { const float bt = off + bl[j], e1 = fexp(bt - rr), e2 = fexp(rr - bt), kk = 1.f - fexp(lf[j]); const int t = sg * 16 + j;
          qd[t * (HO_QSTRIDE / 2) + k] = (unsigned short)(cvtpk(qq[j] * e1, 0.f) & 0xffffu); kd[t * (HO_QSTRIDE / 2) + k] = (unsigned short)(cvtpk(kk * e2, 0.f) & 0xffffu);
          qe[t * (HO_QSTRIDE / 2) + k] = (unsigned short)(cvtpk(qq[j] * fexp(bt), 0.f) & 0xffffu); }
#pragma unroll
      for (int j = 0; j < 8; ++j) pv[j] = cvtpk(vv[2 * j], vv[2 * j + 1]);
      *(LAS v4u*)(vt + k * HL_STRIDE + sg * 32) = (v4u){pv[0], pv[1], pv[2], pv[3]}; *(LAS v4u*)(vt + k * HL_STRIDE + sg * 32 + 16) = (v4u){pv[4], pv[5], pv[6], pv[7]}; }
    __syncthreads();
    { const int hi = lane >> 5, m = lane & 31, tt = wave >> 2, vti = wave & 3;
      f32x16 acc = {0.f, 0.f, 0.f, 0.f, 0.f, 0.f, 0.f, 0.f, 0.f, 0.f, 0.f, 0.f, 0.f, 0.f, 0.f, 0.f};
      const LAS unsigned char* qeb = lds + HO_QE + (32 * tt + m) * HO_QSTRIDE + 16 * hi;
      if (c > 0) {
          const bf16* sp = LSb + ((size_t)(item - 1) * 128 + 32 * vti + m) * 128 + 8 * hi;
#pragma unroll
          for (int ks = 0; ks < 8; ++ks) { const bf16x8 af = *(const LAS bf16x8*)(qeb + 32 * ks); const bf16x8 bfr = *(const GAS bf16x8*)(sp + 16 * ks); acc = MFMA32(af, bfr, acc); }
      }
      const LAS unsigned char* qdb = lds + HO_QD + (32 * tt + m) * HO_QSTRIDE + 16 * hi;
#pragma unroll
      for (int st = 0; st < 2; ++st) if (st <= tt) {
          f32x16 pt = {0.f, 0.f, 0.f, 0.f, 0.f, 0.f, 0.f, 0.f, 0.f, 0.f, 0.f, 0.f, 0.f, 0.f, 0.f, 0.f};
          const LAS unsigned char* kdb = lds + HO_KD + (32 * st + m) * HO_QSTRIDE + 16 * hi;
#pragma unroll
          for (int ks = 0; ks < 8; ++ks) { const bf16x8 af = *(const LAS bf16x8*)(kdb + 32 * ks); const bf16x8 bfr = *(const LAS bf16x8*)(qdb + 32 * ks); pt = MFMA32(af, bfr, pt); }
          float p[16];
#pragma unroll
          for (int r = 0; r < 16; ++r) { const int s = 32 * st + crow(r, hi), t = 32 * tt + m; p[r] = (s <= t) ? pt[r] : 0.f; }
          const v4u pa0 = {cvtpk(p[0], p[1]), cvtpk(p[2], p[3]), cvtpk(p[4], p[5]), cvtpk(p[6], p[7])}, pa1 = {cvtpk(p[8], p[9]), cvtpk(p[10], p[11]), cvtpk(p[12], p[13]), cvtpk(p[14], p[15])};
#pragma unroll
          for (int kk = 0; kk < 2; ++kk) { const LAS unsigned char* vp = vt + (32 * vti + m) * HL_STRIDE + (32 * st + 16 * kk + 4 * hi) * 2;
              const v2u lo = *(const LAS v2u*)(vp), hh = *(const LAS v2u*)(vp + 16);
              const v4u vw = {lo.x, lo.y, hh.x, hh.y};
              acc = MFMA32(__builtin_bit_cast(bf16x8, kk ? pa1 : pa0), __builtin_bit_cast(bf16x8, vw), acc); }
      }
#pragma unroll
      for (int r = 0; r < 16; ++r) ost[(32 * tt + crow(r, hi)) * HO_OSTRIDE + 32 * vti + m] = acc[r];
    }
    __syncthreads();
    { const int t = tid >> 3, s8 = tid & 7; const LAS float* src = ost + t * HO_OSTRIDE + s8 * 16; float v[16], ss = 0.f;
#pragma unroll
      for (int i = 0; i < 4; ++i) { const f32x4 x = *(const LAS f32x4*)(src + 4 * i); v[4 * i] = x.x; v[4 * i + 1] = x.y; v[4 * i + 2] = x.z; v[4 * i + 3] = x.w; ss += (x.x * x.x + x.y * x.y) + (x.z * x.z + x.w * x.w); }
      ss += __shfl_xor(ss, 1); ss += __shfl_xor(ss, 2); ss += __shfl_xor(ss, 4);
      const float ri = frsq(ss * (1.f / 128.f) + EPS);
      const size_t tok = (size_t)b * SEQ + c * 64 + t; const float* g = a.in[IN_RECG] + h * 128 + s8 * 16;
      const v4u g0 = *(const GAS v4u*)(GR + tok * 512 + h * 128 + s8 * 16), g1 = *(const GAS v4u*)(GR + tok * 512 + h * 128 + s8 * 16 + 8);
      const unsigned gw[8] = {g0.x, g0.y, g0.z, g0.w, g1.x, g1.y, g1.z, g1.w}; unsigned ow[8];
#pragma unroll
      for (int i = 0; i < 8; ++i) ow[i] = cvtpk(v[2 * i] * ri * g[2 * i] * bflo(gw[i]), v[2 * i + 1] * ri * g[2 * i + 1] * bfhi(gw[i]));
      bf16* dst = MIX + tok * 1024 + h * 128 + s8 * 16;
      *(GAS v4u*)dst = (v4u){ow[0], ow[1], ow[2], ow[3]}; *(GAS v4u*)(dst + 8) = (v4u){ow[4], ow[5], ow[6], ow[7]}; }
    __syncthreads();
}

struct EpiOutProj {
    static constexpr bool PERM = false, AFTER_DRAIN = false;
    const float* x; float* out; const float* modf;
    __device__ __forceinline__ void operator()(const pg8::f32x4 (&acc)[2][2][4][2], const pg8::Unit& u, int wr, int wc, int fr, int fq) const {
        const int row0 = u.pm * 256 + wr * 64 + fr, col0 = u.pn * 256 + wc * 32 + 4 * fq, b = u.pm >> 5;
        f32x4 gv[2][2];
#pragma unroll
        for (int bj = 0; bj < 2; ++bj)
#pragma unroll
            for (int n = 0; n < 2; ++n) gv[bj][n] = *(const f32x4*)(modf + b * 6144 + 2048 + col0 + bj * 128 + n * 16);
#pragma unroll
        for (int ai = 0; ai < 2; ++ai)
#pragma unroll
            for (int m = 0; m < 4; ++m) { const size_t off = (size_t)(row0 + ai * 128 + m * 16) * DM + col0;
#pragma unroll
                for (int bj = 0; bj < 2; ++bj)
#pragma unroll
                    for (int n = 0; n < 2; ++n) { const f32x4 xv = *(const GAS f32x4*)(x + off + bj * 128 + n * 16); *(GAS f32x4*)(out + off + bj * 128 + n * 16) = xv + gv[bj][n] * acc[ai][bj][m][n]; } }
    }
};

constexpr int RT_RW = 0, RT_A2 = 81920, RT_S2 = RT_A2 + 8192, RT_CNT = RT_S2 + 8192, RT_SCR = RT_CNT + 128;
__device__ __forceinline__ void load_mod2(const Args& a, LAS unsigned char* lds, int tid) {
    LAS float* A2 = (LAS float*)(lds + RT_A2); LAS float* S2 = (LAS float*)(lds + RT_S2);
    const float* modf = (const float*)(a.ws + WS_MODF); const float* g = a.in[IN_N2G];
    for (int idx = tid; idx < 2048; idx += 512) { const int b = idx >> 10, i = idx & 1023; A2[idx] = g[i] * (1.f + modf[b * 6144 + 4096 + i]); S2[idx] = modf[b * 6144 + 3072 + i]; }
}
__device__ __forceinline__ void phase7(const Args& a, LAS unsigned char* lds, int tid, int lane, int wave, int G) {
    LAS float* RW = (LAS float*)(lds + RT_RW); LAS float* A2 = (LAS float*)(lds + RT_A2); LAS float* S2 = (LAS float*)(lds + RT_S2); LAS unsigned* lcnt = (LAS unsigned*)(lds + RT_CNT);
    const float* wrg = a.in[IN_WRG]; const float* wre = a.in[IN_WRE];
    for (int idx = tid; idx < 1024 * 20; idx += 512) { const int i = idx / 20, n = idx % 20; RW[idx] = n < 4 ? wrg[i * 4 + n] : wre[i * 16 + (n - 4)]; }
    load_mod2(a, lds, tid);
    if (tid < 32) lcnt[tid] = 0u;
    __syncthreads();
    const int gw = blockIdx.x * NWAVES + wave, NGW = G * NWAVES;
    const float* x1 = a.out; f32x4* route = (f32x4*)(a.ws + WS_ROUTE);
    float bias[20];
#pragma unroll
    for (int n = 0; n < 20; ++n) bias[n] = n < 4 ? a.in[IN_BRG][n] : a.in[IN_BRE][n - 4];
    for (int m = gw; m < MTOK; m += NGW) {
        const int b = m >> 13; const float* xr = x1 + (size_t)m * DM + lane;
        float xv[16], ss = 0.f;
#pragma unroll
        for (int j = 0; j < 16; ++j) { xv[j] = xr[64 * j]; ss += xv[j] * xv[j]; }
        const float ri = frsq(wave_sum(ss) * (1.f / DM) + EPS);
        float lg[20];
#pragma unroll
        for (int n = 0; n < 20; ++n) lg[n] = 0.f;
#pragma unroll
        for (int j = 0; j < 16; ++j) { const int i = lane + 64 * j; const float h2 = xv[j] * ri * A2[b * 1024 + i] + S2[b * 1024 + i];
            const LAS f32x4* wr = (const LAS f32x4*)(RW + i * 20);
#pragma unroll
            for (int q = 0; q < 5; ++q) { const f32x4 w = wr[q]; lg[4 * q] += h2 * w.x; lg[4 * q + 1] += h2 * w.y; lg[4 * q + 2] += h2 * w.z; lg[4 * q + 3] += h2 * w.w; } }
#pragma unroll
        for (int n = 0; n < 20; ++n) lg[n] = wave_sum(lg[n]) + bias[n];
        int gt = 0; float gm = lg[0];
#pragma unroll
        for (int n = 1; n < 4; ++n) if (lg[n] > gm) { gm = lg[n]; gt = n; }
        float gs = 0.f;
#pragma unroll
        for (int n = 0; n < 4; ++n) gs += fexp(lg[n] - gm);
        const float gate = 1.f / gs;
        float e[4];
#pragma unroll
        for (int n = 0; n < 4; ++n) e[n] = gt == 0 ? lg[4 + n] : gt == 1 ? lg[8 + n] : gt == 2 ? lg[12 + n] : lg[16 + n];
        int j0 = 0; float v0 = e[0];
#pragma unroll
        for (int n = 1; n < 4; ++n) if (e[n] > v0) { v0 = e[n]; j0 = n; }
        int j1 = -1; float v1 = -3.0e38f;
#pragma unroll
        for (int n = 0; n < 4; ++n) if (n != j0 && e[n] > v1) { v1 = e[n]; j1 = n; }
        const float w0 = gate / (1.f + fexp(v1 - v0)), w1 = gate - w0;
        const int lo = j0 < j1 ? j0 : j1, hh = j0 < j1 ? j1 : j0; const float wlo = j0 < j1 ? w0 : w1, whi = j0 < j1 ? w1 : w0;
        const int pidx = lo == 0 ? hh - 1 : lo == 1 ? hh + 1 : 5;
        const int combo = gt * 6 + pidx;
        if (lane == 0) { route[m] = (f32x4){__int_as_float(combo), wlo, whi, ri}; __hip_atomic_fetch_add(lcnt + combo, 1u, __ATOMIC_RELAXED, __HIP_MEMORY_SCOPE_WORKGROUP); }
    }
    __syncthreads();
    if (tid < NCOMBO) { const unsigned c = lcnt[tid]; if (c) __hip_atomic_fetch_add((unsigned*)(a.ws + WS_CTL) + CW_CNT + tid, c, __ATOMIC_RELAXED, __HIP_MEMORY_SCOPE_AGENT); }
    __syncthreads();
    moe_weight_items(a, (LAS float*)(lds + wave * 16384), gw, NGW, lane);
}

constexpr int MB_BASE = MISC_OFF + 1024, MB_CNT = MB_BASE + 128, MB_NBLK = MB_CNT + 128, MB_BLK = MB_NBLK + 16;
__device__ __forceinline__ void build_buckets(const Args& a, LAS unsigned char* lds, int tid) {
    if (tid == 0) {
        LAS int* base = (LAS int*)(lds + MB_BASE); LAS int* cnt = (LAS int*)(lds + MB_CNT); LAS int* blk = (LAS int*)(lds + MB_BLK);
        const unsigned* gc = (const unsigned*)(a.ws + WS_CTL) + CW_CNT; int nb = 0;
        for (int c = 0; c < NCOMBO; ++c) { const int n = (int)__hip_atomic_load(gc + c, __ATOMIC_RELAXED, __HIP_MEMORY_SCOPE_AGENT); base[c] = nb * 256; cnt[c] = n;
            const int k = (n + 255) >> 8; for (int i = 0; i < k; ++i) blk[nb + i] = c; nb += k; }
        *(LAS int*)(lds + MB_NBLK) = nb;
    }
    __syncthreads();
}

__device__ __forceinline__ void phase8(const Args& a, LAS unsigned char* lds, int tid, int lane, int wave, int G) {
    load_mod2(a, lds, tid);
    build_buckets(a, lds, tid);
    LAS float* A2 = (LAS float*)(lds + RT_A2); LAS float* S2 = (LAS float*)(lds + RT_S2); const LAS int* base = (const LAS int*)(lds + MB_BASE);
    const int gw = blockIdx.x * NWAVES + wave, NGW = G * NWAVES;
    const float* x1 = a.out; const f32x4* route = (const f32x4*)(a.ws + WS_ROUTE); bf16* H2S = (bf16*)(a.ws + WS_H2S);
    int* stok = (int*)(a.ws + WS_STOK); f32x2* wsort = (f32x2*)(a.ws + WS_WSORT); unsigned* cur = (unsigned*)(a.ws + WS_CTL) + CW_CUR;
    for (int m = gw; m < MTOK; m += NGW) {
        const int b = m >> 13; const f32x4 rt = route[m]; const int combo = __float_as_int(rt.x);
        int pos = 0;
        if (lane == 0) { pos = base[combo] + (int)__hip_atomic_fetch_add(cur + combo, 1u, __ATOMIC_RELAXED, __HIP_MEMORY_SCOPE_AGENT); stok[pos] = m; wsort[pos] = (f32x2){rt.y, rt.z}; }
        pos = __builtin_amdgcn_readfirstlane(pos);
        const GAS f32x4* xr = (const GAS f32x4*)(x1 + (size_t)m * DM) + lane; GAS v2u* o8 = (GAS v2u*)(H2S + (size_t)pos * DM) + lane;
#pragma unroll
        for (int j = 0; j < 4; ++j) { const f32x4 v = xr[64 * j]; const f32x4 aa = *(LAS f32x4*)(A2 + b * 1024 + 256 * j + 4 * lane), ss = *(LAS f32x4*)(S2 + b * 1024 + 256 * j + 4 * lane);
            const f32x4 h = v * rt.w * aa + ss; v2u w; w.x = cvtpk(h.x, h.y); w.y = cvtpk(h.z, h.w); o8[64 * j] = w; }
    }
}

__device__ __forceinline__ void pair_of(int pidx, int& lo, int& hh) { lo = pidx < 3 ? 0 : pidx < 5 ? 1 : 2; hh = pidx < 3 ? pidx + 1 : pidx < 5 ? pidx - 1 : 3; }
struct MoeSched1 {
    const LAS int* blk; int nblk, G, c;
    __device__ __forceinline__ bool next(int i, pg8::Unit& u) const {
        const int L = i * G + c; if (L >= nblk * 8) return false;
        const int rb = L >> 3, nt = L & 7, cmb = blk[rb]; int lo, hh; pair_of(cmb % 6, lo, hh);
        const int e = (cmb / 6) * 4 + (nt < 4 ? lo : hh);
        u.pm = rb; u.pn = e * 4 + (nt & 3); u.aux = nt; u.cont = 0; return true;
    }
    __device__ __forceinline__ void a_ready(const pg8::Unit&) const {}
    __device__ __forceinline__ void done(const pg8::Unit&) const {}
};
struct EpiMoe1 {
    static constexpr bool PERM = true, AFTER_DRAIN = false;
    bf16* he; const f32x2* wsort;
    __device__ __forceinline__ void operator()(const pg8::f32x4 (&acc)[2][2][4][2], const pg8::Unit& u, int wr, int wc, int fr, int fq) const {
        const int slot = u.aux >> 2, jt = u.aux & 3, row0 = u.pm * 256 + wr * 64 + fr, col0 = jt * 128 + wc * 32 + 8 * fq;
        bf16* dst = he + (size_t)slot * NSROWS * 512;
#pragma unroll
        for (int ai = 0; ai < 2; ++ai)
#pragma unroll
            for (int m = 0; m < 4; ++m) { const int pos = row0 + ai * 128 + m * 16; const f32x2 wv = wsort[pos]; const float ws = slot ? wv.y : wv.x;
                const pg8::f32x4 a0 = acc[ai][0][m][0], a1 = acc[ai][0][m][1], b0 = acc[ai][1][m][0], b1 = acc[ai][1][m][1];
                v4u w; w.x = cvtpk(ws * silu_f(a0[0]) * b0[0], ws * silu_f(a0[1]) * b0[1]); w.y = cvtpk(ws * silu_f(a0[2]) * b0[2], ws * silu_f(a0[3]) * b0[3]);
                w.z = cvtpk(ws * silu_f(a1[0]) * b1[0], ws * silu_f(a1[1]) * b1[1]); w.w = cvtpk(ws * silu_f(a1[2]) * b1[2], ws * silu_f(a1[3]) * b1[3]);
                *(GAS v4u*)(dst + (size_t)pos * 512 + col0) = w; }
    }
};
struct MoeSched2 {
    const LAS int* blk; int nblk, G, c;
    __device__ __forceinline__ bool next(int i, pg8::Unit& u) const {
        const int L = (i >> 1) * G + c, sg = i & 1; if (L >= nblk * 4) return false;
        const int rb = L >> 2, nt = L & 3, cmb = blk[rb]; int lo, hh; pair_of(cmb % 6, lo, hh);
        const int e = (cmb / 6) * 4 + (sg ? hh : lo);
        u.pm = sg * NROWBLK + rb; u.pn = e * 4 + nt; u.aux = rb * 4 + nt; u.cont = sg ? 0 : 1; return true;
    }
    __device__ __forceinline__ void a_ready(const pg8::Unit&) const {}
    __device__ __forceinline__ void done(const pg8::Unit&) const {}
};
struct EpiMoe2 {
    static constexpr bool PERM = false, AFTER_DRAIN = false;
    float* out; const float* modf; const int* stok; const LAS int* blk; const LAS int* base; const LAS int* cnt;
    __device__ __forceinline__ void operator()(const pg8::f32x4 (&acc)[2][2][4][2], const pg8::Unit& u, int wr, int wc, int fr, int fq) const {
        const int rb = u.aux >> 2, nt = u.aux & 3, cmb = blk[rb], nvalid = cnt[cmb] - (rb * 256 - base[cmb]);
        const int col0 = nt * 256 + wc * 32 + 4 * fq;
#pragma unroll
        for (int ai = 0; ai < 2; ++ai)
#pragma unroll
            for (int m = 0; m < 4; ++m) { const int lr = ai * 128 + wr * 64 + m * 16 + fr;
                if (lr < nvalid) { const int tok = stok[rb * 256 + lr]; const float* gp = modf + (tok >> 13) * 6144 + 5120 + col0; float* op = out + (size_t)tok * DM + col0;
#pragma unroll
                    for (int bj = 0; bj < 2; ++bj)
#pragma unroll
                        for (int n = 0; n < 2; ++n) { const f32x4 g = *(const f32x4*)(gp + bj * 128 + n * 16); const f32x4 xv = *(const GAS f32x4*)(op + bj * 128 + n * 16);
                            *(GAS f32x4*)(op + bj * 128 + n * 16) = xv + g * acc[ai][bj][m][n]; } } }
    }
};

#ifndef MK_N_LAUNCHES
#define MK_N_LAUNCHES 1
#endif
__global__ void __launch_bounds__(NWAVES * 64, 2) fwd(Args a) {
    extern __shared__ __attribute__((aligned(16))) unsigned char lds_raw[];
    LAS unsigned char* lds = (LAS unsigned char*)lds_raw;
    const int tid = threadIdx.x, lane = tid & 63, wave = __builtin_amdgcn_readfirstlane(tid >> 6), G = gridDim.x;
    volatile LAS unsigned* MISC = (volatile LAS unsigned*)(lds + MISC_OFF);
    for (int u = tid; u < (LDS_BYTES - MISC_OFF) / 4; u += NWAVES * 64) ((LAS unsigned*)(lds + MISC_OFF))[u] = 0u;
    __syncthreads();
    unsigned* ctl = (unsigned*)(a.ws + WS_CTL);
    XcdBarrier bar; bar.bar = ctl + CW_BAR; bar.x = 0; bar.st = nullptr;
    const int lo = a.ph_lo, hi = a.ph_hi;
    if (hi - lo > 1) bar = xcd_barrier_post(ctl + CW_BAR, MISC + 8);
#define IN(k) (lo <= (k) && (k) < hi)
#define SEAM(k) do { if (IN(k) && IN((k) + 1)) xcd_barrier(bar); } while (0)

    if (IN(0)) { phase0(a, lds, tid, lane, wave, G); SEAM(0); }
    if (IN(1)) { phase1(a, lds, tid, lane, wave, G); SEAM(1); }
    if (IN(2)) {
        pg8::Gemm g{(const pg8::bf16_t*)(a.ws + WS_H), (const pg8::bf16_t*)(a.ws + WS_WIN), MTOK, NINP, DM}; pg8::StaticOrder S; S.init(MTOK, NINP, G, (int)blockIdx.x);
        EpiInProj E{a.ws, a.in[IN_LBL], a.in[IN_QG], a.in[IN_KG], a.in[IN_IKG], a.in[IN_IKB]};
        pg8::gemm_phase<EpiInProj, pg8::StaticOrder, true, true>(lds + RING_OFF, g, S, E);
        SEAM(2);
    }
    if (IN(3)) {
        for (int it = blockIdx.x; it < 256; it += G) { const int b = it >> 7, p = it & 127; idx_item(a, lds, b, p, tid, lane, wave); idx_item(a, lds, b, 255 - p, tid, lane, wave); }
        for (int it = blockIdx.x; it < 1024; it += G) hgrn_local_item(a, lds, it, tid, lane, wave);
        SEAM(3);
    }
    if (IN(4)) { phase4(a, tid, G); SEAM(4); }
    if (IN(5)) {
        for (int it = blockIdx.x; it < 256; it += G) { const int bh = it >> 4, s = it & 15; attn_item(a, lds, bh >> 3, bh & 7, s, tid, lane, wave); attn_item(a, lds, bh >> 3, bh & 7, 31 - s, tid, lane, wave); }
        for (int it = blockIdx.x; it < 1024; it += G) hgrn_out_item(a, lds, it, tid, lane, wave);
        SEAM(5);
    }
    if (IN(6)) {
        pg8::Gemm g{(const pg8::bf16_t*)(a.ws + WS_H), (const pg8::bf16_t*)(a.ws + WS_WOUT), MTOK, DM, DM}; pg8::StaticOrder S; S.init(MTOK, DM, G, (int)blockIdx.x);
        EpiOutProj E{a.in[IN_X], a.out, (const float*)(a.ws + WS_MODF)};
        pg8::gemm_phase<EpiOutProj, pg8::StaticOrder, false, true>(lds + RING_OFF, g, S, E);
        SEAM(6);
    }
    if (IN(7)) { phase7(a, lds, tid, lane, wave, G); SEAM(7); }
    if (IN(8)) { phase8(a, lds, tid, lane, wave, G); SEAM(8); }
    if (IN(9)) {
        build_buckets(a, lds, tid);
        pg8::Gemm g{(const pg8::bf16_t*)(a.ws + WS_H2S), (const pg8::bf16_t*)(a.ws + WS_W13), NSROWS, 16 * 1024, DM};
        MoeSched1 S{(const LAS int*)(lds + MB_BLK), *(const LAS int*)(lds + MB_NBLK), G, (int)blockIdx.x};
        EpiMoe1 E{(bf16*)(a.ws + WS_HE), (const f32x2*)(a.ws + WS_WSORT)};
        pg8::gemm_phase<EpiMoe1, MoeSched1, true, true>(lds + RING_OFF, g, S, E);
        SEAM(9);
    }
    if (IN(10)) {
        build_buckets(a, lds, tid);
        pg8::Gemm g{(const pg8::bf16_t*)(a.ws + WS_HE), (const pg8::bf16_t*)(a.ws + WS_W2), 2 * NSROWS, 16 * 1024, 512};
        MoeSched2 S{(const LAS int*)(lds + MB_BLK), *(const LAS int*)(lds + MB_NBLK), G, (int)blockIdx.x};
        EpiMoe2 E{a.out, (const float*)(a.ws + WS_MODF), (const int*)(a.ws + WS_STOK), (const LAS int*)(lds + MB_BLK), (const LAS int*)(lds + MB_BASE), (const LAS int*)(lds + MB_CNT)};
        pg8::gemm_phase<EpiMoe2, MoeSched2, false, true>(lds + RING_OFF, g, S, E);
    }
#undef IN
#undef SEAM
}

extern "C" void kernel_launch(void* const* d_in, const int* in_sizes, int n_in, void* d_out, int out_size, void* d_ws, size_t ws_size, hipStream_t stream) {
    static int grid = 0;
    if (grid == 0) {
        if (n_in != N_IN || in_sizes[0] != MTOK * DM || out_size != MTOK * DM || ws_size < WS_END) { fprintf(stderr, "kernel_launch: unexpected shapes (n_in %d, in0 %d, out %d, ws %zu); nothing launched\n", n_in, n_in > 0 ? in_sizes[0] : -1, out_size, ws_size); grid = -1; return; }
        int dev = 0, cus = 0, per_cu = 0;
        if (hipGetDevice(&dev) != hipSuccess || hipDeviceGetAttribute(&cus, hipDeviceAttributeMultiprocessorCount, dev) != hipSuccess) { grid = -1; return; }
        if (hipFuncSetAttribute((const void*)fwd, hipFuncAttributeMaxDynamicSharedMemorySize, LDS_BYTES) != hipSuccess) { fprintf(stderr, "kernel_launch: hipFuncSetAttribute failed\n"); grid = -1; return; }
        if (hipOccupancyMaxActiveBlocksPerMultiprocessor(&per_cu, (const void*)fwd, NWAVES * 64, LDS_BYTES) != hipSuccess || per_cu < 1) fprintf(stderr, "kernel_launch: occupancy query reports %d\n", per_cu);
        (void)hipGetLastError();
        grid = cus;
    }
    if (grid < 0) return;
    if (hipMemsetAsync((char*)d_ws + WS_CTL, 0, CTL_ZERO_BYTES, stream) != hipSuccess) return;
    Args a{};
    for (int i = 0; i < N_IN; ++i) a.in[i] = (const float*)d_in[i];
    a.out = (float*)d_out; a.ws = (unsigned char*)d_ws;
    constexpr int NL = MK_N_LAUNCHES;
    for (int li = 0; li < NL; ++li) {
        a.ph_lo = (NL == 1) ? 0 : li; a.ph_hi = (NL == 1) ? NPH : li + 1;
        hipLaunchKernelGGL(fwd, dim3(grid), dim3(NWAVES * 64), LDS_BYTES, stream, a);
        const hipError_t le = hipPeekAtLastError();
        if (le != hipSuccess) { fprintf(stderr, "kernel_launch: launch %d failed: %s\n", li, hipGetErrorName(le)); break; }
    }
}
```

```cpp
#include <hip/hip_runtime.h>
#include <cstdio>
#include <cstdint>
namespace pg8 {
#define PG8_LAS __attribute__((address_space(3)))
typedef unsigned short bf16_t;
typedef short bf16x8 __attribute__((ext_vector_type(8)));
typedef float f32x4 __attribute__((ext_vector_type(4)));
typedef unsigned u32x4 __attribute__((ext_vector_type(4)));
constexpr int BM = 256, BK = 64, HALF = 128, HTB = HALF * BK * 2  , STAGE_BYTES = 8 * HTB, NXCD = 8, WGM = 8;

__host__ __device__ __forceinline__ int lds_byte(int r, int c) { const int st = (r >> 4) * 2 + (c >> 5), rr = r & 15, cc = c & 31, ob = rr * 64 + cc * 2; return st * 1024 + (ob ^ (((ob >> 9) & 1) << 5)); }
__host__ __device__ __forceinline__ void stage_rc(int b, int& R, int& C) { const int st = b / 1024, sb = b % 1024, swz = sb ^ (((sb >> 9) & 1) << 5); R = (st >> 1) * 16 + swz / 64; C = (st & 1) * 32 + (swz % 64) / 2; }
__host__ __device__ __forceinline__ int perm32(int rho) { const int n = rho >> 4, i = rho & 15; return 8 * (i >> 2) + 4 * n + (i & 3); }

struct Unit { int pm, pn, aux, cont; };
struct Gemm { const bf16_t* A; const bf16_t* Bt; int M, N, K; };

struct StaticOrder {
    int nM, nN, nwg, G, c;
    __host__ __device__ void init(int M, int N, int G_, int c_) { nM = M / BM; nN = N / BM; nwg = nM * nN; G = G_; c = c_; }
    __host__ __device__ bool next(int i, Unit& u) const {
        const long L = (long)i * G + c; if (L >= nwg) return false;
        int wgid = (int)L; { const int q = nwg / NXCD, r = nwg % NXCD, xcd = wgid % NXCD, off = wgid / NXCD; wgid = (xcd < r ? xcd * (q + 1) : r * (q + 1) + (xcd - r) * q) + off; }
        const int nig = WGM * nN, gid = wgid / nig, fm = gid * WGM, gsz = (nM - fm) < WGM ? (nM - fm) : WGM;
        u.pm = fm + ((wgid % nig) % gsz); u.pn = (wgid % nig) / gsz; u.aux = 0; u.cont = 0; return true;
    }
    __device__ __forceinline__ void a_ready(const Unit&) const {}
    __device__ __forceinline__ void done(const Unit&) const {}
};

__device__ __forceinline__ unsigned cvt_pk_bf16(float lo, float hi) { unsigned r; asm volatile("v_cvt_pk_bf16_f32 %0, %1, %2" : "=v"(r) : "v"(lo), "v"(hi)); return r; }
typedef float f32x2 __attribute__((ext_vector_type(2)));

template <class Epi, class Sched, bool ALIGN_EPI = false, bool SP2 = false>
__device__ __forceinline__ void gemm_phase(PG8_LAS unsigned char* lds, const Gemm g, const Sched& S, const Epi& E) {
    const int tid = threadIdx.x, wid = __builtin_amdgcn_readfirstlane(tid >> 6), lane = tid & 63, wr = wid >> 2, wc = wid & 3, fr = lane & 15, fq = lane >> 4;
    const int K = g.K, nt = K / BK;
    unsigned voffA[2], voffB[2];
#pragma unroll
    for (int i = 0; i < 2; ++i) { int R, C; stage_rc(tid * 16 + i * 8192, R, C); const int Rb = Epi::PERM ? ((R & ~31) + perm32(R & 31)) : R;
        voffA[i] = (unsigned)(R * K + C) * 2u; voffB[i] = (unsigned)(Rb * K + C) * 2u; }
    const size_t kstep = (size_t)(BK * 2);
    const size_t hstep = (size_t)HALF * K * 2;
    const size_t tstep = 2 * hstep;
    const unsigned ldsw = (unsigned)wid * 1024u;
    const int aoff = lds_byte(wr * 64 + fr, fq * 8), boff = lds_byte(wc * 32 + fr, fq * 8);
#define PG8_SA(b, h) (((b) * 2 + (h)) * HTB)
#define PG8_SB(b, h) ((4 + (b) * 2 + (h)) * HTB)
#define PG8_STAGE(bufoff, gbase, voff) do { _Pragma("unroll") for (int _i = 0; _i < 2; ++_i) \
        __builtin_amdgcn_global_load_lds((const unsigned*)((const char*)(gbase) + (voff)[_i]), (PG8_LAS unsigned*)(lds + (bufoff) + ldsw + _i * 8192), 16, 0, 0); } while (0)
#define PG8_LDA(dst, b, h) do { _Pragma("unroll") for (int m = 0; m < 4; ++m) _Pragma("unroll") for (int k = 0; k < 2; ++k) dst[m][k] = *(const PG8_LAS bf16x8*)(lds + PG8_SA(b, h) + aoff + m * 2048 + k * 1024); } while (0)
#define PG8_LDB(dst, b, h) do { _Pragma("unroll") for (int n = 0; n < 2; ++n) _Pragma("unroll") for (int k = 0; k < 2; ++k) dst[n][k] = *(const PG8_LAS bf16x8*)(lds + PG8_SB(b, h) + boff + n * 2048 + k * 1024); } while (0)
#define PG8_MMA(ai, bj, At, Bt) do { __builtin_amdgcn_s_setprio(1); _Pragma("unroll") for (int m = 0; m < 4; ++m) _Pragma("unroll") for (int n = 0; n < 2; ++n) _Pragma("unroll") for (int k = 0; k < 2; ++k) \
        acc[ai][bj][m][n] = __builtin_amdgcn_mfma_f32_16x16x32_bf16(Bt[n][k], At[m][k], acc[ai][bj][m][n], 0, 0, 0); __builtin_amdgcn_s_setprio(0); } while (0)
#define PG8_WAIT_V(n) asm volatile("s_waitcnt vmcnt(" #n ")" ::: "memory")
#define PG8_WAIT_L(n) asm volatile("s_waitcnt lgkmcnt(" #n ")" ::: "memory")
#define PG8_BAR __builtin_amdgcn_s_barrier()
#define PG8_SCHED __builtin_amdgcn_sched_barrier(0)
    Unit cur, nxt; int ui = 0;
    if (!S.next(0, cur)) return;
    f32x4 acc[2][2][4][2];
#pragma unroll
    for (int a = 0; a < 2; ++a)
#pragma unroll
        for (int b = 0; b < 2; ++b)
#pragma unroll
            for (int m = 0; m < 4; ++m)
#pragma unroll
                for (int n = 0; n < 2; ++n) acc[a][b][m][n] = (f32x4){0.f, 0.f, 0.f, 0.f};
    bf16x8 At[4][2], B0[2][2], B1[2][2];
    const char* cA = (const char*)g.A + (size_t)cur.pm * tstep; const char* cB = (const char*)g.Bt + (size_t)cur.pn * tstep;
    S.a_ready(cur);
    if constexpr (SP2) {
        PG8_STAGE(PG8_SB(0, 0), cB, voffB); PG8_STAGE(PG8_SB(0, 1), cB + hstep, voffB); PG8_STAGE(PG8_SA(0, 0), cA, voffA); PG8_STAGE(PG8_SA(0, 1), cA + hstep, voffA);
        if (wr == 1) PG8_BAR;
        PG8_WAIT_V(2); PG8_BAR;
        PG8_STAGE(PG8_SB(1, 0), cB + kstep, voffB); PG8_STAGE(PG8_SA(1, 0), cA + kstep, voffA); PG8_STAGE(PG8_SB(1, 1), cB + hstep + kstep, voffB);
        PG8_WAIT_V(6); PG8_BAR;
    } else {
        PG8_STAGE(PG8_SB(0, 0), cB, voffB); PG8_STAGE(PG8_SA(0, 0), cA, voffA); PG8_STAGE(PG8_SB(0, 1), cB + hstep, voffB); PG8_STAGE(PG8_SA(0, 1), cA + hstep, voffA);
        if (wr == 1) PG8_BAR;
        PG8_WAIT_V(4); PG8_BAR;
        PG8_STAGE(PG8_SB(1, 0), cB + kstep, voffB); PG8_STAGE(PG8_SA(1, 0), cA + kstep, voffA); PG8_STAGE(PG8_SB(1, 1), cB + hstep + kstep, voffB);
        PG8_WAIT_V(6); PG8_BAR;
    }
    for (;;) {
        const bool has_next = S.next(ui + 1, nxt);
        const char* nA = has_next ? (const char*)g.A + (size_t)nxt.pm * tstep : cA; const char* nB = has_next ? (const char*)g.Bt + (size_t)nxt.pn * tstep : cB;
        for (int t = 0; t < nt; t += 2) {
            const bool last = (t == nt - 2);
            const char* a1 = cA + (size_t)(t + 1) * kstep;
            const char* a2 = last ? nA : cA + (size_t)(t + 2) * kstep; const char* b2 = last ? nB : cB + (size_t)(t + 2) * kstep;
            const char* a3 = a2 + kstep; const char* b3 = b2 + kstep;
            if (last && has_next) S.a_ready(nxt);
            if constexpr (SP2) {
            PG8_LDB(B0, 0, 0); PG8_LDB(B1, 0, 1); PG8_SCHED; PG8_LDA(At, 0, 0); PG8_STAGE(PG8_SA(1, 1), a1 + hstep, voffA);
            PG8_WAIT_V(8); PG8_WAIT_L(0); PG8_BAR; PG8_MMA(0, 0, At, B0); PG8_MMA(0, 1, At, B1); PG8_BAR; PG8_SCHED;
            PG8_LDA(At, 0, 1); PG8_STAGE(PG8_SB(0, 0), b2, voffB); PG8_STAGE(PG8_SB(0, 1), b2 + hstep, voffB); PG8_STAGE(PG8_SA(0, 0), a2, voffA);
            PG8_WAIT_V(8); PG8_WAIT_L(0); PG8_BAR; PG8_MMA(1, 0, At, B0); PG8_MMA(1, 1, At, B1); PG8_BAR; PG8_SCHED;
            PG8_LDB(B0, 1, 0); PG8_LDB(B1, 1, 1); PG8_SCHED; PG8_LDA(At, 1, 0); PG8_STAGE(PG8_SA(0, 1), a2 + hstep, voffA);
            PG8_WAIT_V(8); PG8_WAIT_L(0); PG8_BAR; PG8_MMA(0, 0, At, B0); PG8_MMA(0, 1, At, B1); PG8_BAR; PG8_SCHED;
            PG8_LDA(At, 1, 1); PG8_STAGE(PG8_SB(1, 0), b3, voffB); PG8_STAGE(PG8_SB(1, 1), b3 + hstep, voffB); PG8_STAGE(PG8_SA(1, 0), a3, voffA);
            PG8_WAIT_V(8); PG8_WAIT_L(0); PG8_BAR; PG8_MMA(1, 0, At, B0); PG8_MMA(1, 1, At, B1); PG8_BAR; PG8_SCHED;
            } else {
            PG8_LDB(B0, 0, 0); PG8_SCHED; PG8_LDA(At, 0, 0); PG8_STAGE(PG8_SA(1, 1), a1 + hstep, voffA);
            PG8_WAIT_L(8); PG8_BAR; PG8_WAIT_L(0); PG8_MMA(0, 0, At, B0); PG8_BAR; PG8_SCHED;
            PG8_LDB(B1, 0, 1); PG8_STAGE(PG8_SB(0, 0), b2, voffB);
            PG8_BAR; PG8_WAIT_L(0); PG8_MMA(0, 1, At, B1); PG8_BAR;
            PG8_LDA(At, 0, 1); PG8_STAGE(PG8_SA(0, 0), a2, voffA);
            PG8_BAR; PG8_WAIT_L(0); PG8_MMA(1, 0, At, B0); PG8_BAR; PG8_SCHED;
            PG8_STAGE(PG8_SB(0, 1), b2 + hstep, voffB);
            PG8_WAIT_V(6); PG8_BAR; PG8_MMA(1, 1, At, B1); PG8_BAR;
            PG8_LDB(B0, 1, 0); PG8_SCHED; PG8_LDA(At, 1, 0); PG8_STAGE(PG8_SA(0, 1), a2 + hstep, voffA);
            PG8_WAIT_L(8); PG8_BAR; PG8_WAIT_L(0); PG8_MMA(0, 0, At, B0); PG8_BAR; PG8_SCHED;
            PG8_LDB(B1, 1, 1); PG8_STAGE(PG8_SB(1, 0), b3, voffB);
            PG8_BAR; PG8_WAIT_L(0); PG8_MMA(0, 1, At, B1); PG8_BAR;
            PG8_LDA(At, 1, 1); PG8_STAGE(PG8_SA(1, 0), a3, voffA);
            PG8_BAR; PG8_WAIT_L(0); PG8_MMA(1, 0, At, B0); PG8_BAR; PG8_SCHED;
            PG8_STAGE(PG8_SB(1, 1), b3 + hstep, voffB);
            PG8_WAIT_V(6); PG8_BAR; PG8_MMA(1, 1, At, B1); PG8_BAR;
            }
        }
        if constexpr (ALIGN_EPI) { if (wr == 0) PG8_BAR; }
        if constexpr (!Epi::AFTER_DRAIN) { if (!cur.cont) E(acc, cur, wr, wc, fr, fq); S.done(cur); }
        if (!has_next) break;
        if (!cur.cont)
#pragma unroll
        for (int a = 0; a < 2; ++a)
#pragma unroll
            for (int b = 0; b < 2; ++b)
#pragma unroll
                for (int m = 0; m < 4; ++m)
#pragma unroll
                    for (int n = 0; n < 2; ++n) acc[a][b][m][n] = (f32x4){0.f, 0.f, 0.f, 0.f};
        cur = nxt; cA = nA; cB = nB; ++ui;
        if constexpr (ALIGN_EPI) { if (wr == 1) PG8_BAR; }
    }
    PG8_WAIT_V(0);
    if constexpr (!ALIGN_EPI) { if (wr == 0) PG8_BAR; }
    PG8_BAR;
    if constexpr (Epi::AFTER_DRAIN) { E.fused(acc, cur, wr, wc, fr, fq, lds, wid, lane); S.done(cur); }
#undef PG8_SA
#undef PG8_SB
#undef PG8_STAGE
#undef PG8_LDA
#undef PG8_LDB
#undef PG8_MMA
#undef PG8_WAIT_V
#undef PG8_WAIT_L
#undef PG8_BAR
#undef PG8_SCHED
}
}

#define GAS __attribute__((address_space(1)))
#define LAS __attribute__((address_space(3)))
typedef unsigned short bf16;
typedef unsigned v4u __attribute__((ext_vector_type(4)));
typedef float f32x4 __attribute__((ext_vector_type(4)));
typedef short bf16x8 __attribute__((ext_vector_type(8)));
typedef GAS unsigned gu32;
typedef GAS unsigned long long gu64;
#define RLX_AGENT __ATOMIC_RELAXED, __HIP_MEMORY_SCOPE_AGENT
#define LDS_WAIT() asm volatile("s_waitcnt lgkmcnt(0)" ::: "memory")
#define VM_WAIT() asm volatile("s_waitcnt vmcnt(0)" ::: "memory")
__device__ __forceinline__ unsigned long long rt() { return __builtin_amdgcn_s_memrealtime(); }
__device__ __forceinline__ unsigned f2bf(float f) { unsigned u = __builtin_bit_cast(unsigned, f); return (u + 0x7fffu + ((u >> 16) & 1u)) >> 16; }
__device__ __forceinline__ unsigned pk2(float lo, float hi) { return f2bf(lo) | (f2bf(hi) << 16); }

#define XB_TMO      128
#define XB_XCNT(j)  (256  + 64 * (j))
#define XB_XSUB(j)  (1280 + 64 * (j))
#define XB_XGEN(j)  (2304 + 64 * (j))
#define XB_TOP      3328
#define XB_TOPGEN   3392
#define XCD_BAR_WORDS 3456
#define XB_SPIN_CAP (1u << 18)

__device__ __forceinline__ unsigned xb_ld(unsigned* p)              { return __hip_atomic_load(p, __ATOMIC_RELAXED, __HIP_MEMORY_SCOPE_AGENT); }
__device__ __forceinline__ unsigned xb_add(unsigned* p, unsigned v) { return __hip_atomic_fetch_add(p, v, __ATOMIC_RELAXED, __HIP_MEMORY_SCOPE_AGENT); }
__device__ __forceinline__ unsigned xb_xcc_id() { return (unsigned)__builtin_amdgcn_s_getreg((3 << 11) | 20) & 0xFu; }
#define XB_SPIN(cond, bar) do { unsigned _sp = 0; while (cond) { __builtin_amdgcn_s_sleep(1); \
    if ((++_sp & 255u) == 0u) { if (xb_ld(&(bar)[XB_TMO])) break; if (_sp > XB_SPIN_CAP) { atomicAdd(&(bar)[XB_TMO], 1u); break; } } } } while (0)

struct XcdBarrier {
    unsigned* bar; unsigned x;
    volatile LAS unsigned* st;
};

__device__ __forceinline__ XcdBarrier xcd_barrier_post(unsigned* bar, volatile LAS unsigned* st) {
    XcdBarrier b; b.bar = bar; b.x = xb_xcc_id(); b.st = st;
    if (threadIdx.x == 0) (void)xb_add(&bar[XB_XCNT(b.x)], 1u);
    return b;
}
__device__ __forceinline__ void xcd_barrier_complete(unsigned* bar, unsigned x, unsigned& nloc, unsigned& nx) {
    const unsigned G = gridDim.x * gridDim.y * gridDim.z;
    unsigned sum, cnt, mine, sp = 0u;
    for (;;) {
        sum = 0u; cnt = 0u; mine = 0u;
#pragma unroll
        for (unsigned j = 0; j < 16; ++j) { const unsigned c = xb_ld(&bar[XB_XCNT(j)]); sum += c; cnt += (c > 0u) ? 1u : 0u; mine = (j == x) ? c : mine; }
        if (sum == G) break;
        __builtin_amdgcn_s_sleep(1);
        if ((++sp & 255u) == 0u) { if (xb_ld(&bar[XB_TMO])) break; if (sp > XB_SPIN_CAP) { atomicAdd(&bar[XB_TMO], 1u); break; } }
    }
    nloc = mine > 0u ? mine : 1u; nx = cnt > 0u ? cnt : 1u;
}

__device__ __forceinline__ void xcd_barrier(const XcdBarrier& b) {
    asm volatile("s_waitcnt vmcnt(0)" ::: "memory");
    __syncthreads();
    if (threadIdx.x == 0) {
        unsigned* bar = b.bar;
        __builtin_amdgcn_s_waitcnt(0);
        unsigned nloc = b.st[0], nx = b.st[1];
        if (nloc == 0u) { xcd_barrier_complete(bar, b.x, nloc, nx); b.st[0] = nloc; b.st[1] = nx; }
        const unsigned old = xb_add(&bar[XB_XSUB(b.x)], 1u);
        const unsigned gen = old / nloc;
        if (old + 1u == (gen + 1u) * nloc) {
            __builtin_amdgcn_fence(__ATOMIC_RELEASE, "agent");
            asm volatile("s_waitcnt vmcnt(0)" ::: "memory");
            const unsigned og = xb_add(&bar[XB_TOP], 1u);
            const unsigned tg = og / nx;
            if (og + 1u == (tg + 1u) * nx) xb_add(&bar[XB_TOPGEN], 1u);
            else XB_SPIN(xb_ld(&bar[XB_TOPGEN]) == tg, bar);
            __builtin_amdgcn_fence(__ATOMIC_ACQUIRE, "agent");
            xb_add(&bar[XB_XGEN(b.x)], 1u);
            asm volatile("s_waitcnt vmcnt(0)" ::: "memory");
        } else {
            XB_SPIN(xb_ld(&bar[XB_XGEN(b.x)]) == gen, bar);
            __builtin_amdgcn_fence(__ATOMIC_ACQUIRE, "agent");
            asm volatile("s_waitcnt vmcnt(0)" ::: "memory");
        }
    }
    __syncthreads();
}


#ifndef PROBE_REP
#define PROBE_REP -1
#endif
constexpr int NB = 2, SEQ = 8192, MTOK = NB * SEQ, DM = 1024, DIN = 4168, NINP = 4352;
constexpr int NCOMBO = 24, NROWBLK = 88, NSROWS = NROWBLK * 256;
constexpr float EPS = 1e-6f, LOG2E = 1.4426950408889634f, LN2 = 0.6931471805599453f, QSCALE = 0.125f * 1.4426950408889634f;
enum { IN_X = 0, IN_C, IN_WADA, IN_BADA, IN_N1G, IN_N2G, IN_WIN, IN_LBL, IN_RECG, IN_QG, IN_KG, IN_IKG, IN_IKB, IN_ATTG, IN_RELB, IN_WOUT, IN_WRG, IN_BRG, IN_WRE, IN_BRE, IN_W1, IN_W3, IN_W2, N_IN };

constexpr size_t MiB = 1u << 20;
constexpr size_t WS_CTL = 0, CTL_ZERO_BYTES = 1 * MiB;
constexpr size_t WS_MODP = 1 * MiB;
constexpr size_t WS_MODF = 1 * MiB + 512 * 1024;
constexpr size_t WS_WIN = 2 * MiB;
constexpr size_t WS_WOUT = 11 * MiB;
constexpr size_t WS_W13 = 13 * MiB;
constexpr size_t WS_W2 = 45 * MiB;
constexpr size_t WS_LS = 13 * MiB;
constexpr size_t WS_MASK = 45 * MiB;
constexpr size_t WS_H = 61 * MiB;
constexpr size_t WS_QR = 93 * MiB, WS_LF = 109 * MiB, WS_VR = 141 * MiB, WS_GR = 157 * MiB, WS_AQ = 173 * MiB, WS_AK = 189 * MiB, WS_AV = 205 * MiB, WS_IQ = 221 * MiB;
constexpr size_t WS_IK = 237 * MiB, WS_IW = 239 * MiB, WS_DEC = 239 * MiB + 512 * 1024;
constexpr size_t WS_ROUTE = 240 * MiB;
constexpr size_t WS_STOK = 241 * MiB;
constexpr size_t WS_WSORT = 242 * MiB;
constexpr size_t WS_H2S = 93 * MiB;
constexpr size_t WS_HE = 141 * MiB;
constexpr size_t WS_END = 256 * MiB;
static_assert(WS_H2S + (size_t)NSROWS * 1024 * 2 <= WS_HE && WS_HE + (size_t)NSROWS * 1024 * 2 <= WS_ROUTE && WS_WSORT + NSROWS * 8 <= WS_END, "ws map");
constexpr int CW_FAIL = 16;
constexpr int CW_BAR = 4096;
constexpr int CW_CNT = 8192, CW_CUR = 8192 + 64;

constexpr int RING_OFF = 0, RING_BYTES = 131072, MISC_OFF = 147456, LDS_BYTES = 163840;
constexpr int NWAVES = 8, NPH = 11;

typedef float f32x16 __attribute__((ext_vector_type(16)));
typedef float f32x2 __attribute__((ext_vector_type(2)));
typedef unsigned v2u __attribute__((ext_vector_type(2)));
typedef short v4i16_t __attribute__((ext_vector_type(4)));
typedef short s16x4 __attribute__((ext_vector_type(4)));

struct Args { const float* in[N_IN]; float* out; unsigned char* ws; int ph_lo, ph_hi; };

__device__ __forceinline__ float wave_sum(float v) {
#pragma unroll
    for (int o = 1; o < 64; o <<= 1) v += __shfl_xor(v, o);
    return v;
}
__device__ __forceinline__ float bf2f(unsigned short h) { return __uint_as_float((unsigned)h << 16); }
__device__ __forceinline__ float bflo(unsigned w) { return __uint_as_float(w << 16); }
__device__ __forceinline__ float bfhi(unsigned w) { return __uint_as_float(w & 0xffff0000u); }
__device__ __forceinline__ unsigned cvtpk(float lo, float hi) { unsigned r; asm volatile("v_cvt_pk_bf16_f32 %0, %1, %2" : "=v"(r) : "v"(lo), "v"(hi)); return r; }
__device__ __forceinline__ float fexp2(float x) { return __builtin_amdgcn_exp2f(x); }
__device__ __forceinline__ float fexp(float x) { return __builtin_amdgcn_exp2f(x * LOG2E); }
__device__ __forceinline__ float flog(float x) { return __builtin_amdgcn_logf(x) * LN2; }
__device__ __forceinline__ float frcp(float x) { return __builtin_amdgcn_rcpf(x); }
__device__ __forceinline__ float frsq(float x) { return __builtin_amdgcn_rsqf(x); }
__device__ __forceinline__ float silu_f(float v) { return v * frcp(1.f + fexp(-v)); }
__device__ __forceinline__ float sigm_f(float v) { return frcp(1.f + fexp(-v)); }
__device__ __forceinline__ int crow(int r, int hi) { return (r & 3) + 8 * (r >> 2) + 4 * hi; }
#define MFMA32(a, b, c) __builtin_amdgcn_mfma_f32_32x32x16_bf16((a), (b), (c), 0, 0, 0)

struct WinMap { __device__ __forceinline__ int operator()(int n) const {
    if (n < 2048) return n;
    if (n < 3072) { const int j = (n - 2048) & 511, seg = (n - 2048) >> 9, h = j >> 6, d = j & 63; return (8 + seg * 2 + (h >> 2)) * 256 + 128 * (d >> 5) + 32 * (h & 3) + (d & 31); }
    if (n < 4096) return n;
    if (n < 4160) { const int d = n - 4096; return 16 * 256 + 128 * (d >> 5) + (d & 31); }
    return 16 * 256 + 32 + (n - 4160); } };
struct OffMap { int off; __device__ __forceinline__ int operator()(int n) const { return off + n; } };
struct W13Map { int base; __device__ __forceinline__ int operator()(int n) const { return base + (n >> 7) * 256 + (n & 127); } };

template <class Map>
__device__ __forceinline__ void transpose_item(const float* W, int N, bf16* WT, int ldt, const Map map, LAS float* scr, int item, int lane) {
    const int nblk = (N + 31) / 32, kb = item / nblk, nb = item % nblk, k0 = 64 * kb, n0 = 32 * nb;
    const bool inb = (n0 + (lane & 31)) < N;
    float tv[32];
#pragma unroll
    for (int i = 0; i < 32; ++i) { const int kk = 2 * i + (lane >> 5); tv[i] = inb ? __builtin_nontemporal_load(W + (size_t)(k0 + kk) * N + n0 + (lane & 31)) : 0.f; }
#pragma unroll
    for (int i = 0; i < 32; ++i) { const int kk = 2 * i + (lane >> 5); scr[kk * 33 + (lane & 31)] = tv[i]; }
    LDS_WAIT(); asm volatile("" ::: "memory");
    const int c = lane & 7;
#pragma unroll
    for (int j = 0; j < 4; ++j) { const int n = (lane >> 3) + 8 * j; const LAS float* s = scr + (8 * c) * 33 + n;
        v4u o; o.x = pk2(s[0 * 33], s[1 * 33]); o.y = pk2(s[2 * 33], s[3 * 33]); o.z = pk2(s[4 * 33], s[5 * 33]); o.w = pk2(s[6 * 33], s[7 * 33]);
        if (n0 + n < N) *(GAS v4u*)(WT + (size_t)map(n0 + n) * ldt + k0 + 8 * c) = o; }
    LDS_WAIT(); asm volatile("" ::: "memory");
}

__device__ __forceinline__ void phase0(const Args& a, LAS unsigned char* lds, int tid, int lane, int wave, int G) {
    const float* wada = a.in[IN_WADA]; const float* cvec = a.in[IN_C]; float* modp = (float*)(a.ws + WS_MODP);
    for (int it = blockIdx.x; it < 192; it += G) {
        const int ks = it / 24, cg = it % 24, k0 = ks * 128 + wave * 16, col = cg * 256 + 4 * lane;
        f32x4 a0 = {0.f, 0.f, 0.f, 0.f}, a1 = {0.f, 0.f, 0.f, 0.f};
#pragma unroll 4
        for (int r = 0; r < 16; ++r) { const int k = k0 + r; const float s0 = silu_f(cvec[k]), s1 = silu_f(cvec[1024 + k]);
            const f32x4 w = *(const GAS f32x4*)(wada + (size_t)k * 6144 + col); a0 += w * s0; a1 += w * s1; }
        LAS float* red = (LAS float*)lds;
        *(LAS f32x4*)(red + wave * 512 + 4 * lane) = a0; *(LAS f32x4*)(red + wave * 512 + 256 + 4 * lane) = a1;
        __syncthreads();
        { float s = 0.f;
#pragma unroll
          for (int w = 0; w < 8; ++w) s += red[w * 512 + tid];
          const int b = tid >> 8, cc = tid & 255; modp[(size_t)(ks * 2 + b) * 6144 + cg * 256 + cc] = s; }
        __syncthreads();
    }
    LAS float* scr = (LAS float*)(lds + wave * 16384);
    const int gw = blockIdx.x * NWAVES + wave, NGW = G * NWAVES;
    constexpr int I_IN = 16 * 131, I_OUT = 16 * 32, I_Z = 256;
    bf16* win = (bf16*)(a.ws + WS_WIN); bf16* wout = (bf16*)(a.ws + WS_WOUT);
    for (int it = gw; it < I_IN + I_OUT + I_Z; it += NGW) {
        int r = it;
        if (r < I_IN) { transpose_item(a.in[IN_WIN], DIN, win, 1024, WinMap{}, scr, r, lane); continue; } r -= I_IN;
        if (r < I_OUT) { transpose_item(a.in[IN_WOUT], 1024, wout, 1024, OffMap{0}, scr, r, lane); continue; } r -= I_OUT;
        { const bool valid = (r < 40) || (r >= 128 && r < 160);
          if (!valid) { GAS v4u* p = (GAS v4u*)(win + (size_t)(16 * 256 + r) * 1024) + lane; const v4u z = {0u, 0u, 0u, 0u}; p[0] = z; p[64] = z; } }
    }
}

__device__ __forceinline__ void moe_weight_items(const Args& a, LAS float* scr, int gw, int NGW, int lane) {
    bf16* w13 = (bf16*)(a.ws + WS_W13); bf16* w2t = (bf16*)(a.ws + WS_W2);
    constexpr int I_1 = 16 * 16, I_2 = 8 * 32;
    for (int it = gw; it < 16 * (2 * I_1 + I_2); it += NGW) {
        const int e = it / (2 * I_1 + I_2); int r = it % (2 * I_1 + I_2);
        if (r < I_1) { transpose_item(a.in[IN_W1] + (size_t)e * 1024 * 512, 512, w13, 1024, W13Map{e * 1024}, scr, r, lane); continue; } r -= I_1;
        if (r < I_1) { transpose_item(a.in[IN_W3] + (size_t)e * 1024 * 512, 512, w13, 1024, W13Map{e * 1024 + 128}, scr, r, lane); continue; } r -= I_1;
        transpose_item(a.in[IN_W2] + (size_t)e * 512 * 1024, 1024, w2t, 512, OffMap{e * 1024}, scr, r, lane);
    }
}

__device__ __forceinline__ void phase1(const Args& a, LAS unsigned char* lds, int tid, int lane, int wave, int G) {
    LAS float* A1 = (LAS float*)lds; LAS float* S1 = A1 + 2048;
    const float* modp = (const float*)(a.ws + WS_MODP); const float* bada = a.in[IN_BADA]; const float* g = a.in[IN_N1G];
    for (int idx = tid; idx < 2048; idx += 512) { const int b = idx >> 10, i = idx & 1023; float sh = bada[i], sc = bada[1024 + i];
#pragma unroll
        for (int ks = 0; ks < 8; ++ks) { sh += modp[(size_t)(ks * 2 + b) * 6144 + i]; sc += modp[(size_t)(ks * 2 + b) * 6144 + 1024 + i]; }
        A1[idx] = g[i] * (1.f + sc); S1[idx] = sh; }
    float* modf = (float*)(a.ws + WS_MODF);
    for (int idx = blockIdx.x * 512 + tid; idx < 12288; idx += G * 512) { const int b = idx / 6144, j = idx % 6144; float s = bada[j];
#pragma unroll
        for (int ks = 0; ks < 8; ++ks) s += modp[(size_t)(ks * 2 + b) * 6144 + j];
        modf[idx] = s; }
    __syncthreads();
    const int gw = blockIdx.x * NWAVES + wave, NGW = G * NWAVES;
    const float* x = a.in[IN_X]; bf16* H = (bf16*)(a.ws + WS_H);
    for (int m = gw; m < MTOK; m += NGW) {
        const int b = m >> 13; const GAS f32x4* xr = (const GAS f32x4*)(x + (size_t)m * DM) + lane;
        f32x4 v[4]; float s = 0.f;
#pragma unroll
        for (int j = 0; j < 4; ++j) { v[j] = xr[64 * j]; s += (v[j].x * v[j].x + v[j].y * v[j].y) + (v[j].z * v[j].z + v[j].w * v[j].w); }
        const float r = frsq(wave_sum(s) * (1.f / DM) + EPS);
        GAS v2u* o8 = (GAS v2u*)(H + (size_t)m * DM) + lane;
#pragma unroll
        for (int j = 0; j < 4; ++j) { const f32x4 aa = *(LAS f32x4*)(A1 + b * 1024 + 256 * j + 4 * lane), ss = *(LAS f32x4*)(S1 + b * 1024 + 256 * j + 4 * lane);
            const f32x4 h = v[j] * r * aa + ss; v2u w; w.x = cvtpk(h.x, h.y); w.y = cvtpk(h.z, h.w); o8[64 * j] = w; }
    }
}

struct EpiInProj {
    static constexpr bool PERM = true, AFTER_DRAIN = false;
    unsigned char* ws; const float *lbl, *qg, *kg, *ikg, *ikb;
    __device__ __forceinline__ void operator()(const pg8::f32x4 (&acc)[2][2][4][2], const pg8::Unit& u, int wr, int wc, int fr, int fq) const {
        const int pn = u.pn, row0 = u.pm * 256 + wr * 64 + fr;
        if (pn < 2 || (pn >= 4 && pn < 8) || (pn >= 12 && pn < 16)) {
            size_t off; int ct; bool act;
            if (pn < 2) { off = WS_QR; ct = pn; act = true; } else if (pn < 6) { off = WS_VR; ct = pn - 4; act = false; } else if (pn < 8) { off = WS_GR; ct = pn - 6; act = true; }
            else if (pn < 14) { off = WS_AV; ct = pn - 12; act = false; } else { off = WS_IQ; ct = pn - 14; act = false; }
            bf16* dst = (bf16*)(ws + off); const int col0 = ct * 256 + wc * 32 + 8 * fq;
#pragma unroll
            for (int ai = 0; ai < 2; ++ai)
#pragma unroll
                for (int m = 0; m < 4; ++m) { bf16* rowp = dst + (size_t)(row0 + ai * 128 + m * 16) * 512 + col0;
#pragma unroll
                    for (int bj = 0; bj < 2; ++bj) { pg8::f32x4 v0 = acc[ai][bj][m][0], v1 = acc[ai][bj][m][1];
                        if (act) { v0 = (pg8::f32x4){silu_f(v0[0]), silu_f(v0[1]), silu_f(v0[2]), silu_f(v0[3])}; v1 = (pg8::f32x4){silu_f(v1[0]), silu_f(v1[1]), silu_f(v1[2]), silu_f(v1[3])}; }
                        v4u w; w.x = cvtpk(v0[0], v0[1]); w.y = cvtpk(v0[2], v0[3]); w.z = cvtpk(v1[0], v1[1]); w.w = cvtpk(v1[2], v1[3]);
                        *(GAS v4u*)(rowp + bj * 128) = w; } }
        } else if (pn < 4) {
            float* dst = (float*)(ws + WS_LF); const int col0 = (pn - 2) * 256 + wc * 32 + 8 * fq;
            float lb[2][8];
#pragma unroll
            for (int bj = 0; bj < 2; ++bj)
#pragma unroll
                for (int j = 0; j < 8; ++j) { const int c = col0 + bj * 128 + j; lb[bj][j] = frcp(1.f + fexp(lbl[512 + c] - lbl[c])); }
#pragma unroll
            for (int ai = 0; ai < 2; ++ai)
#pragma unroll
                for (int m = 0; m < 4; ++m) { float* rowp = dst + (size_t)(row0 + ai * 128 + m * 16) * 512 + col0;
#pragma unroll
                    for (int bj = 0; bj < 2; ++bj) { f32x4 o0, o1;
#pragma unroll
                        for (int j = 0; j < 4; ++j) { const float l0 = lb[bj][j], l1 = lb[bj][4 + j];
                            o0[j] = flog(l0 + (1.f - l0) * sigm_f(acc[ai][bj][m][0][j])); o1[j] = flog(l1 + (1.f - l1) * sigm_f(acc[ai][bj][m][1][j])); }
                        *(GAS f32x4*)(rowp + bj * 128) = o0; *(GAS f32x4*)(rowp + bj * 128 + 4) = o1; } }
        } else if (pn < 12) {
            const int seg = (pn - 8) >> 1, head = ((pn - 8) & 1) * 4 + wc; const float* gs = seg ? kg : qg; const float sc = seg ? 1.f : QSCALE;
            bf16* dst = (bf16*)(ws + (seg ? WS_AK : WS_AQ));
            f32x4 gv[2][2];
#pragma unroll
            for (int bj = 0; bj < 2; ++bj)
#pragma unroll
                for (int n = 0; n < 2; ++n) gv[bj][n] = *(const f32x4*)(gs + 32 * bj + 8 * fq + 4 * n) * sc;
#pragma unroll
            for (int ai = 0; ai < 2; ++ai)
#pragma unroll
                for (int m = 0; m < 4; ++m) { float ss = 0.f;
#pragma unroll
                    for (int bj = 0; bj < 2; ++bj)
#pragma unroll
                        for (int n = 0; n < 2; ++n) { const pg8::f32x4 v = acc[ai][bj][m][n]; ss += (v[0] * v[0] + v[1] * v[1]) + (v[2] * v[2] + v[3] * v[3]); }
                    ss += __shfl_xor(ss, 16); ss += __shfl_xor(ss, 32);
                    const float ri = frsq(ss * (1.f / 64.f) + EPS);
                    bf16* rowp = dst + (size_t)(row0 + ai * 128 + m * 16) * 512 + head * 64 + 8 * fq;
#pragma unroll
                    for (int bj = 0; bj < 2; ++bj) { const f32x4 v0 = acc[ai][bj][m][0] * ri * gv[bj][0], v1 = acc[ai][bj][m][1] * ri * gv[bj][1];
                        v4u w; w.x = cvtpk(v0[0], v0[1]); w.y = cvtpk(v0[2], v0[3]); w.z = cvtpk(v1[0], v1[1]); w.w = cvtpk(v1[2], v1[3]);
                        *(GAS v4u*)(rowp + bj * 32) = w; } }
        } else {
            if (wc == 0) {
                bf16* dst = (bf16*)(ws + WS_IK); f32x4 gv[2][2], bv[2][2];
#pragma unroll
                for (int bj = 0; bj < 2; ++bj)
#pragma unroll
                    for (int n = 0; n < 2; ++n) { gv[bj][n] = *(const f32x4*)(ikg + 32 * bj + 8 * fq + 4 * n); bv[bj][n] = *(const f32x4*)(ikb + 32 * bj + 8 * fq + 4 * n); }
#pragma unroll
                for (int ai = 0; ai < 2; ++ai)
#pragma unroll
                    for (int m = 0; m < 4; ++m) { float s = 0.f;
#pragma unroll
                        for (int bj = 0; bj < 2; ++bj)
#pragma unroll
                            for (int n = 0; n < 2; ++n) { const pg8::f32x4 v = acc[ai][bj][m][n]; s += (v[0] + v[1]) + (v[2] + v[3]); }
                        s += __shfl_xor(s, 16); s += __shfl_xor(s, 32);
                        const float mu = s * (1.f / 64.f); float q = 0.f;
#pragma unroll
                        for (int bj = 0; bj < 2; ++bj)
#pragma unroll
                            for (int n = 0; n < 2; ++n) { const pg8::f32x4 d = acc[ai][bj][m][n] - mu; q += (d[0] * d[0] + d[1] * d[1]) + (d[2] * d[2] + d[3] * d[3]); }
                        q += __shfl_xor(q, 16); q += __shfl_xor(q, 32);
                        const float rs = frsq(q * (1.f / 64.f) + EPS);
                        bf16* rowp = dst + (size_t)(row0 + ai * 128 + m * 16) * 64 + 8 * fq;
#pragma unroll
                        for (int bj = 0; bj < 2; ++bj) { const f32x4 v0 = (acc[ai][bj][m][0] - mu) * rs * gv[bj][0] + bv[bj][0], v1 = (acc[ai][bj][m][1] - mu) * rs * gv[bj][1] + bv[bj][1];
                            v4u w; w.x = cvtpk(v0[0], v0[1]); w.y = cvtpk(v0[2], v0[3]); w.z = cvtpk(v1[0], v1[1]); w.w = cvtpk(v1[2], v1[3]);
                            *(GAS v4u*)(rowp + bj * 32) = w; } }
            } else if (wc == 1 && fq == 0) {
                float* dst = (float*)(ws + WS_IW);
#pragma unroll
                for (int ai = 0; ai < 2; ++ai)
#pragma unroll
                    for (int m = 0; m < 4; ++m) { float* rowp = dst + (size_t)(row0 + ai * 128 + m * 16) * 8;
                        *(GAS f32x4*)(rowp) = acc[ai][0][m][0] * 0.35355339059327373f; *(GAS f32x4*)(rowp + 4) = acc[ai][0][m][1] * 0.35355339059327373f; }
            }
        }
    }
};

constexpr int IDX_CAP = 768, IDX_KT_STRIDE = 144, IDX_STG = 128, IDX_KT_BYTES = IDX_STG * IDX_KT_STRIDE;
constexpr int IDX_CAND_OFF = 0, IDX_KT_OFF = NWAVES * 4 * IDX_CAP * 4, IDX_HIST_OFF = IDX_KT_OFF + 2 * IDX_KT_BYTES, IDX_DUM_OFF = IDX_HIST_OFF + NWAVES * 1024, IDX_FLAG_OFF = IDX_DUM_OFF + NWAVES * 256;
constexpr int IDX_PRMIN = 448;
static_assert(IDX_FLAG_OFF + 16 <= MISC_OFF, "indexer LDS");

__device__ __forceinline__ unsigned mono_pack(float s, int kidx) {
    const unsigned u = __float_as_uint(s); const unsigned m = u ^ ((unsigned)((int)u >> 31) | 0x80000000u);
    return (m & 0xFFFFE000u) | (unsigned)(8191 - kidx);
}
__device__ __forceinline__ int lane_prefix(unsigned long long bal) { return __builtin_amdgcn_mbcnt_hi((unsigned)(bal >> 32), __builtin_amdgcn_mbcnt_lo((unsigned)bal, 0u)); }
#define DPP_STEP(v, ctrl, rm) __builtin_amdgcn_update_dpp(0, (int)(v), (ctrl), (rm), 0xf, false)
__device__ __forceinline__ int scan_add(int v) {
    v += DPP_STEP(v, 0x111, 0xf); v += DPP_STEP(v, 0x112, 0xf); v += DPP_STEP(v, 0x114, 0xf); v += DPP_STEP(v, 0x118, 0xf); v += DPP_STEP(v, 0x142, 0xa); v += DPP_STEP(v, 0x143, 0xc); return v;
}
__device__ __forceinline__ unsigned umax2(unsigned a, unsigned b) { return a > b ? a : b; }
__device__ __forceinline__ unsigned wave_max_u(unsigned v) {
    v = umax2(v, (unsigned)DPP_STEP(v, 0x111, 0xf)); v = umax2(v, (unsigned)DPP_STEP(v, 0x112, 0xf)); v = umax2(v, (unsigned)DPP_STEP(v, 0x114, 0xf)); v = umax2(v, (unsigned)DPP_STEP(v, 0x118, 0xf));
    v = umax2(v, (unsigned)DPP_STEP(v, 0x142, 0xa)); v = umax2(v, (unsigned)DPP_STEP(v, 0x143, 0xc)); return (unsigned)__builtin_amdgcn_readlane((int)v, 63);
}

__device__ __forceinline__ unsigned idx_prune(LAS unsigned* buf, int cnt, LAS unsigned* hist, int lane) {
    constexpr int NV = IDX_CAP / 64; unsigned v[NV]; unsigned mx = 0u, mnc = 0u;
#pragma unroll
    for (int j = 0; j < NV; ++j) { const int idx = j * 64 + lane; const bool ok = idx < cnt; v[j] = ok ? buf[idx] : 0u; mx = umax2(mx, v[j]); mnc = umax2(mnc, ok ? ~v[j] : 0u); }
    mx = wave_max_u(mx); const unsigned mn = ~wave_max_u(mnc);
    unsigned lo = mn, wm1 = mx - mn;
    int sh = 24 - __clz((int)(wm1 | 1u)); sh = sh < 0 ? 0 : sh;
    int need = 256; unsigned T = 0u;
    for (int pass = 0; pass < 5; ++pass) {
        *(LAS v4u*)(hist + 4 * lane) = (v4u){0u, 0u, 0u, 0u};
        LDS_WAIT();
#pragma unroll
        for (int j = 0; j < NV; ++j) { const unsigned d = v[j] - lo; if ((j * 64 + lane) < cnt && d <= wm1) __hip_atomic_fetch_add(hist + (d >> sh), 1u, __ATOMIC_RELAXED, __HIP_MEMORY_SCOPE_WORKGROUP); }
        LDS_WAIT();
        const v4u h4 = *(const LAS v4u*)(hist + 4 * lane);
        const int s4 = (int)(h4.x + h4.y + h4.z + h4.w), P = scan_add(s4), tot = __builtin_amdgcn_readlane(P, 63);
        const int S = tot - P + s4;
        const unsigned long long bal = __ballot(S >= need);
        const int Ls = 63 - __clzll((long long)bal);
        const int Sab = __builtin_amdgcn_readlane(S - s4, Ls);
        const int h0 = __builtin_amdgcn_readlane((int)h4.x, Ls), h1 = __builtin_amdgcn_readlane((int)h4.y, Ls), h2 = __builtin_amdgcn_readlane((int)h4.z, Ls), h3 = __builtin_amdgcn_readlane((int)h4.w, Ls);
        int above = Sab, B = 3, nB = h3;
        if (above + h3 < need) { above += h3; B = 2; nB = h2; if (above + h2 < need) { above += h2; B = 1; nB = h1; if (above + h1 < need) { above += h1; B = 0; nB = h0; } } }
        const unsigned edge = lo + ((unsigned)(4 * Ls + B) << sh);
        need -= above;
        T = edge;
        if (nB == need || sh == 0) break;
        lo = edge; wm1 = (1u << sh) - 1u; sh = sh > 8 ? sh - 8 : 0;
    }
    int base = 0;
#pragma unroll
    for (int j = 0; j < NV; ++j) { const bool p = ((j * 64 + lane) < cnt) && v[j] >= T; const unsigned long long bal = __ballot(p); const int pre = lane_prefix(bal);
        if (p) buf[base + pre] = v[j]; base += __popcll(bal); }
    LDS_WAIT();
    return T;
}

template <bool DRY>
__device__ __forceinline__ void idx_item(const Args& a, LAS unsigned char* lds, int b, int qblk, int tid, int lane, int wave) {
    const bf16* IQ = (const bf16*)(a.ws + WS_IQ); const bf16* IK = (const bf16*)(a.ws + WS_IK); const float* IW = (const float*)(a.ws + WS_IW); unsigned* MASK = (unsigned*)(a.ws + WS_MASK);
    const int t0 = qblk * 32 + wave * 4, nkeys = ((qblk >> 1) + 1) * 64, nst = (nkeys + IDX_STG - 1) / IDX_STG;
    const int hi = lane >> 5, m = lane & 31;
    bf16x8 af[4];
    { const int qa = 2 * ((m >> 2) & 1) + ((m >> 4) & 1), ha = 4 * ((m >> 3) & 1) + (m & 3); const size_t tok = (size_t)b * SEQ + t0 + qa;
      const float wsc = IW[tok * 8 + ha] * 0.125f;
#pragma unroll
      for (int ks = 0; ks < 4; ++ks) { const v4u raw = *(const GAS v4u*)(IQ + tok * 512 + ha * 64 + 16 * ks + 8 * hi); v4u o;
          o.x = cvtpk(bflo(raw.x) * wsc, bfhi(raw.x) * wsc); o.y = cvtpk(bflo(raw.y) * wsc, bfhi(raw.y) * wsc); o.z = cvtpk(bflo(raw.z) * wsc, bfhi(raw.z) * wsc); o.w = cvtpk(bflo(raw.w) * wsc, bfhi(raw.w) * wsc);
          af[ks] = __builtin_bit_cast(bf16x8, o); } }
    float cinf[16];
#pragma unroll
    for (int i = 0; i < 16; ++i) { const float w = IW[((size_t)b * SEQ + t0 + 2 * hi + (i >> 3)) * 8 + (i & 7)]; cinf[i] = w >= 0.f ? __builtin_inff() : -__builtin_inff(); }
    LAS unsigned* cb = (LAS unsigned*)(lds + IDX_CAND_OFF) + wave * 4 * IDX_CAP;
    LAS unsigned* cb0 = cb + (2 * hi) * IDX_CAP; LAS unsigned* cb1 = cb0 + IDX_CAP;
    LAS unsigned* hist = (LAS unsigned*)(lds + IDX_HIST_OFF) + wave * 256;
    LAS unsigned* dum = (LAS unsigned*)(lds + IDX_DUM_OFF) + wave * 64 + lane;
    int cnt0 = 0, cnt1 = 0; unsigned thr0 = DRY ? 0xffffffffu : 0u, thr1 = thr0;
    const unsigned himask = hi ? 0xffffffffu : 0u;
    const int skey = tid >> 3, sch = tid & 7;
    const bf16* ksrc = IK + ((size_t)b * SEQ + skey) * 64 + sch * 8;
    LAS unsigned char* kt = lds + IDX_KT_OFF; const int kdst = skey * IDX_KT_STRIDE + sch * 16;
    v4u kreg0 = *(const GAS v4u*)ksrc, kreg1 = kreg0;
    if (nkeys > 64) kreg1 = *(const GAS v4u*)(ksrc + 64 * 64);
    *(LAS v4u*)(kt + kdst) = kreg0; *(LAS v4u*)(kt + kdst + 64 * IDX_KT_STRIDE) = kreg1;
    __syncthreads();
    LAS unsigned* pflag = (LAS unsigned*)(lds + IDX_FLAG_OFF);
    if (tid < 3) pflag[tid] = 0u;
    __syncthreads();
#define IDX_MMA(accv, sub) do { accv = (f32x16){0.f, 0.f, 0.f, 0.f, 0.f, 0.f, 0.f, 0.f, 0.f, 0.f, 0.f, 0.f, 0.f, 0.f, 0.f, 0.f}; \
        _Pragma("unroll") for (int ks = 0; ks < 4; ++ks) { const bf16x8 bfr = *(const LAS bf16x8*)(kcur + (sub) * 32 * IDX_KT_STRIDE + 32 * ks); accv = MFMA32(af[ks], bfr, accv); } } while (0)
#define IDX_VALU(accv, sub) do { float s0 = 0.f, s1 = 0.f; \
        _Pragma("unroll") for (int j = 0; j < 8; ++j) { s0 += __builtin_amdgcn_fmed3f(accv[j], 0.f, cinf[j]); s1 += __builtin_amdgcn_fmed3f(accv[8 + j], 0.f, cinf[8 + j]); } \
        const int kidx = kbase + (sub) * 32 + m; const unsigned p0 = mono_pack(s0, kidx), p1 = mono_pack(s1, kidx); \
        { const bool ps = p0 > thr0; const unsigned long long bal = __ballot(ps); const unsigned lo = (unsigned)bal, hh = (unsigned)(bal >> 32); \
          const int pre = (int)__builtin_amdgcn_mbcnt_hi(hh, __builtin_amdgcn_mbcnt_lo(lo, 0u)) - (int)((unsigned)__popc(lo) & himask); \
          LAS unsigned* dst = ps ? (cb0 + cnt0 + pre) : dum; *dst = p0; cnt0 += hi ? __popc(hh) : __popc(lo); } \
        { const bool ps = p1 > thr1; const unsigned long long bal = __ballot(ps); const unsigned lo = (unsigned)bal, hh = (unsigned)(bal >> 32); \
          const int pre = (int)__builtin_amdgcn_mbcnt_hi(hh, __builtin_amdgcn_mbcnt_lo(lo, 0u)) - (int)((unsigned)__popc(lo) & himask); \
          LAS unsigned* dst = ps ? (cb1 + cnt1 + pre) : dum; *dst = p1; cnt1 += hi ? __popc(hh) : __popc(lo); } } while (0)
    for (int st = 0; st < nst; ++st) {
        const int kbase = st * IDX_STG; const bool full = (nkeys - kbase) >= IDX_STG;
        if (st + 1 < nst) { kreg0 = *(const GAS v4u*)(ksrc + (size_t)(kbase + IDX_STG) * 64); if (nkeys - kbase - IDX_STG > 64) kreg1 = *(const GAS v4u*)(ksrc + (size_t)(kbase + IDX_STG + 64) * 64); }
        const LAS unsigned char* kcur = kt + (st & 1) * IDX_KT_BYTES + m * IDX_KT_STRIDE + 16 * hi;
        f32x16 accA, accB;
        IDX_MMA(accA, 0);
        IDX_MMA(accB, 1); __builtin_amdgcn_sched_barrier(0);
        IDX_VALU(accA, 0); __builtin_amdgcn_sched_barrier(0);
        if (full) {
            IDX_MMA(accA, 2); __builtin_amdgcn_sched_barrier(0);
            IDX_VALU(accB, 1); __builtin_amdgcn_sched_barrier(0);
            IDX_MMA(accB, 3); __builtin_amdgcn_sched_barrier(0);
            IDX_VALU(accA, 2); __builtin_amdgcn_sched_barrier(0);
            IDX_VALU(accB, 3);
        } else { IDX_VALU(accB, 1); }
        { const int c00 = __builtin_amdgcn_readlane(cnt0, 0), c01 = __builtin_amdgcn_readlane(cnt1, 0), c10 = __builtin_amdgcn_readlane(cnt0, 32), c11 = __builtin_amdgcn_readlane(cnt1, 32);
          constexpr int LIM = IDX_CAP - IDX_STG;
          if ((c00 > LIM || c01 > LIM || c10 > LIM || c11 > LIM) && lane == 0) pflag[st % 3] = 1u; }
        if (tid == 0) pflag[(st + 1) % 3] = 0u;
        if (st + 1 < nst) { LAS unsigned char* kn = kt + ((st + 1) & 1) * IDX_KT_BYTES + kdst; *(LAS v4u*)kn = kreg0; *(LAS v4u*)(kn + 64 * IDX_KT_STRIDE) = kreg1; }
        __syncthreads();
        if (pflag[st % 3] != 0u && st + 1 < nst) {
            const int c00 = __builtin_amdgcn_readlane(cnt0, 0), c01 = __builtin_amdgcn_readlane(cnt1, 0), c10 = __builtin_amdgcn_readlane(cnt0, 32), c11 = __builtin_amdgcn_readlane(cnt1, 32);
            if (c00 > IDX_PRMIN) { const unsigned T = idx_prune(cb, c00, hist, lane); if (!hi) { thr0 = T - 1u; cnt0 = 256; } }
            if (c01 > IDX_PRMIN) { const unsigned T = idx_prune(cb + IDX_CAP, c01, hist, lane); if (!hi) { thr1 = T - 1u; cnt1 = 256; } }
            if (c10 > IDX_PRMIN) { const unsigned T = idx_prune(cb + 2 * IDX_CAP, c10, hist, lane); if (hi) { thr0 = T - 1u; cnt0 = 256; } }
            if (c11 > IDX_PRMIN) { const unsigned T = idx_prune(cb + 3 * IDX_CAP, c11, hist, lane); if (hi) { thr1 = T - 1u; cnt1 = 256; } }
        }
    }
#undef IDX_MMA
#undef IDX_VALU
    LDS_WAIT();
    if (DRY) { __syncthreads(); return; }
#pragma unroll
    for (int q = 0; q < 4; ++q) {
        int cq = __builtin_amdgcn_readlane((q & 1) ? cnt1 : cnt0, (q >> 1) * 32);
        LAS unsigned* buf = cb + q * IDX_CAP;
        if (cq > 256) { (void)idx_prune(buf, cq, hist, lane); cq = 256; }
        LAS unsigned* mrow = buf + 256;
#pragma unroll
        for (int j = 0; j < 4; ++j) mrow[j * 64 + lane] = 0u;
        LDS_WAIT();
#pragma unroll
        for (int j = 0; j < 4; ++j) { const int idx = j * 64 + lane; if (idx < cq) { const unsigned v = buf[idx]; const unsigned key = 8191u - (v & 8191u);
            __hip_atomic_fetch_or(mrow + (key >> 5), 1u << (key & 31u), __ATOMIC_RELAXED, __HIP_MEMORY_SCOPE_WORKGROUP); } }
        LDS_WAIT();
        const v4u o = *(const LAS v4u*)(mrow + 4 * lane);
        *(GAS v4u*)(MASK + ((size_t)b * SEQ + t0 + q) * 256 + 4 * lane) = o;
    }
    __syncthreads();
}

constexpr int HL_STRIDE = 144;
__device__ __forceinline__ void hgrn_local_item(const Args& a, LAS unsigned char* lds, int item, int tid, int lane, int wave) {
    const int bh = item >> 7, c = item & 127, b = bh >> 2, h = bh & 3;
    const float* LF = (const float*)(a.ws + WS_LF); const bf16* VR = (const bf16*)(a.ws + WS_VR);
    unsigned* LS = (unsigned*)(a.ws + WS_LS); float* DEC = (float*)(a.ws + WS_DEC);
    LAS unsigned char* kct = lds; LAS unsigned char* vt = lds + 128 * HL_STRIDE; LAS float* seg = (LAS float*)(lds + 2 * 128 * HL_STRIDE);
    const int k = tid & 127, sg = tid >> 7;
    const size_t row0 = (size_t)b * SEQ + c * 64 + sg * 16;
    float lf[16], vv[16];
#pragma unroll
    for (int j = 0; j < 16; ++j) { lf[j] = LF[(row0 + j) * 512 + h * 128 + k]; vv[j] = bf2f(VR[(row0 + j) * 512 + h * 128 + k]); }
    float run = 0.f, bl[16];
#pragma unroll
    for (int j = 0; j < 16; ++j) { run += lf[j]; bl[j] = run; }
    seg[sg * 128 + k] = run;
    __syncthreads();
    float off = 0.f, tot = 0.f;
#pragma unroll
    for (int s = 0; s < 4; ++s) { const float x = seg[s * 128 + k]; tot += x; if (s < sg) off += x; }
    { unsigned pk[8], pv[8];
#pragma unroll
      for (int j = 0; j < 8; ++j) { const float k0 = (1.f - fexp(lf[2 * j])) * fexp(tot - off - bl[2 * j]), k1 = (1.f - fexp(lf[2 * j + 1])) * fexp(tot - off - bl[2 * j + 1]);
          pk[j] = cvtpk(k0, k1); pv[j] = cvtpk(vv[2 * j], vv[2 * j + 1]); }
      *(LAS v4u*)(kct + k * HL_STRIDE + sg * 32) = (v4u){pk[0], pk[1], pk[2], pk[3]}; *(LAS v4u*)(kct + k * HL_STRIDE + sg * 32 + 16) = (v4u){pk[4], pk[5], pk[6], pk[7]};
      *(LAS v4u*)(vt + k * HL_STRIDE + sg * 32) = (v4u){pv[0], pv[1], pv[2], pv[3]}; *(LAS v4u*)(vt + k * HL_STRIDE + sg * 32 + 16) = (v4u){pv[4], pv[5], pv[6], pv[7]}; }
    if (sg == 0) DEC[(size_t)item * 128 + k] = fexp(tot);
    __syncthreads();
    { const int hi = lane >> 5, m = lane & 31, mt = wave >> 1, np = wave & 1;
      f32x16 acc0 = {0.f, 0.f, 0.f, 0.f, 0.f, 0.f, 0.f, 0.f, 0.f, 0.f, 0.f, 0.f, 0.f, 0.f, 0.f, 0.f}, acc1 = acc0;
#pragma unroll
      for (int ks = 0; ks < 4; ++ks) { const bf16x8 av = *(const LAS bf16x8*)(vt + (32 * mt + m) * HL_STRIDE + (16 * ks + 8 * hi) * 2);
          const bf16x8 b0 = *(const LAS bf16x8*)(kct + (64 * np + 2 * m) * HL_STRIDE + (16 * ks + 8 * hi) * 2), b1 = *(const LAS bf16x8*)(kct + (64 * np + 2 * m + 1) * HL_STRIDE + (16 * ks + 8 * hi) * 2);
          acc0 = MFMA32(av, b0, acc0); acc1 = MFMA32(av, b1, acc1); }
#pragma unroll
      for (int i = 0; i < 16; ++i) { const int v = 32 * mt + crow(i, hi); LS[((size_t)item * 128 + v) * 64 + 32 * np + m] = cvtpk(acc0[i], acc1[i]); } }
    __syncthreads();
}

__device__ __forceinline__ void phase4(const Args& a, int tid, int G) {
    unsigned* LS = (unsigned*)(a.ws + WS_LS); const float* DEC = (const float*)(a.ws + WS_DEC);
    for (int gid = blockIdx.x * 512 + tid; gid < 65536; gid += G * 512) {
        const int bh = gid >> 13, v = (gid >> 6) & 127, kp = gid & 63;
        float s0 = 0.f, s1 = 0.f;
        unsigned* p = LS + ((size_t)bh * 128 * 128 + v) * 64 + kp; const float* dp = DEC + (size_t)bh * 128 * 128 + 2 * kp;
        for (int c0 = 0; c0 < 128; c0 += 16) {
            unsigned w[16]; f32x2 d[16];
#pragma unroll
            for (int i = 0; i < 16; ++i) { w[i] = __builtin_nontemporal_load(p + (size_t)(c0 + i) * 128 * 64); d[i] = *(const f32x2*)(dp + (size_t)(c0 + i) * 128); }
#pragma unroll
            for (int i = 0; i < 16; ++i) { s0 = d[i].x * s0 + bflo(w[i]); s1 = d[i].y * s1 + bfhi(w[i]); w[i] = cvtpk(s0, s1); }
#pragma unroll
            for (int i = 0; i < 16; ++i) p[(size_t)(c0 + i) * 128 * 64] = w[i];
        }
    }
}

constexpr int AT_KSTRIDE = 144, AT_STG = 128, AT_KBYTES = AT_STG * AT_KSTRIDE, AT_VBYTES = 2 * 8192, AT_SBYTES = AT_KBYTES + AT_VBYTES;
constexpr int AT_STG_OFF = 0, AT_TAB_OFF = 2 * AT_SBYTES, AT_L_OFF = AT_TAB_OFF + 1024, AT_OST_OFF = AT_L_OFF + NWAVES * 128, AT_OST_STRIDE = 68;
static_assert(AT_OST_OFF + NWAVES * 32 * AT_OST_STRIDE * 4 <= MISC_OFF, "attention LDS");

__device__ __forceinline__ int t5_bucket_neg(int n) {
    return n < 8 ? n : n < 12 ? 8 : n < 16 ? 9 : n < 23 ? 10 : n < 32 ? 11 : n < 46 ? 12 : n < 64 ? 13 : n < 91 ? 14 : 15;
}
__device__ __forceinline__ s16x4 vtr(const LAS unsigned char* p) { return __builtin_bit_cast(s16x4, __builtin_amdgcn_ds_read_tr16_b64_v4i16((LAS v4i16_t*)p)); }

__device__ __forceinline__ float msel(int w, int pos, float x) { int t; float r; asm("v_bfe_i32 %0, %1, %2, 1" : "=v"(t) : "v"(w), "n"(pos)); asm("v_bfi_b32 %0, %1, %2, %3" : "=v"(r) : "v"(t), "v"(x), "v"(0xff800000u)); return r; }
template <int DRYM>
__device__ __forceinline__ void attn_item(const Args& a, LAS unsigned char* lds, int b, int h, int qb, int tid, int lane, int wave) {
    const bf16* AQ = (const bf16*)(a.ws + WS_AQ); const bf16* AK = (const bf16*)(a.ws + WS_AK); const bf16* AV = (const bf16*)(a.ws + WS_AV);
    const unsigned* MASK = (const unsigned*)(a.ws + WS_MASK); bf16* MIX = (bf16*)(a.ws + WS_H);
    const int hi = lane >> 5, r32 = lane & 31, q0 = qb * 256, qw = q0 + wave * 32, nst = (q0 + 256) >> 7, kend = (((qw + 31) >> 6) + 1) * 64;
    LAS float* tab = (LAS float*)(lds + AT_TAB_OFF);
    if (tid < 192) {
        const float* qg = a.in[IN_QG]; const float* kg = a.in[IN_KG]; const float* rb = a.in[IN_RELB];
        float mq = 0.f, mk = 0.f, mb = -3.0e38f;
        for (int i = 0; i < 64; ++i) { mq = fmaxf(mq, fabsf(qg[i])); mk = fmaxf(mk, fabsf(kg[i])); }
        for (int i = 0; i < 32; ++i) mb = fmaxf(mb, rb[i * 8 + h]);
        const float bound = 8.f * mq * mk + mb; const int rel = tid - 128, n = rel < 0 ? -rel : rel;
        const int bk = (rel > 0 ? 16 : 0) + t5_bucket_neg(n);
        tab[tid] = (rb[bk * 8 + h] - bound) * LOG2E;
    }
    bf16x8 qr[4];
    { const bf16* qp = AQ + ((size_t)b * SEQ + qw + r32) * 512 + h * 64 + 8 * hi;
#pragma unroll
      for (int d0 = 0; d0 < 4; ++d0) qr[d0] = *(const GAS bf16x8*)(qp + 16 * d0); }
    const int skey = tid >> 3, sch = tid & 7;
    const size_t srow = ((size_t)b * SEQ + skey) * 512 + h * 64 + sch * 8;
    const int kdst = skey * AT_KSTRIDE + sch * 16, vdst = AT_KBYTES + ((sch >> 2) * 4 + (skey >> 4)) * 1024 + (skey & 15) * 64 + (sch & 3) * 16;
    LAS unsigned char* sbuf = lds + AT_STG_OFF;
    v4u kr0 = *(const GAS v4u*)(AK + srow), kr1 = *(const GAS v4u*)(AK + srow + 64 * 512), vr0 = *(const GAS v4u*)(AV + srow), vr1 = *(const GAS v4u*)(AV + srow + 64 * 512);
    *(LAS v4u*)(sbuf + kdst) = kr0; *(LAS v4u*)(sbuf + kdst + 64 * AT_KSTRIDE) = kr1; *(LAS v4u*)(sbuf + vdst) = vr0; *(LAS v4u*)(sbuf + vdst + 8192) = vr1;
    const unsigned* mrow = MASK + ((size_t)b * SEQ + qw + r32) * 256;
    v4u mw = *(const GAS v4u*)(mrow);
    f32x16 o0 = {0.f, 0.f, 0.f, 0.f, 0.f, 0.f, 0.f, 0.f, 0.f, 0.f, 0.f, 0.f, 0.f, 0.f, 0.f, 0.f}, o1 = o0;
    float lsum = 0.f;
    __syncthreads();
    const float cfar = tab[0];
    const int vb = ((lane >> 4) & 1) * 32 + (lane & 3) * 8 + (4 * hi + ((lane & 15) >> 2)) * 64;
#define AT_QK(sv, sub, wordv) do { if (DRYM == 4) { _Pragma("unroll") for (int r = 0; r < 16; ++r) sv[r] = cfar; break; } const int ks_ = kb0 + 32 * (sub); const int wsh_ = (int)((wordv) >> (4 * hi)); \
        if (ks_ + 31 - qw <= -91) { _Pragma("unroll") for (int r = 0; r < 16; ++r) sv[r] = msel(wsh_, (r & 3) + 8 * (r >> 2), cfar); } \
        else { const int base_ = ks_ + 4 * hi - qw - r32 + 128; _Pragma("unroll") for (int r = 0; r < 16; ++r) { int ix = base_ + (r & 3) + 8 * (r >> 2); ix = ix < 0 ? 0 : ix; sv[r] = msel(wsh_, (r & 3) + 8 * (r >> 2), tab[ix]); } } \
        _Pragma("unroll") for (int d0 = 0; d0 < 4; ++d0) { const bf16x8 kf = *(const LAS bf16x8*)(kcur + ((sub) * 32 + r32) * AT_KSTRIDE + (16 * d0 + 8 * hi) * 2); sv = MFMA32(kf, qr[d0], sv); } } while (0)
#define AT_SOFT(sv, wordv, pa0, pa1) do { if (DRYM == 2) { pa0 = (v4u){__float_as_uint(sv[0]), __float_as_uint(sv[1]), __float_as_uint(sv[2]), __float_as_uint(sv[3])}; pa1 = (v4u){__float_as_uint(sv[4]) ^ (wordv), __float_as_uint(sv[5]), __float_as_uint(sv[6]), __float_as_uint(sv[7])}; break; } float p_[16]; \
        _Pragma("unroll") for (int r = 0; r < 16; ++r) { p_[r] = fexp2(sv[r]); lsum += p_[r]; } \
        pa0 = (v4u){cvtpk(p_[0], p_[1]), cvtpk(p_[2], p_[3]), cvtpk(p_[4], p_[5]), cvtpk(p_[6], p_[7])}; pa1 = (v4u){cvtpk(p_[8], p_[9]), cvtpk(p_[10], p_[11]), cvtpk(p_[12], p_[13]), cvtpk(p_[14], p_[15])}; } while (0)
#define AT_PV(pa0, pa1, sub) do { if (DRYM == 3) { o0[0] += __uint_as_float(pa0.x ^ pa1.y); break; } const LAS unsigned char* vs_ = vcur + ((sub) >> 1) * 8192; \
        _Pragma("unroll") for (int kk = 0; kk < 2; ++kk) { const int kg = 2 * ((sub) & 1) + kk; const bf16x8 pa = __builtin_bit_cast(bf16x8, kk ? pa1 : pa0); \
            _Pragma("unroll") for (int dh = 0; dh < 2; ++dh) { const s16x4 lo_ = vtr(vs_ + dh * 4096 + kg * 1024), hh_ = vtr(vs_ + dh * 4096 + kg * 1024 + 512); \
                const bf16x8 vf = {lo_[0], lo_[1], lo_[2], lo_[3], hh_[0], hh_[1], hh_[2], hh_[3]}; if (dh == 0) o0 = MFMA32(pa, vf, o0); else o1 = MFMA32(pa, vf, o1); } } } while (0)
#define AT_SB() __builtin_amdgcn_sched_barrier(0)
    for (int st = 0; st < nst; ++st) {
        const int kb0 = st * AT_STG; v4u mwn = mw;
        if (st + 1 < nst) { const size_t nx = srow + (size_t)(kb0 + AT_STG) * 512; kr0 = *(const GAS v4u*)(AK + nx); kr1 = *(const GAS v4u*)(AK + nx + 64 * 512); vr0 = *(const GAS v4u*)(AV + nx); vr1 = *(const GAS v4u*)(AV + nx + 64 * 512);
            mwn = *(const GAS v4u*)(mrow + 4 * (st + 1)); }
        const LAS unsigned char* kcur = sbuf + (st & 1) * AT_SBYTES; const LAS unsigned char* vcur = kcur + AT_KBYTES + vb;
        const int nsub = kend - kb0 >= AT_STG ? 4 : kend - kb0 > 0 ? (kend - kb0) >> 5 : 0;
        if (nsub > 0) {
            f32x16 sA, sB; v4u a0, a1, b0, b1;
            AT_QK(sA, 0, mw.x); AT_QK(sB, 1, mw.y); AT_SB();
            AT_SOFT(sA, mw.x, a0, a1); AT_SB();
            if (nsub == 4) {
                AT_QK(sA, 2, mw.z); AT_PV(a0, a1, 0); AT_SB();
                AT_SOFT(sB, mw.y, b0, b1); AT_SB();
                AT_QK(sB, 3, mw.w); AT_PV(b0, b1, 1); AT_SB();
                AT_SOFT(sA, mw.z, a0, a1); AT_SB();
                AT_PV(a0, a1, 2); AT_SB();
                AT_SOFT(sB, mw.w, b0, b1); AT_SB();
                AT_PV(b0, b1, 3);
            } else {
                AT_PV(a0, a1, 0); AT_SB();
                AT_SOFT(sB, mw.y, b0, b1); AT_SB();
                AT_PV(b0, b1, 1);
            }
        }
        if (st + 1 < nst) { LAS unsigned char* sn = sbuf + ((st + 1) & 1) * AT_SBYTES; *(LAS v4u*)(sn + kdst) = kr0; *(LAS v4u*)(sn + kdst + 64 * AT_KSTRIDE) = kr1; *(LAS v4u*)(sn + vdst) = vr0; *(LAS v4u*)(sn + vdst + 8192) = vr1; }
        mw = mwn;
        __syncthreads();
    }
#undef AT_QK
#undef AT_SOFT
#undef AT_PV
#undef AT_SB
    if (DRYM != 0) { if (o0[0] + o1[3] + lsum == 1.2345e-30f) ((float*)(a.ws + WS_DEC))[tid] = 1.f; __syncthreads(); return; }
    lsum += __shfl_xor(lsum, 32);
    LAS float* lw = (LAS float*)(lds + AT_L_OFF) + wave * 32; LAS float* ost = (LAS float*)(lds + AT_OST_OFF) + wave * 32 * AT_OST_STRIDE;
    if (hi == 0) lw[r32] = lsum;
    LDS_WAIT();
#pragma unroll
    for (int r = 0; r < 16; ++r) { const int q = crow(r, hi); const float rl = frcp(lw[q]); ost[q * AT_OST_STRIDE + r32] = o0[r] * rl; ost[q * AT_OST_STRIDE + 32 + r32] = o1[r] * rl; }
    LDS_WAIT();
    { const int q = lane >> 1, hf = lane & 1; const LAS float* src = ost + q * AT_OST_STRIDE + hf * 32; const float* g = a.in[IN_ATTG] + h * 64 + hf * 32;
      float v[32], ss = 0.f;
#pragma unroll
      for (int i = 0; i < 8; ++i) { const f32x4 t = *(const LAS f32x4*)(src + 4 * i); v[4 * i] = t.x; v[4 * i + 1] = t.y; v[4 * i + 2] = t.z; v[4 * i + 3] = t.w; ss += (t.x * t.x + t.y * t.y) + (t.z * t.z + t.w * t.w); }
      ss += __shfl_xor(ss, 1);
      const float ri = frsq(ss * (1.f / 64.f) + EPS);
      bf16* dst = MIX + ((size_t)b * SEQ + qw + q) * 1024 + 512 + h * 64 + hf * 32;
#pragma unroll
      for (int i = 0; i < 4; ++i) { v4u w;
          w.x = cvtpk(v[8 * i] * ri * g[8 * i], v[8 * i + 1] * ri * g[8 * i + 1]); w.y = cvtpk(v[8 * i + 2] * ri * g[8 * i + 2], v[8 * i + 3] * ri * g[8 * i + 3]);
          w.z = cvtpk(v[8 * i + 4] * ri * g[8 * i + 4], v[8 * i + 5] * ri * g[8 * i + 5]); w.w = cvtpk(v[8 * i + 6] * ri * g[8 * i + 6], v[8 * i + 7] * ri * g[8 * i + 7]);
          *(GAS v4u*)(dst + 8 * i) = w; } }
    __syncthreads();
}

constexpr int HO_QSTRIDE = 272, HO_QBYTES = 64 * HO_QSTRIDE;
constexpr int HO_QD = 0, HO_KD = HO_QBYTES, HO_QE = 2 * HO_QBYTES, HO_VT = 3 * HO_QBYTES, HO_SEG = HO_VT + 128 * HL_STRIDE, HO_RB = HO_SEG + 2048, HO_OST = HO_RB + 512, HO_OSTRIDE = 132;
static_assert(HO_OST + 64 * HO_OSTRIDE * 4 <= RING_BYTES, "hgrn-out LDS");
__device__ __forceinline__ void hgrn_out_item(const Args& a, LAS unsigned char* lds, int item, int tid, int lane, int wave) {
    const int bh = item >> 7, c = item & 127, b = bh >> 2, h = bh & 3;
    const float* LF = (const float*)(a.ws + WS_LF); const bf16* VR = (const bf16*)(a.ws + WS_VR); const bf16* QR = (const bf16*)(a.ws + WS_QR); const bf16* GR = (const bf16*)(a.ws + WS_GR);
    const bf16* LSb = (const bf16*)(a.ws + WS_LS); bf16* MIX = (bf16*)(a.ws + WS_H);
    LAS unsigned short* qd = (LAS unsigned short*)(lds + HO_QD); LAS unsigned short* kd = (LAS unsigned short*)(lds + HO_KD); LAS unsigned short* qe = (LAS unsigned short*)(lds + HO_QE);
    LAS unsigned char* vt = lds + HO_VT; LAS float* seg = (LAS float*)(lds + HO_SEG); LAS float* rbuf = (LAS float*)(lds + HO_RB); LAS float* ost = (LAS float*)(lds + HO_OST);
    const int k = tid & 127, sg = tid >> 7;
    const size_t row0 = (size_t)b * SEQ + c * 64 + sg * 16;
    float lf[16], qq[16], vv[16];
#pragma unroll
    for (int j = 0; j < 16; ++j) { const size_t ix = (row0 + j) * 512 + h * 128 + k; lf[j] = LF[ix]; qq[j] = bf2f(QR[ix]); vv[j] = bf2f(VR[ix]); }
    float run = 0.f, bl[16];
#pragma unroll
    for (int j = 0; j < 16; ++j) { run += lf[j]; bl[j] = run; }
    seg[sg * 128 + k] = run;
    __syncthreads();
    float off = 0.f;
#pragma unroll
    for (int s = 0; s < 4; ++s) { const float x = seg[s * 128 + k]; if (s < sg) off += x; }
    if (sg == 1) rbuf[k] = off + bl[15];
    __syncthreads();
    const float rr = rbuf[k];
    { unsigned pv[8];
#pragma unroll
      for (int j = 0; j < 16; ++j) { const float bt = off + bl[j], e1 = fexp(bt - rr), e2 = fexp(rr - bt), kk = 1.f - fexp(lf[j]); const int t = sg * 16 + j;
          qd[t * (HO_QSTRIDE / 2) + k] = (unsigned short)(cvtpk(qq[j] * e1, 0.f) & 0xffffu); kd[t * (HO_QSTRIDE / 2) + k] = (unsigned short)(cvtpk(kk * e2, 0.f) & 0xffffu);
          qe[t * (HO_QSTRIDE / 2) + k] = (unsigned short)(cvtpk(qq[j] * fexp(bt), 0.f) & 0xffffu); }
#pragma unroll
      for (int j = 0; j < 8; ++j) pv[j] = cvtpk(vv[2 * j], vv[2 * j + 1]);
      *(LAS v4u*)(vt + k * HL_STRIDE + sg * 32) = (v4u){pv[0], pv[1], pv[2], pv[3]}; *(LAS v4u*)(vt + k * HL_STRIDE + sg * 32 + 16) = (v4u){pv[4], pv[5], pv[6], pv[7]}; }
    __syncthreads();
    { const int hi = lane >> 5, m = lane & 31, tt = wave >> 2, vti = wave & 3;
      f32x16 acc = {0.f, 0.f, 0.f, 0.f, 0.f, 0.f, 0.f, 0.f, 0.f, 0.f, 0.f, 0.f, 0.f, 0.f, 0.f, 0.f};
      const LAS unsigned char* qeb = lds + HO_QE + (32 * tt + m) * HO_QSTRIDE + 16 * hi;
      if (c > 0) {
          const bf16* sp = LSb + ((size_t)(item - 1) * 128 + 32 * vti + m) * 128 + 8 * hi;
#pragma unroll
          for (int ks = 0; ks < 8; ++ks) { const bf16x8 af = *(const LAS bf16x8*)(qeb + 32 * ks); const bf16x8 bfr = *(const GAS bf16x8*)(sp + 16 * ks); acc = MFMA32(af, bfr, acc); }
      }
      const LAS unsigned char* qdb = lds + HO_QD + (32 * tt + m) * HO_QSTRIDE + 16 * hi;
#pragma unroll
      for (int st = 0; st < 2; ++st) if (st <= tt) {
          f32x16 pt = {0.f, 0.f, 0.f, 0.f, 0.f, 0.f, 0.f, 0.f, 0.f, 0.f, 0.f, 0.f, 0.f, 0.f, 0.f, 0.f};
          const LAS unsigned char* kdb = lds + HO_KD + (32 * st + m) * HO_QSTRIDE + 16 * hi;
#pragma unroll
          for (int ks = 0; ks < 8; ++ks) { const bf16x8 af = *(const LAS bf16x8*)(kdb + 32 * ks); const bf16x8 bfr = *(const LAS bf16x8*)(qdb + 32 * ks); pt = MFMA32(af, bfr, pt); }
          float p[16];
#pragma unroll
          for (int r = 0; r < 16; ++r) { const int s = 32 * st + crow(r, hi), t = 32 * tt + m; p[r] = (s <= t) ? pt[r] : 0.f; }
          const v4u pa0 = {cvtpk(p[0], p[1]), cvtpk(p[2], p[3]), cvtpk(p[4], p[5]), cvtpk(p[6], p[7])}, pa1 = {cvtpk(p[8], p[9]), cvtpk(p[10], p[11]), cvtpk(p[12], p[13]), cvtpk(p[14], p[15])};
#pragma unroll
          for (int kk = 0; kk < 2; ++kk) { const LAS unsigned char* vp = vt + (32 * vti + m) * HL_STRIDE + (32 * st + 16 * kk + 4 * hi) * 2;
              const v2u lo = *(const LAS v2u*)(vp), hh = *(const LAS v2u*)(vp + 16);
              const v4u vw = {lo.x, lo.y, hh.x, hh.y};
              acc = MFMA32(__builtin_bit_cast(bf16x8, kk ? pa1 : pa0), __builtin_bit_cast(bf16x8, vw), acc); }
      }
#pragma unroll
      for (int r = 0; r < 16; ++r) ost[(32 * tt + crow(r, hi)) * HO_OSTRIDE + 32 * vti + m] = acc[r];
    }
    __syncthreads();
    { const int t = tid >> 3, s8 = tid & 7; const LAS float* src = ost + t * HO_OSTRIDE + s8 * 16; float v[16], ss = 0.f;
#pragma unroll
      for (int i = 0; i < 4; ++i) { const f32x4 x = *(const LAS f32x4*)(src + 4 * i); v[4 * i] = x.x; v[4 * i + 1] = x.y; v[4 * i + 2] = x.z; v[4 * i + 3] = x.w; ss += (x.x * x.x + x.y * x.y) + (x.z * x.z + x.w * x.w); }
      ss += __shfl_xor(ss, 1); ss += __shfl_xor(ss, 2); ss += __shfl_xor(ss, 4);
      const float ri = frsq(ss * (1.f / 128.f) + EPS);
      const size_t tok = (size_t)b * SEQ + c * 64 + t; const float* g = a.in[IN_RECG] + h * 128 + s8 * 16;
      const v4u g0 = *(const GAS v4u*)(GR + tok * 512 + h * 128 + s8 * 16), g1 = *(const GAS v4u*)(GR + tok * 512 + h * 128 + s8 * 16 + 8);
      const unsigned gw[8] = {g0.x, g0.y, g0.z, g0.w, g1.x, g1.y, g1.z, g1.w}; unsigned ow[8];
#pragma unroll
      for (int i = 0; i < 8; ++i) ow[i] = cvtpk(v[2 * i] * ri * g[2 * i] * bflo(gw[i]), v[2 * i + 1] * ri * g[2 * i + 1] * bfhi(gw[i]));
      bf16* dst = MIX + tok * 1024 + h * 128 + s8 * 16;
      *(GAS v4u*)dst = (v4u){ow[0], ow[1], ow[2], ow[3]}; *(GAS v4u*)(dst + 8) = (v4u){ow[4], ow[5], ow[6], ow[7]}; }
    __syncthreads();
}

struct EpiOutProj {
    static constexpr bool PERM = false, AFTER_DRAIN = false;
    const float* x; float* out; const float* modf;
    __device__ __forceinline__ void operator()(const pg8::f32x4 (&acc)[2][2][4][2], const pg8::Unit& u, int wr, int wc, int fr, int fq) const {
        const int row0 = u.pm * 256 + wr * 64 + fr, col0 = u.pn * 256 + wc * 32 + 4 * fq, b = u.pm >> 5;
        f32x4 gv[2][2];
#pragma unroll
        for (int bj = 0; bj < 2; ++bj)
#pragma unroll
            for (int n = 0; n < 2; ++n) gv[bj][n] = *(const f32x4*)(modf + b * 6144 + 2048 + col0 + bj * 128 + n * 16);
#pragma unroll
        for (int ai = 0; ai < 2; ++ai)
#pragma unroll
            for (int m = 0; m < 4; ++m) { const size_t off = (size_t)(row0 + ai * 128 + m * 16) * DM + col0;
#pragma unroll
                for (int bj = 0; bj < 2; ++bj)
#pragma unroll
                    for (int n = 0; n < 2; ++n) { const f32x4 xv = *(const GAS f32x4*)(x + off + bj * 128 + n * 16); *(GAS f32x4*)(out + off + bj * 128 + n * 16) = xv + gv[bj][n] * acc[ai][bj][m][n]; } }
    }
};

constexpr int RT_RW = 0, RT_A2 = 81920, RT_S2 = RT_A2 + 8192, RT_CNT = RT_S2 + 8192, RT_SCR = RT_CNT + 128;
__device__ __forceinline__ void load_mod2(const Args& a, LAS unsigned char* lds, int tid) {
    LAS float* A2 = (LAS float*)(lds + RT_A2); LAS float* S2 = (LAS float*)(lds + RT_S2);
    const float* modf = (const float*)(a.ws + WS_MODF); const float* g = a.in[IN_N2G];
    float gv[4], sc[4], sh[4];
#pragma unroll
    for (int q = 0; q < 4; ++q) { const int idx = tid + 512 * q, b = idx >> 10, i = idx & 1023; gv[q] = g[i]; sc[q] = modf[b * 6144 + 4096 + i]; sh[q] = modf[b * 6144 + 3072 + i]; }
#pragma unroll
    for (int q = 0; q < 4; ++q) { const int idx = tid + 512 * q; A2[idx] = gv[q] * (1.f + sc[q]); S2[idx] = sh[q]; }
}
__device__ __forceinline__ void phase7(const Args& a, LAS unsigned char* lds, int tid, int lane, int wave, int G) {
    LAS float* RW = (LAS float*)(lds + RT_RW); LAS float* A2 = (LAS float*)(lds + RT_A2); LAS float* S2 = (LAS float*)(lds + RT_S2); LAS unsigned* lcnt = (LAS unsigned*)(lds + RT_CNT);
    const float* wrg = a.in[IN_WRG]; const float* wre = a.in[IN_WRE];
    { f32x4 t[10];
#pragma unroll
      for (int q = 0; q < 10; ++q) { const int f = tid + 512 * q, i = f / 5, c = f % 5; t[q] = c == 0 ? *(const GAS f32x4*)(wrg + i * 4) : *(const GAS f32x4*)(wre + i * 16 + (c - 1) * 4); }
#pragma unroll
      for (int q = 0; q < 10; ++q) { const int f = tid + 512 * q; *(LAS f32x4*)(RW + f * 4) = t[q]; } }
    load_mod2(a, lds, tid);
    if (tid < 32) lcnt[tid] = 0u;
    __syncthreads();
    const int gw = blockIdx.x * NWAVES + wave, NGW = G * NWAVES;
    const float* x1 = a.out; f32x4* route = (f32x4*)(a.ws + WS_ROUTE);
    float bias[20];
#pragma unroll
    for (int n = 0; n < 20; ++n) bias[n] = n < 4 ? a.in[IN_BRG][n] : a.in[IN_BRE][n - 4];
    for (int rep_ = 0; rep_ < (PROBE_REP == 70 ? 2 : 1); ++rep_)
    for (int m = gw; m < MTOK; m += NGW) {
        const int b = m >> 13; const float* xr = x1 + (size_t)m * DM + lane;
        float xv[16], ss = 0.f;
#pragma unroll
        for (int j = 0; j < 16; ++j) { xv[j] = xr[64 * j]; ss += xv[j] * xv[j]; }
        const float ri = frsq(wave_sum(ss) * (1.f / DM) + EPS);
        float lg[20];
#pragma unroll
        for (int n = 0; n < 20; ++n) lg[n] = 0.f;
#pragma unroll
        for (int j = 0; j < 16; ++j) { const int i = lane + 64 * j; const float h2 = xv[j] * ri * A2[b * 1024 + i] + S2[b * 1024 + i];
            const LAS f32x4* wr = (const LAS f32x4*)(RW + i * 20);
#pragma unroll
            for (int q = 0; q < 5; ++q) { const f32x4 w = wr[q]; lg[4 * q] += h2 * w.x; lg[4 * q + 1] += h2 * w.y; lg[4 * q + 2] += h2 * w.z; lg[4 * q + 3] += h2 * w.w; } }
#pragma unroll
        for (int n = 0; n < 20; ++n) lg[n] = wave_sum(lg[n]) + bias[n];
        int gt = 0; float gm = lg[0];
#pragma unroll
        for (int n = 1; n < 4; ++n) if (lg[n] > gm) { gm = lg[n]; gt = n; }
        float gs = 0.f;
#pragma unroll
        for (int n = 0; n < 4; ++n) gs += fexp(lg[n] - gm);
        const float gate = 1.f / gs;
        float e[4];
#pragma unroll
        for (int n = 0; n < 4; ++n) e[n] = gt == 0 ? lg[4 + n] : gt == 1 ? lg[8 + n] : gt == 2 ? lg[12 + n] : lg[16 + n];
        int j0 = 0; float v0 = e[0];
#pragma unroll
        for (int n = 1; n < 4; ++n) if (e[n] > v0) { v0 = e[n]; j0 = n; }
        int j1 = -1; float v1 = -3.0e38f;
#pragma unroll
        for (int n = 0; n < 4; ++n) if (n != j0 && e[n] > v1) { v1 = e[n]; j1 = n; }
        const float w0 = gate / (1.f + fexp(v1 - v0)), w1 = gate - w0;
        const int lo = j0 < j1 ? j0 : j1, hh = j0 < j1 ? j1 : j0; const float wlo = j0 < j1 ? w0 : w1, whi = j0 < j1 ? w1 : w0;
        const int pidx = lo == 0 ? hh - 1 : lo == 1 ? hh + 1 : 5;
        const int combo = gt * 6 + pidx;
        if (lane == 0 && rep_ == 0) { route[m] = (f32x4){__int_as_float(combo), wlo, whi, ri}; __hip_atomic_fetch_add(lcnt + combo, 1u, __ATOMIC_RELAXED, __HIP_MEMORY_SCOPE_WORKGROUP); }
    }
    __syncthreads();
    if (tid < NCOMBO) { const unsigned c = lcnt[tid]; if (c) __hip_atomic_fetch_add((unsigned*)(a.ws + WS_CTL) + CW_CNT + tid, c, __ATOMIC_RELAXED, __HIP_MEMORY_SCOPE_AGENT); }
    __syncthreads();
    for (int rep_ = 0; rep_ < (PROBE_REP == 71 ? 2 : 1); ++rep_) moe_weight_items(a, (LAS float*)(lds + wave * 16384), gw, NGW, lane);
}

constexpr int MB_BASE = MISC_OFF + 1024, MB_CNT = MB_BASE + 128, MB_NBLK = MB_CNT + 128, MB_BLK = MB_NBLK + 16;
__device__ __forceinline__ void build_buckets(const Args& a, LAS unsigned char* lds, int tid) {
    LAS int* base = (LAS int*)(lds + MB_BASE); LAS int* cnt = (LAS int*)(lds + MB_CNT); LAS int* blk = (LAS int*)(lds + MB_BLK);
    if (tid < 64) {
        const unsigned* gc = (const unsigned*)(a.ws + WS_CTL) + CW_CNT;
        const int n = tid < NCOMBO ? (int)__hip_atomic_load(gc + tid, __ATOMIC_RELAXED, __HIP_MEMORY_SCOPE_AGENT) : 0;
        const int k = (n + 255) >> 8; int inc = k;
#pragma unroll
        for (int o = 1; o < 32; o <<= 1) { const int t = __shfl_up(inc, o); if ((tid & 63) >= o) inc += t; }
        const int excl = inc - k;
        if (tid < NCOMBO) { base[tid] = excl * 256; cnt[tid] = n; for (int i = 0; i < k; ++i) blk[excl + i] = tid; }
        if (tid == NCOMBO - 1) *(LAS int*)(lds + MB_NBLK) = inc;
    }
    __syncthreads();
}

__device__ __forceinline__ void phase8(const Args& a, LAS unsigned char* lds, int tid, int lane, int wave, int G) {
    load_mod2(a, lds, tid);
    build_buckets(a, lds, tid);
    LAS float* A2 = (LAS float*)(lds + RT_A2); LAS float* S2 = (LAS float*)(lds + RT_S2); const LAS int* base = (const LAS int*)(lds + MB_BASE);
    const int gw = blockIdx.x * NWAVES + wave, NGW = G * NWAVES;
    const float* x1 = a.out; const f32x4* route = (const f32x4*)(a.ws + WS_ROUTE); bf16* H2S = (bf16*)(a.ws + WS_H2S);
    int* stok = (int*)(a.ws + WS_STOK); f32x2* wsort = (f32x2*)(a.ws + WS_WSORT); unsigned* cur = (unsigned*)(a.ws + WS_CTL) + CW_CUR;
    const int mj = gw + lane * NGW; f32x4 rtl = {0.f, 0.f, 0.f, 0.f}; int posl = 0;
    if (mj < MTOK) { rtl = route[mj]; const int combo = __float_as_int(rtl.x);
        posl = base[combo] + (int)__hip_atomic_fetch_add(cur + combo, 1u, __ATOMIC_RELAXED, __HIP_MEMORY_SCOPE_AGENT); stok[posl] = mj; wsort[posl] = (f32x2){rtl.y, rtl.z}; }
    for (int rep_ = 0; rep_ < (PROBE_REP == 80 ? 2 : 1); ++rep_)
    for (int j = 0, m = gw; m < MTOK; m += NGW, ++j) {
        const int b = m >> 13; const int pos = __shfl(posl, j); const float ri = __shfl(rtl.w, j);
        const GAS f32x4* xr = (const GAS f32x4*)(x1 + (size_t)m * DM) + lane; GAS v2u* o8 = (GAS v2u*)(H2S + (size_t)pos * DM) + lane;
#pragma unroll
        for (int q = 0; q < 4; ++q) { const f32x4 v = xr[64 * q]; const f32x4 aa = *(LAS f32x4*)(A2 + b * 1024 + 256 * q + 4 * lane), ss = *(LAS f32x4*)(S2 + b * 1024 + 256 * q + 4 * lane);
            const f32x4 h = v * ri * aa + ss; v2u w; w.x = cvtpk(h.x, h.y); w.y = cvtpk(h.z, h.w); o8[64 * q] = w; }
    }
}

__device__ __forceinline__ void pair_of(int pidx, int& lo, int& hh) { lo = pidx < 3 ? 0 : pidx < 5 ? 1 : 2; hh = pidx < 3 ? pidx + 1 : pidx < 5 ? pidx - 1 : 3; }
struct MoeSched1 {
    const LAS int* blk; int nblk, G, c;
    __device__ __forceinline__ bool next(int i, pg8::Unit& u) const {
        const int L = i * G + c; if (L >= nblk * 8) return false;
        const int rb = L >> 3, nt = L & 7, cmb = blk[rb]; int lo, hh; pair_of(cmb % 6, lo, hh);
        const int e = (cmb / 6) * 4 + (nt < 4 ? lo : hh);
        u.pm = rb; u.pn = e * 4 + (nt & 3); u.aux = nt; u.cont = 0; return true;
    }
    __device__ __forceinline__ void a_ready(const pg8::Unit&) const {}
    __device__ __forceinline__ void done(const pg8::Unit&) const {}
};
struct EpiMoe1 {
    static constexpr bool PERM = true, AFTER_DRAIN = false;
    bf16* he; const f32x2* wsort;
    __device__ __forceinline__ void operator()(const pg8::f32x4 (&acc)[2][2][4][2], const pg8::Unit& u, int wr, int wc, int fr, int fq) const {
        const int slot = u.aux >> 2, jt = u.aux & 3, row0 = u.pm * 256 + wr * 64 + fr, col0 = jt * 128 + wc * 32 + 8 * fq;
        bf16* dst = he + (size_t)slot * NSROWS * 512;
#pragma unroll
        for (int ai = 0; ai < 2; ++ai)
#pragma unroll
            for (int m = 0; m < 4; ++m) { const int pos = row0 + ai * 128 + m * 16; const f32x2 wv = wsort[pos]; const float ws = slot ? wv.y : wv.x;
                const pg8::f32x4 a0 = acc[ai][0][m][0], a1 = acc[ai][0][m][1], b0 = acc[ai][1][m][0], b1 = acc[ai][1][m][1];
                v4u w; w.x = cvtpk(ws * silu_f(a0[0]) * b0[0], ws * silu_f(a0[1]) * b0[1]); w.y = cvtpk(ws * silu_f(a0[2]) * b0[2], ws * silu_f(a0[3]) * b0[3]);
                w.z = cvtpk(ws * silu_f(a1[0]) * b1[0], ws * silu_f(a1[1]) * b1[1]); w.w = cvtpk(ws * silu_f(a1[2]) * b1[2], ws * silu_f(a1[3]) * b1[3]);
                *(GAS v4u*)(dst + (size_t)pos * 512 + col0) = w; }
    }
};
struct MoeSched2 {
    const LAS int* blk; int nblk, G, c;
    __device__ __forceinline__ bool next(int i, pg8::Unit& u) const {
        const int L = (i >> 1) * G + c, sg = i & 1; if (L >= nblk * 4) return false;
        const int rb = L >> 2, nt = L & 3, cmb = blk[rb]; int lo, hh; pair_of(cmb % 6, lo, hh);
        const int e = (cmb / 6) * 4 + (sg ? hh : lo);
        u.pm = sg * NROWBLK + rb; u.pn = e * 4 + nt; u.aux = rb * 4 + nt; u.cont = sg ? 0 : 1; return true;
    }
    __device__ __forceinline__ void a_ready(const pg8::Unit&) const {}
    __device__ __forceinline__ void done(const pg8::Unit&) const {}
};
struct EpiMoe2 {
    static constexpr bool PERM = false, AFTER_DRAIN = false;
    float* out; const float* modf; const int* stok; const LAS int* blk; const LAS int* base; const LAS int* cnt;
    __device__ __forceinline__ void operator()(const pg8::f32x4 (&acc)[2][2][4][2], const pg8::Unit& u, int wr, int wc, int fr, int fq) const {
        const int rb = u.aux >> 2, nt = u.aux & 3, cmb = blk[rb], nvalid = cnt[cmb] - (rb * 256 - base[cmb]);
        const int col0 = nt * 256 + wc * 32 + 4 * fq;
#pragma unroll
        for (int ai = 0; ai < 2; ++ai)
#pragma unroll
            for (int m = 0; m < 4; ++m) { const int lr = ai * 128 + wr * 64 + m * 16 + fr;
                if (lr < nvalid) { const int tok = stok[rb * 256 + lr]; const float* gp = modf + (tok >> 13) * 6144 + 5120 + col0; float* op = out + (size_t)tok * DM + col0;
#pragma unroll
                    for (int bj = 0; bj < 2; ++bj)
#pragma unroll
                        for (int n = 0; n < 2; ++n) { const f32x4 g = *(const f32x4*)(gp + bj * 128 + n * 16); const f32x4 xv = *(const GAS f32x4*)(op + bj * 128 + n * 16);
                            *(GAS f32x4*)(op + bj * 128 + n * 16) = xv + g * acc[ai][bj][m][n]; } } }
    }
};

#ifndef MK_N_LAUNCHES
#define MK_N_LAUNCHES 1
#endif
__global__ void __launch_bounds__(NWAVES * 64, 2) fwd(Args a) {
    extern __shared__ __attribute__((aligned(16))) unsigned char lds_raw[];
    LAS unsigned char* lds = (LAS unsigned char*)lds_raw;
    const int tid = threadIdx.x, lane = tid & 63, wave = __builtin_amdgcn_readfirstlane(tid >> 6), G = gridDim.x;
    volatile LAS unsigned* MISC = (volatile LAS unsigned*)(lds + MISC_OFF);
    for (int u = tid; u < (LDS_BYTES - MISC_OFF) / 4; u += NWAVES * 64) ((LAS unsigned*)(lds + MISC_OFF))[u] = 0u;
    __syncthreads();
    unsigned* ctl = (unsigned*)(a.ws + WS_CTL);
    XcdBarrier bar; bar.bar = ctl + CW_BAR; bar.x = 0; bar.st = nullptr;
    const int lo = a.ph_lo, hi = a.ph_hi;
    if (hi - lo > 1) bar = xcd_barrier_post(ctl + CW_BAR, MISC + 8);
#define IN(k) (lo <= (k) && (k) < hi)
#ifndef PROBE_REP
#define PROBE_REP -1
#endif
#define TWICE(id, call) do { call; if (PROBE_REP == (id)) { call; } } while (0)
#define REP(id) for (int rep_ = 0; rep_ < ((PROBE_REP == (id)) ? 2 : 1); ++rep_)
#define SEAM(k) do { if (IN(k) && IN((k) + 1)) xcd_barrier(bar); } while (0)

    if (IN(0)) { REP(0) { phase0(a, lds, tid, lane, wave, G); __syncthreads(); } SEAM(0); }
    if (IN(1)) { REP(1) { phase1(a, lds, tid, lane, wave, G); __syncthreads(); } SEAM(1); }
    if (IN(2)) {
        pg8::Gemm g{(const pg8::bf16_t*)(a.ws + WS_H), (const pg8::bf16_t*)(a.ws + WS_WIN), MTOK, NINP, DM}; pg8::StaticOrder S; S.init(MTOK, NINP, G, (int)blockIdx.x);
        EpiInProj E{a.ws, a.in[IN_LBL], a.in[IN_QG], a.in[IN_KG], a.in[IN_IKG], a.in[IN_IKB]};
        TWICE(2, (pg8::gemm_phase<EpiInProj, pg8::StaticOrder, true, true>(lds + RING_OFF, g, S, E)));
        SEAM(2);
    }
    if (IN(3)) {
        REP(30) for (int it = blockIdx.x; it < 256; it += G) { const int b = it >> 7, p = it & 127; idx_item<false>(a, lds, b, p, tid, lane, wave); idx_item<false>(a, lds, b, 255 - p, tid, lane, wave); }
        if (PROBE_REP == 33) for (int it = blockIdx.x; it < 256; it += G) { const int b = it >> 7, p = it & 127; idx_item<true>(a, lds, b, p, tid, lane, wave); idx_item<true>(a, lds, b, 255 - p, tid, lane, wave); }
        REP(31) for (int it = blockIdx.x; it < 1024; it += G) hgrn_local_item(a, lds, it, tid, lane, wave);
        SEAM(3);
    }
    if (IN(4)) { phase4(a, tid, G); SEAM(4); }
    if (IN(5)) {
        const int vcu = (G % 8 == 0) ? (int)(blockIdx.x % 8) * (G / 8) + (int)(blockIdx.x / 8) : (int)blockIdx.x;
        REP(50) for (int it = vcu; it < 256; it += G) { const int bh = it >> 4, s = it & 15; attn_item<0>(a, lds, bh >> 3, bh & 7, s, tid, lane, wave); attn_item<0>(a, lds, bh >> 3, bh & 7, 31 - s, tid, lane, wave); }
        if (PROBE_REP >= 52 && PROBE_REP <= 55) for (int it = vcu; it < 256; it += G) { const int bh = it >> 4, s = it & 15; constexpr int DM_ = (PROBE_REP >= 52 && PROBE_REP <= 55) ? PROBE_REP - 51 : 1; attn_item<DM_>(a, lds, bh >> 3, bh & 7, s, tid, lane, wave); attn_item<DM_>(a, lds, bh >> 3, bh & 7, 31 - s, tid, lane, wave); }
        REP(51) for (int it = blockIdx.x; it < 1024; it += G) hgrn_out_item(a, lds, it, tid, lane, wave);
        SEAM(5);
    }
    if (IN(6)) {
        pg8::Gemm g{(const pg8::bf16_t*)(a.ws + WS_H), (const pg8::bf16_t*)(a.ws + WS_WOUT), MTOK, DM, DM}; pg8::StaticOrder S; S.init(MTOK, DM, G, (int)blockIdx.x);
        EpiOutProj E{a.in[IN_X], a.out, (const float*)(a.ws + WS_MODF)};
        TWICE(6, (pg8::gemm_phase<EpiOutProj, pg8::StaticOrder, false, true>(lds + RING_OFF, g, S, E)));
        SEAM(6);
    }
    if (IN(7)) { phase7(a, lds, tid, lane, wave, G); SEAM(7); }
    if (IN(8)) { phase8(a, lds, tid, lane, wave, G); SEAM(8); }
    if (IN(9)) {
        build_buckets(a, lds, tid);
        pg8::Gemm g{(const pg8::bf16_t*)(a.ws + WS_H2S), (const pg8::bf16_t*)(a.ws + WS_W13), NSROWS, 16 * 1024, DM};
        MoeSched1 S{(const LAS int*)(lds + MB_BLK), *(const LAS int*)(lds + MB_NBLK), G, (int)blockIdx.x};
        EpiMoe1 E{(bf16*)(a.ws + WS_HE), (const f32x2*)(a.ws + WS_WSORT)};
        TWICE(9, (pg8::gemm_phase<EpiMoe1, MoeSched1, true, true>(lds + RING_OFF, g, S, E)));
        SEAM(9);
    }
    if (IN(10)) {
        build_buckets(a, lds, tid);
        pg8::Gemm g{(const pg8::bf16_t*)(a.ws + WS_HE), (const pg8::bf16_t*)(a.ws + WS_W2), 2 * NSROWS, 16 * 1024, 512};
        MoeSched2 S{(const LAS int*)(lds + MB_BLK), *(const LAS int*)(lds + MB_NBLK), G, (int)blockIdx.x};
        EpiMoe2 E{a.out, (const float*)(a.ws + WS_MODF), (const int*)(a.ws + WS_STOK), (const LAS int*)(lds + MB_BLK), (const LAS int*)(lds + MB_BASE), (const LAS int*)(lds + MB_CNT)};
        pg8::gemm_phase<EpiMoe2, MoeSched2, false, true>(lds + RING_OFF, g, S, E);
    }
#undef IN
#undef SEAM
}

extern "C" void kernel_launch(void* const* d_in, const int* in_sizes, int n_in, void* d_out, int out_size, void* d_ws, size_t ws_size, hipStream_t stream) {
    static int grid = 0;
    if (grid == 0) {
        if (n_in != N_IN || in_sizes[0] != MTOK * DM || out_size != MTOK * DM || ws_size < WS_END) { fprintf(stderr, "kernel_launch: unexpected shapes (n_in %d, in0 %d, out %d, ws %zu); nothing launched\n", n_in, n_in > 0 ? in_sizes[0] : -1, out_size, ws_size); grid = -1; return; }
        int dev = 0, cus = 0, per_cu = 0;
        if (hipGetDevice(&dev) != hipSuccess || hipDeviceGetAttribute(&cus, hipDeviceAttributeMultiprocessorCount, dev) != hipSuccess) { grid = -1; return; }
        if (hipFuncSetAttribute((const void*)fwd, hipFuncAttributeMaxDynamicSharedMemorySize, LDS_BYTES) != hipSuccess) { fprintf(stderr, "kernel_launch: hipFuncSetAttribute failed\n"); grid = -1; return; }
        if (hipOccupancyMaxActiveBlocksPerMultiprocessor(&per_cu, (const void*)fwd, NWAVES * 64, LDS_BYTES) != hipSuccess || per_cu < 1) fprintf(stderr, "kernel_launch: occupancy query reports %d\n", per_cu);
        (void)hipGetLastError();
        grid = cus;
    }
    if (grid < 0) return;
    if (hipMemsetAsync((char*)d_ws + WS_CTL, 0, CTL_ZERO_BYTES, stream) != hipSuccess) return;
    Args a{};
    for (int i = 0; i < N_IN; ++i) a.in[i] = (const float*)d_in[i];
    a.out = (float*)d_out; a.ws = (unsigned char*)d_ws;
    constexpr int NL = MK_N_LAUNCHES;
    for (int li = 0; li < NL; ++li) {
        a.ph_lo = (NL == 1) ? 0 : li; a.ph_hi = (NL == 1) ? NPH : li + 1;
        hipLaunchKernelGGL(fwd, dim3(grid), dim3(NWAVES * 64), LDS_BYTES, stream, a);
        const hipError_t le = hipPeekAtLastError();
        if (le != hipSuccess) { fprintf(stderr, "kernel_launch: launch %d failed: %s\n", li, hipGetErrorName(le)); break; }
    }
}
```

```cpp
#include <hip/hip_runtime.h>
#include <cstdio>
#include <cstdint>
namespace pg8 {
#define PG8_LAS __attribute__((address_space(3)))
typedef unsigned short bf16_t;
typedef short bf16x8 __attribute__((ext_vector_type(8)));
typedef float f32x4 __attribute__((ext_vector_type(4)));
typedef unsigned u32x4 __attribute__((ext_vector_type(4)));
constexpr int BM = 256, BK = 64, HALF = 128, HTB = HALF * BK * 2  , STAGE_BYTES = 8 * HTB, NXCD = 8, WGM = 8;

__host__ __device__ __forceinline__ int lds_byte(int r, int c) { const int st = (r >> 4) * 2 + (c >> 5), rr = r & 15, cc = c & 31, ob = rr * 64 + cc * 2; return st * 1024 + (ob ^ (((ob >> 9) & 1) << 5)); }
__host__ __device__ __forceinline__ void stage_rc(int b, int& R, int& C) { const int st = b / 1024, sb = b % 1024, swz = sb ^ (((sb >> 9) & 1) << 5); R = (st >> 1) * 16 + swz / 64; C = (st & 1) * 32 + (swz % 64) / 2; }
__host__ __device__ __forceinline__ int perm32(int rho) { const int n = rho >> 4, i = rho & 15; return 8 * (i >> 2) + 4 * n + (i & 3); }

struct Unit { int pm, pn, aux, cont; };
struct Gemm { const bf16_t* A; const bf16_t* Bt; int M, N, K; };

struct StaticOrder {
    int nM, nN, nwg, G, c;
    __host__ __device__ void init(int M, int N, int G_, int c_) { nM = M / BM; nN = N / BM; nwg = nM * nN; G = G_; c = c_; }
    __host__ __device__ bool next(int i, Unit& u) const {
        const long L = (long)i * G + c; if (L >= nwg) return false;
        int wgid = (int)L; { const int q = nwg / NXCD, r = nwg % NXCD, xcd = wgid % NXCD, off = wgid / NXCD; wgid = (xcd < r ? xcd * (q + 1) : r * (q + 1) + (xcd - r) * q) + off; }
        const int nig = WGM * nN, gid = wgid / nig, fm = gid * WGM, gsz = (nM - fm) < WGM ? (nM - fm) : WGM;
        u.pm = fm + ((wgid % nig) % gsz); u.pn = (wgid % nig) / gsz; u.aux = 0; u.cont = 0; return true;
    }
    __device__ __forceinline__ void a_ready(const Unit&) const {}
    __device__ __forceinline__ void done(const Unit&) const {}
};

__device__ __forceinline__ unsigned cvt_pk_bf16(float lo, float hi) { unsigned r; asm volatile("v_cvt_pk_bf16_f32 %0, %1, %2" : "=v"(r) : "v"(lo), "v"(hi)); return r; }
typedef float f32x2 __attribute__((ext_vector_type(2)));

template <class Epi, class Sched, bool ALIGN_EPI = false, bool SP2 = false>
__device__ __forceinline__ void gemm_phase(PG8_LAS unsigned char* lds, const Gemm g, const Sched& S, const Epi& E) {
    const int tid = threadIdx.x, wid = __builtin_amdgcn_readfirstlane(tid >> 6), lane = tid & 63, wr = wid >> 2, wc = wid & 3, fr = lane & 15, fq = lane >> 4;
    const int K = g.K, nt = K / BK;
    unsigned voffA[2], voffB[2];
#pragma unroll
    for (int i = 0; i < 2; ++i) { int R, C; stage_rc(tid * 16 + i * 8192, R, C); const int Rb = Epi::PERM ? ((R & ~31) + perm32(R & 31)) : R;
        voffA[i] = (unsigned)(R * K + C) * 2u; voffB[i] = (unsigned)(Rb * K + C) * 2u; }
    const size_t kstep = (size_t)(BK * 2);
    const size_t hstep = (size_t)HALF * K * 2;
    const size_t tstep = 2 * hstep;
    const unsigned ldsw = (unsigned)wid * 1024u;
    const int aoff = lds_byte(wr * 64 + fr, fq * 8), boff = lds_byte(wc * 32 + fr, fq * 8);
#define PG8_SA(b, h) (((b) * 2 + (h)) * HTB)
#define PG8_SB(b, h) ((4 + (b) * 2 + (h)) * HTB)
#define PG8_STAGE(bufoff, gbase, voff) do { _Pragma("unroll") for (int _i = 0; _i < 2; ++_i) \
        __builtin_amdgcn_global_load_lds((const unsigned*)((const char*)(gbase) + (voff)[_i]), (PG8_LAS unsigned*)(lds + (bufoff) + ldsw + _i * 8192), 16, 0, 0); } while (0)
#define PG8_LDA(dst, b, h) do { _Pragma("unroll") for (int m = 0; m < 4; ++m) _Pragma("unroll") for (int k = 0; k < 2; ++k) dst[m][k] = *(const PG8_LAS bf16x8*)(lds + PG8_SA(b, h) + aoff + m * 2048 + k * 1024); } while (0)
#define PG8_LDB(dst, b, h) do { _Pragma("unroll") for (int n = 0; n < 2; ++n) _Pragma("unroll") for (int k = 0; k < 2; ++k) dst[n][k] = *(const PG8_LAS bf16x8*)(lds + PG8_SB(b, h) + boff + n * 2048 + k * 1024); } while (0)
#define PG8_MMA(ai, bj, At, Bt) do { __builtin_amdgcn_s_setprio(1); _Pragma("unroll") for (int m = 0; m < 4; ++m) _Pragma("unroll") for (int n = 0; n < 2; ++n) _Pragma("unroll") for (int k = 0; k < 2; ++k) \
        acc[ai][bj][m][n] = __builtin_amdgcn_mfma_f32_16x16x32_bf16(Bt[n][k], At[m][k], acc[ai][bj][m][n], 0, 0, 0); __builtin_amdgcn_s_setprio(0); } while (0)
#define PG8_WAIT_V(n) asm volatile("s_waitcnt vmcnt(" #n ")" ::: "memory")
#define PG8_WAIT_L(n) asm volatile("s_waitcnt lgkmcnt(" #n ")" ::: "memory")
#define PG8_BAR __builtin_amdgcn_s_barrier()
#define PG8_SCHED __builtin_amdgcn_sched_barrier(0)
    Unit cur, nxt; int ui = 0;
    if (!S.next(0, cur)) return;
    f32x4 acc[2][2][4][2];
#pragma unroll
    for (int a = 0; a < 2; ++a)
#pragma unroll
        for (int b = 0; b < 2; ++b)
#pragma unroll
            for (int m = 0; m < 4; ++m)
#pragma unroll
                for (int n = 0; n < 2; ++n) acc[a][b][m][n] = (f32x4){0.f, 0.f, 0.f, 0.f};
    bf16x8 At[4][2], B0[2][2], B1[2][2];
    const char* cA = (const char*)g.A + (size_t)cur.pm * tstep; const char* cB = (const char*)g.Bt + (size_t)cur.pn * tstep;
    S.a_ready(cur);
    if constexpr (SP2) {
        PG8_STAGE(PG8_SB(0, 0), cB, voffB); PG8_STAGE(PG8_SB(0, 1), cB + hstep, voffB); PG8_STAGE(PG8_SA(0, 0), cA, voffA); PG8_STAGE(PG8_SA(0, 1), cA + hstep, voffA);
        if (wr == 1) PG8_BAR;
        PG8_WAIT_V(2); PG8_BAR;
        PG8_STAGE(PG8_SB(1, 0), cB + kstep, voffB); PG8_STAGE(PG8_SA(1, 0), cA + kstep, voffA); PG8_STAGE(PG8_SB(1, 1), cB + hstep + kstep, voffB);
        PG8_WAIT_V(6); PG8_BAR;
    } else {
        PG8_STAGE(PG8_SB(0, 0), cB, voffB); PG8_STAGE(PG8_SA(0, 0), cA, voffA); PG8_STAGE(PG8_SB(0, 1), cB + hstep, voffB); PG8_STAGE(PG8_SA(0, 1), cA + hstep, voffA);
        if (wr == 1) PG8_BAR;
        PG8_WAIT_V(4); PG8_BAR;
        PG8_STAGE(PG8_SB(1, 0), cB + kstep, voffB); PG8_STAGE(PG8_SA(1, 0), cA + kstep, voffA); PG8_STAGE(PG8_SB(1, 1), cB + hstep + kstep, voffB);
        PG8_WAIT_V(6); PG8_BAR;
    }
    for (;;) {
        const bool has_next = S.next(ui + 1, nxt);
        const char* nA = has_next ? (const char*)g.A + (size_t)nxt.pm * tstep : cA; const char* nB = has_next ? (const char*)g.Bt + (size_t)nxt.pn * tstep : cB;
        for (int t = 0; t < nt; t += 2) {
            const bool last = (t == nt - 2);
            const char* a1 = cA + (size_t)(t + 1) * kstep;
            const char* a2 = last ? nA : cA + (size_t)(t + 2) * kstep; const char* b2 = last ? nB : cB + (size_t)(t + 2) * kstep;
            const char* a3 = a2 + kstep; const char* b3 = b2 + kstep;
            if (last && has_next) S.a_ready(nxt);
            if constexpr (SP2) {
            PG8_LDB(B0, 0, 0); PG8_LDB(B1, 0, 1); PG8_SCHED; PG8_LDA(At, 0, 0); PG8_STAGE(PG8_SA(1, 1), a1 + hstep, voffA);
            PG8_WAIT_V(8); PG8_WAIT_L(0); PG8_BAR; PG8_MMA(0, 0, At, B0); PG8_MMA(0, 1, At, B1); PG8_BAR; PG8_SCHED;
            PG8_LDA(At, 0, 1); PG8_STAGE(PG8_SB(0, 0), b2, voffB); PG8_STAGE(PG8_SB(0, 1), b2 + hstep, voffB); PG8_STAGE(PG8_SA(0, 0), a2, voffA);
            PG8_WAIT_V(8); PG8_WAIT_L(0); PG8_BAR; PG8_MMA(1, 0, At, B0); PG8_MMA(1, 1, At, B1); PG8_BAR; PG8_SCHED;
            PG8_LDB(B0, 1, 0); PG8_LDB(B1, 1, 1); PG8_SCHED; PG8_LDA(At, 1, 0); PG8_STAGE(PG8_SA(0, 1), a2 + hstep, voffA);
            PG8_WAIT_V(8); PG8_WAIT_L(0); PG8_BAR; PG8_MMA(0, 0, At, B0); PG8_MMA(0, 1, At, B1); PG8_BAR; PG8_SCHED;
            PG8_LDA(At, 1, 1); PG8_STAGE(PG8_SB(1, 0), b3, voffB); PG8_STAGE(PG8_SB(1, 1), b3 + hstep, voffB); PG8_STAGE(PG8_SA(1, 0), a3, voffA);
            PG8_WAIT_V(8); PG8_WAIT_L(0); PG8_BAR; PG8_MMA(1, 0, At, B0); PG8_MMA(1, 1, At, B1); PG8_BAR; PG8_SCHED;
            } else {
            PG8_LDB(B0, 0, 0); PG8_SCHED; PG8_LDA(At, 0, 0); PG8_STAGE(PG8_SA(1, 1), a1 + hstep, voffA);
            PG8_WAIT_L(8); PG8_BAR; PG8_WAIT_L(0); PG8_MMA(0, 0, At, B0); PG8_BAR; PG8_SCHED;
            PG8_LDB(B1, 0, 1); PG8_STAGE(PG8_SB(0, 0), b2, voffB);
            PG8_BAR; PG8_WAIT_L(0); PG8_MMA(0, 1, At, B1); PG8_BAR;
            PG8_LDA(At, 0, 1); PG8_STAGE(PG8_SA(0, 0), a2, voffA);
            PG8_BAR; PG8_WAIT_L(0); PG8_MMA(1, 0, At, B0); PG8_BAR; PG8_SCHED;
            PG8_STAGE(PG8_SB(0, 1), b2 + hstep, voffB);
            PG8_WAIT_V(6); PG8_BAR; PG8_MMA(1, 1, At, B1); PG8_BAR;
            PG8_LDB(B0, 1, 0); PG8_SCHED; PG8_LDA(At, 1, 0); PG8_STAGE(PG8_SA(0, 1), a2 + hstep, voffA);
            PG8_WAIT_L(8); PG8_BAR; PG8_WAIT_L(0); PG8_MMA(0, 0, At, B0); PG8_BAR; PG8_SCHED;
            PG8_LDB(B1, 1, 1); PG8_STAGE(PG8_SB(1, 0), b3, voffB);
            PG8_BAR; PG8_WAIT_L(0); PG8_MMA(0, 1, At, B1); PG8_BAR;
            PG8_LDA(At, 1, 1); PG8_STAGE(PG8_SA(1, 0), a3, voffA);
            PG8_BAR; PG8_WAIT_L(0); PG8_MMA(1, 0, At, B0); PG8_BAR; PG8_SCHED;
            PG8_STAGE(PG8_SB(1, 1), b3 + hstep, voffB);
            PG8_WAIT_V(6); PG8_BAR; PG8_MMA(1, 1, At, B1); PG8_BAR;
            }
        }
        if constexpr (ALIGN_EPI) { if (wr == 0) PG8_BAR; }
        if constexpr (!Epi::AFTER_DRAIN) { if (!cur.cont) E(acc, cur, wr, wc, fr, fq); S.done(cur); }
        if (!has_next) break;
        if (!cur.cont)
#pragma unroll
        for (int a = 0; a < 2; ++a)
#pragma unroll
            for (int b = 0; b < 2; ++b)
#pragma unroll
                for (int m = 0; m < 4; ++m)
#pragma unroll
                    for (int n = 0; n < 2; ++n) acc[a][b][m][n] = (f32x4){0.f, 0.f, 0.f, 0.f};
        cur = nxt; cA = nA; cB = nB; ++ui;
        if constexpr (ALIGN_EPI) { if (wr == 1) PG8_BAR; }
    }
    PG8_WAIT_V(0);
    if constexpr (!ALIGN_EPI) { if (wr == 0) PG8_BAR; }
    PG8_BAR;
    if constexpr (Epi::AFTER_DRAIN) { E.fused(acc, cur, wr, wc, fr, fq, lds, wid, lane); S.done(cur); }
#undef PG8_SA
#undef PG8_SB
#undef PG8_STAGE
#undef PG8_LDA
#undef PG8_LDB
#undef PG8_MMA
#undef PG8_WAIT_V
#undef PG8_WAIT_L
#undef PG8_BAR
#undef PG8_SCHED
}
}

#define GAS __attribute__((address_space(1)))
#define LAS __attribute__((address_space(3)))
typedef unsigned short bf16;
typedef unsigned v4u __attribute__((ext_vector_type(4)));
typedef float f32x4 __attribute__((ext_vector_type(4)));
typedef short bf16x8 __attribute__((ext_vector_type(8)));
typedef GAS unsigned gu32;
typedef GAS unsigned long long gu64;
#define RLX_AGENT __ATOMIC_RELAXED, __HIP_MEMORY_SCOPE_AGENT
#define LDS_WAIT() asm volatile("s_waitcnt lgkmcnt(0)" ::: "memory")
#define VM_WAIT() asm volatile("s_waitcnt vmcnt(0)" ::: "memory")
__device__ __forceinline__ unsigned long long rt() { return __builtin_amdgcn_s_memrealtime(); }
__device__ __forceinline__ unsigned f2bf(float f) { unsigned u = __builtin_bit_cast(unsigned, f); return (u + 0x7fffu + ((u >> 16) & 1u)) >> 16; }
__device__ __forceinline__ unsigned pk2(float lo, float hi) { return f2bf(lo) | (f2bf(hi) << 16); }

#define XB_TMO      128
#define XB_XCNT(j)  (256  + 64 * (j))
#define XB_XSUB(j)  (1280 + 64 * (j))
#define XB_XGEN(j)  (2304 + 64 * (j))
#define XB_TOP      3328
#define XB_TOPGEN   3392
#define XCD_BAR_WORDS 3456
#define XB_SPIN_CAP (1u << 18)

__device__ __forceinline__ unsigned xb_ld(unsigned* p)              { return __hip_atomic_load(p, __ATOMIC_RELAXED, __HIP_MEMORY_SCOPE_AGENT); }
__device__ __forceinline__ unsigned xb_add(unsigned* p, unsigned v) { return __hip_atomic_fetch_add(p, v, __ATOMIC_RELAXED, __HIP_MEMORY_SCOPE_AGENT); }
__device__ __forceinline__ unsigned xb_xcc_id() { return (unsigned)__builtin_amdgcn_s_getreg((3 << 11) | 20) & 0xFu; }
#define XB_SPIN(cond, bar) do { unsigned _sp = 0; while (cond) { __builtin_amdgcn_s_sleep(1); \
    if ((++_sp & 255u) == 0u) { if (xb_ld(&(bar)[XB_TMO])) break; if (_sp > XB_SPIN_CAP) { atomicAdd(&(bar)[XB_TMO], 1u); break; } } } } while (0)

struct XcdBarrier {
    unsigned* bar; unsigned x;
    volatile LAS unsigned* st;
};

__device__ __forceinline__ XcdBarrier xcd_barrier_post(unsigned* bar, volatile LAS unsigned* st) {
    XcdBarrier b; b.bar = bar; b.x = xb_xcc_id(); b.st = st;
    if (threadIdx.x == 0) (void)xb_add(&bar[XB_XCNT(b.x)], 1u);
    return b;
}
__device__ __forceinline__ void xcd_barrier_complete(unsigned* bar, unsigned x, unsigned& nloc, unsigned& nx) {
    const unsigned G = gridDim.x * gridDim.y * gridDim.z;
    unsigned sum, cnt, mine, sp = 0u;
    for (;;) {
        sum = 0u; cnt = 0u; mine = 0u;
#pragma unroll
        for (unsigned j = 0; j < 16; ++j) { const unsigned c = xb_ld(&bar[XB_XCNT(j)]); sum += c; cnt += (c > 0u) ? 1u : 0u; mine = (j == x) ? c : mine; }
        if (sum == G) break;
        __builtin_amdgcn_s_sleep(1);
        if ((++sp & 255u) == 0u) { if (xb_ld(&bar[XB_TMO])) break; if (sp > XB_SPIN_CAP) { atomicAdd(&bar[XB_TMO], 1u); break; } }
    }
    nloc = mine > 0u ? mine : 1u; nx = cnt > 0u ? cnt : 1u;
}

__device__ __forceinline__ void xcd_barrier(const XcdBarrier& b) {
    asm volatile("s_waitcnt vmcnt(0)" ::: "memory");
    __syncthreads();
    if (threadIdx.x == 0) {
        unsigned* bar = b.bar;
        __builtin_amdgcn_s_waitcnt(0);
        unsigned nloc = b.st[0], nx = b.st[1];
        if (nloc == 0u) { xcd_barrier_complete(bar, b.x, nloc, nx); b.st[0] = nloc; b.st[1] = nx; }
        const unsigned old = xb_add(&bar[XB_XSUB(b.x)], 1u);
        const unsigned gen = old / nloc;
        if (old + 1u == (gen + 1u) * nloc) {
            __builtin_amdgcn_fence(__ATOMIC_RELEASE, "agent");
            asm volatile("s_waitcnt vmcnt(0)" ::: "memory");
            const unsigned og = xb_add(&bar[XB_TOP], 1u);
            const unsigned tg = og / nx;
            if (og + 1u == (tg + 1u) * nx) xb_add(&bar[XB_TOPGEN], 1u);
            else XB_SPIN(xb_ld(&bar[XB_TOPGEN]) == tg, bar);
            __builtin_amdgcn_fence(__ATOMIC_ACQUIRE, "agent");
            xb_add(&bar[XB_XGEN(b.x)], 1u);
            asm volatile("s_waitcnt vmcnt(0)" ::: "memory");
        } else {
            XB_SPIN(xb_ld(&bar[XB_XGEN(b.x)]) == gen, bar);
            __builtin_amdgcn_fence(__ATOMIC_ACQUIRE, "agent");
            asm volatile("s_waitcnt vmcnt(0)" ::: "memory");
        }
    }
    __syncthreads();
}


#ifndef PROBE_REP
#define PROBE_REP -1
#endif
constexpr int NB = 2, SEQ = 8192, MTOK = NB * SEQ, DM = 1024, DIN = 4168, NINP = 4352;
constexpr int NCOMBO = 24, NROWBLK = 88, NSROWS = NROWBLK * 256;
constexpr float EPS = 1e-6f, LOG2E = 1.4426950408889634f, LN2 = 0.6931471805599453f, QSCALE = 0.125f * 1.4426950408889634f;
enum { IN_X = 0, IN_C, IN_WADA, IN_BADA, IN_N1G, IN_N2G, IN_WIN, IN_LBL, IN_RECG, IN_QG, IN_KG, IN_IKG, IN_IKB, IN_ATTG, IN_RELB, IN_WOUT, IN_WRG, IN_BRG, IN_WRE, IN_BRE, IN_W1, IN_W3, IN_W2, N_IN };

constexpr size_t MiB = 1u << 20;
constexpr size_t WS_CTL = 0, CTL_ZERO_BYTES = 1 * MiB;
constexpr size_t WS_MODP = 1 * MiB;
constexpr size_t WS_MODF = 1 * MiB + 512 * 1024;
constexpr size_t WS_WIN = 2 * MiB;
constexpr size_t WS_WOUT = 11 * MiB;
constexpr size_t WS_W13 = 13 * MiB;
constexpr size_t WS_W2 = 45 * MiB;
constexpr size_t WS_LS = 13 * MiB;
constexpr size_t WS_MASK = 45 * MiB;
constexpr size_t WS_H = 61 * MiB;
constexpr size_t WS_QR = 93 * MiB, WS_LF = 109 * MiB, WS_VR = 141 * MiB, WS_GR = 157 * MiB, WS_AQ = 173 * MiB, WS_AK = 189 * MiB, WS_AV = 205 * MiB, WS_IQ = 221 * MiB;
constexpr size_t WS_IK = 237 * MiB, WS_IW = 239 * MiB, WS_DEC = 239 * MiB + 512 * 1024;
constexpr size_t WS_ROUTE = 240 * MiB;
constexpr size_t WS_STOK = 241 * MiB;
constexpr size_t WS_WSORT = 242 * MiB;
constexpr size_t WS_H2S = 93 * MiB;
constexpr size_t WS_HE = 141 * MiB;
constexpr size_t WS_END = 256 * MiB;
static_assert(WS_H2S + (size_t)NSROWS * 1024 * 2 <= WS_HE && WS_HE + (size_t)NSROWS * 1024 * 2 <= WS_ROUTE && WS_WSORT + NSROWS * 8 <= WS_END, "ws map");
constexpr int CW_FAIL = 16;
constexpr int CW_BAR = 4096;
constexpr int CW_CNT = 8192, CW_CUR = 8192 + 64;

constexpr int RING_OFF = 0, RING_BYTES = 131072, MISC_OFF = 147456, LDS_BYTES = 163840;
constexpr int NWAVES = 8, NPH = 11;

typedef float f32x16 __attribute__((ext_vector_type(16)));
typedef float f32x2 __attribute__((ext_vector_type(2)));
typedef unsigned v2u __attribute__((ext_vector_type(2)));
typedef short v4i16_t __attribute__((ext_vector_type(4)));
typedef short s16x4 __attribute__((ext_vector_type(4)));

struct Args { const float* in[N_IN]; float* out; unsigned char* ws; int ph_lo, ph_hi; };

__device__ __forceinline__ float wave_sum(float v) {
#pragma unroll
    for (int o = 1; o < 64; o <<= 1) v += __shfl_xor(v, o);
    return v;
}
__device__ __forceinline__ float bf2f(unsigned short h) { return __uint_as_float((unsigned)h << 16); }
__device__ __forceinline__ float bflo(unsigned w) { return __uint_as_float(w << 16); }
__device__ __forceinline__ float bfhi(unsigned w) { return __uint_as_float(w & 0xffff0000u); }
__device__ __forceinline__ unsigned cvtpk(float lo, float hi) { unsigned r; asm volatile("v_cvt_pk_bf16_f32 %0, %1, %2" : "=v"(r) : "v"(lo), "v"(hi)); return r; }
typedef float f32x2_t __attribute__((ext_vector_type(2))); typedef __bf16 bf16x2_t __attribute__((ext_vector_type(2)));
__device__ __forceinline__ unsigned cvtpk_s(float lo, float hi) { f32x2_t v = {lo, hi}; bf16x2_t b = __builtin_convertvector(v, bf16x2_t); return __builtin_bit_cast(unsigned, b); }
__device__ __forceinline__ float fexp2(float x) { return __builtin_amdgcn_exp2f(x); }
__device__ __forceinline__ float fexp(float x) { return __builtin_amdgcn_exp2f(x * LOG2E); }
__device__ __forceinline__ float flog(float x) { return __builtin_amdgcn_logf(x) * LN2; }
__device__ __forceinline__ float frcp(float x) { return __builtin_amdgcn_rcpf(x); }
__device__ __forceinline__ float frsq(float x) { return __builtin_amdgcn_rsqf(x); }
__device__ __forceinline__ float silu_f(float v) { return v * frcp(1.f + fexp(-v)); }
__device__ __forceinline__ float sigm_f(float v) { return frcp(1.f + fexp(-v)); }
__device__ __forceinline__ int crow(int r, int hi) { return (r & 3) + 8 * (r >> 2) + 4 * hi; }
#define MFMA32(a, b, c) __builtin_amdgcn_mfma_f32_32x32x16_bf16((a), (b), (c), 0, 0, 0)

struct WinMap { __device__ __forceinline__ int operator()(int n) const {
    if (n < 2048) return n;
    if (n < 3072) { const int j = (n - 2048) & 511, seg = (n - 2048) >> 9, h = j >> 6, d = j & 63; return (8 + seg * 2 + (h >> 2)) * 256 + 128 * (d >> 5) + 32 * (h & 3) + (d & 31); }
    if (n < 4096) return n;
    if (n < 4160) { const int d = n - 4096; return 16 * 256 + 128 * (d >> 5) + (d & 31); }
    return 16 * 256 + 32 + (n - 4160); } };
struct OffMap { int off; __device__ __forceinline__ int operator()(int n) const { return off + n; } };
struct W13Map { int base; __device__ __forceinline__ int operator()(int n) const { return base + (n >> 7) * 256 + (n & 127); } };

template <class Map>
__device__ __forceinline__ void transpose_item(const float* W, int N, bf16* WT, int ldt, const Map map, LAS float* scr, int item, int lane) {
    const int nblk = (N + 31) / 32, kb = item / nblk, nb = item % nblk, k0 = 64 * kb, n0 = 32 * nb;
    const bool inb = (n0 + (lane & 31)) < N;
    float tv[32];
#pragma unroll
    for (int i = 0; i < 32; ++i) { const int kk = 2 * i + (lane >> 5); tv[i] = inb ? __builtin_nontemporal_load(W + (size_t)(k0 + kk) * N + n0 + (lane & 31)) : 0.f; }
#pragma unroll
    for (int i = 0; i < 32; ++i) { const int kk = 2 * i + (lane >> 5); scr[kk * 33 + (lane & 31)] = tv[i]; }
    LDS_WAIT(); asm volatile("" ::: "memory");
    const int c = lane & 7;
#pragma unroll
    for (int j = 0; j < 4; ++j) { const int n = (lane >> 3) + 8 * j; const LAS float* s = scr + (8 * c) * 33 + n;
        v4u o; o.x = pk2(s[0 * 33], s[1 * 33]); o.y = pk2(s[2 * 33], s[3 * 33]); o.z = pk2(s[4 * 33], s[5 * 33]); o.w = pk2(s[6 * 33], s[7 * 33]);
        if (n0 + n < N) *(GAS v4u*)(WT + (size_t)map(n0 + n) * ldt + k0 + 8 * c) = o; }
    LDS_WAIT(); asm volatile("" ::: "memory");
}

__device__ __forceinline__ void phase0(const Args& a, LAS unsigned char* lds, int tid, int lane, int wave, int G) {
    const float* wada = a.in[IN_WADA]; const float* cvec = a.in[IN_C]; float* modp = (float*)(a.ws + WS_MODP);
    for (int it = blockIdx.x; it < 192; it += G) {
        const int ks = it / 24, cg = it % 24, k0 = ks * 128 + wave * 16, col = cg * 256 + 4 * lane;
        f32x4 a0 = {0.f, 0.f, 0.f, 0.f}, a1 = {0.f, 0.f, 0.f, 0.f};
#pragma unroll 4
        for (int r = 0; r < 16; ++r) { const int k = k0 + r; const float s0 = silu_f(cvec[k]), s1 = silu_f(cvec[1024 + k]);
            const f32x4 w = *(const GAS f32x4*)(wada + (size_t)k * 6144 + col); a0 += w * s0; a1 += w * s1; }
        LAS float* red = (LAS float*)lds;
        *(LAS f32x4*)(red + wave * 512 + 4 * lane) = a0; *(LAS f32x4*)(red + wave * 512 + 256 + 4 * lane) = a1;
        __syncthreads();
        { float s = 0.f;
#pragma unroll
          for (int w = 0; w < 8; ++w) s += red[w * 512 + tid];
          const int b = tid >> 8, cc = tid & 255; modp[(size_t)(ks * 2 + b) * 6144 + cg * 256 + cc] = s; }
        __syncthreads();
    }
    LAS float* scr = (LAS float*)(lds + wave * 16384);
    const int gw = blockIdx.x * NWAVES + wave, NGW = G * NWAVES;
    constexpr int I_IN = 16 * 131, I_OUT = 16 * 32, I_Z = 256;
    bf16* win = (bf16*)(a.ws + WS_WIN); bf16* wout = (bf16*)(a.ws + WS_WOUT);
    for (int it = gw; it < I_IN + I_OUT + I_Z; it += NGW) {
        int r = it;
        if (r < I_IN) { transpose_item(a.in[IN_WIN], DIN, win, 1024, WinMap{}, scr, r, lane); continue; } r -= I_IN;
        if (r < I_OUT) { transpose_item(a.in[IN_WOUT], 1024, wout, 1024, OffMap{0}, scr, r, lane); continue; } r -= I_OUT;
        { const bool valid = (r < 40) || (r >= 128 && r < 160);
          if (!valid) { GAS v4u* p = (GAS v4u*)(win + (size_t)(16 * 256 + r) * 1024) + lane; const v4u z = {0u, 0u, 0u, 0u}; p[0] = z; p[64] = z; } }
    }
}

__device__ __forceinline__ void moe_weight_items(const Args& a, LAS float* scr, int gw, int NGW, int lane) {
    bf16* w13 = (bf16*)(a.ws + WS_W13); bf16* w2t = (bf16*)(a.ws + WS_W2);
    constexpr int I_1 = 16 * 16, I_2 = 8 * 32;
    for (int it = gw; it < 16 * (2 * I_1 + I_2); it += NGW) {
        const int e = it / (2 * I_1 + I_2); int r = it % (2 * I_1 + I_2);
        if (r < I_1) { transpose_item(a.in[IN_W1] + (size_t)e * 1024 * 512, 512, w13, 1024, W13Map{e * 1024}, scr, r, lane); continue; } r -= I_1;
        if (r < I_1) { transpose_item(a.in[IN_W3] + (size_t)e * 1024 * 512, 512, w13, 1024, W13Map{e * 1024 + 128}, scr, r, lane); continue; } r -= I_1;
        transpose_item(a.in[IN_W2] + (size_t)e * 512 * 1024, 1024, w2t, 512, OffMap{e * 1024}, scr, r, lane);
    }
}

__device__ __forceinline__ void phase1(const Args& a, LAS unsigned char* lds, int tid, int lane, int wave, int G) {
    LAS float* A1 = (LAS float*)lds; LAS float* S1 = A1 + 2048;
    const float* modp = (const float*)(a.ws + WS_MODP); const float* bada = a.in[IN_BADA]; const float* g = a.in[IN_N1G];
    for (int idx = tid; idx < 2048; idx += 512) { const int b = idx >> 10, i = idx & 1023; float sh = bada[i], sc = bada[1024 + i];
#pragma unroll
        for (int ks = 0; ks < 8; ++ks) { sh += modp[(size_t)(ks * 2 + b) * 6144 + i]; sc += modp[(size_t)(ks * 2 + b) * 6144 + 1024 + i]; }
        A1[idx] = g[i] * (1.f + sc); S1[idx] = sh; }
    float* modf = (float*)(a.ws + WS_MODF);
    for (int idx = blockIdx.x * 512 + tid; idx < 12288; idx += G * 512) { const int b = idx / 6144, j = idx % 6144; float s = bada[j];
#pragma unroll
        for (int ks = 0; ks < 8; ++ks) s += modp[(size_t)(ks * 2 + b) * 6144 + j];
        modf[idx] = s; }
    __syncthreads();
    const int gw = blockIdx.x * NWAVES + wave, NGW = G * NWAVES;
    const float* x = a.in[IN_X]; bf16* H = (bf16*)(a.ws + WS_H);
    for (int m = gw; m < MTOK; m += NGW) {
        const int b = m >> 13; const GAS f32x4* xr = (const GAS f32x4*)(x + (size_t)m * DM) + lane;
        f32x4 v[4]; float s = 0.f;
#pragma unroll
        for (int j = 0; j < 4; ++j) { v[j] = xr[64 * j]; s += (v[j].x * v[j].x + v[j].y * v[j].y) + (v[j].z * v[j].z + v[j].w * v[j].w); }
        const float r = frsq(wave_sum(s) * (1.f / DM) + EPS);
        GAS v2u* o8 = (GAS v2u*)(H + (size_t)m * DM) + lane;
#pragma unroll
        for (int j = 0; j < 4; ++j) { const f32x4 aa = *(LAS f32x4*)(A1 + b * 1024 + 256 * j + 4 * lane), ss = *(LAS f32x4*)(S1 + b * 1024 + 256 * j + 4 * lane);
            const f32x4 h = v[j] * r * aa + ss; v2u w; w.x = cvtpk(h.x, h.y); w.y = cvtpk(h.z, h.w); o8[64 * j] = w; }
    }
}

struct EpiInProj {
    static constexpr bool PERM = true, AFTER_DRAIN = false;
    unsigned char* ws; const float *lbl, *qg, *kg, *ikg, *ikb;
    __device__ __forceinline__ void operator()(const pg8::f32x4 (&acc)[2][2][4][2], const pg8::Unit& u, int wr, int wc, int fr, int fq) const {
        const int pn = u.pn, row0 = u.pm * 256 + wr * 64 + fr;
        if (pn < 2 || (pn >= 4 && pn < 8) || (pn >= 12 && pn < 16)) {
            size_t off; int ct; bool act;
            if (pn < 2) { off = WS_QR; ct = pn; act = true; } else if (pn < 6) { off = WS_VR; ct = pn - 4; act = false; } else if (pn < 8) { off = WS_GR; ct = pn - 6; act = true; }
            else if (pn < 14) { off = WS_AV; ct = pn - 12; act = false; } else { off = WS_IQ; ct = pn - 14; act = false; }
            bf16* dst = (bf16*)(ws + off); const int col0 = ct * 256 + wc * 32 + 8 * fq;
#pragma unroll
            for (int ai = 0; ai < 2; ++ai)
#pragma unroll
                for (int m = 0; m < 4; ++m) { bf16* rowp = dst + (size_t)(row0 + ai * 128 + m * 16) * 512 + col0;
#pragma unroll
                    for (int bj = 0; bj < 2; ++bj) { pg8::f32x4 v0 = acc[ai][bj][m][0], v1 = acc[ai][bj][m][1];
                        if (act) { v0 = (pg8::f32x4){silu_f(v0[0]), silu_f(v0[1]), silu_f(v0[2]), silu_f(v0[3])}; v1 = (pg8::f32x4){silu_f(v1[0]), silu_f(v1[1]), silu_f(v1[2]), silu_f(v1[3])}; }
                        v4u w; w.x = cvtpk(v0[0], v0[1]); w.y = cvtpk(v0[2], v0[3]); w.z = cvtpk(v1[0], v1[1]); w.w = cvtpk(v1[2], v1[3]);
                        *(GAS v4u*)(rowp + bj * 128) = w; } }
        } else if (pn < 4) {
            float* dst = (float*)(ws + WS_LF); const int col0 = (pn - 2) * 256 + wc * 32 + 8 * fq;
            float lb[2][8];
#pragma unroll
            for (int bj = 0; bj < 2; ++bj)
#pragma unroll
                for (int j = 0; j < 8; ++j) { const int c = col0 + bj * 128 + j; lb[bj][j] = frcp(1.f + fexp(lbl[512 + c] - lbl[c])); }
#pragma unroll
            for (int ai = 0; ai < 2; ++ai)
#pragma unroll
                for (int m = 0; m < 4; ++m) { float* rowp = dst + (size_t)(row0 + ai * 128 + m * 16) * 512 + col0;
#pragma unroll
                    for (int bj = 0; bj < 2; ++bj) { f32x4 o0, o1;
#pragma unroll
                        for (int j = 0; j < 4; ++j) { const float l0 = lb[bj][j], l1 = lb[bj][4 + j];
                            o0[j] = flog(l0 + (1.f - l0) * sigm_f(acc[ai][bj][m][0][j])); o1[j] = flog(l1 + (1.f - l1) * sigm_f(acc[ai][bj][m][1][j])); }
                        *(GAS f32x4*)(rowp + bj * 128) = o0; *(GAS f32x4*)(rowp + bj * 128 + 4) = o1; } }
        } else if (pn < 12) {
            const int seg = (pn - 8) >> 1, head = ((pn - 8) & 1) * 4 + wc; const float* gs = seg ? kg : qg; const float sc = seg ? 1.f : QSCALE;
            bf16* dst = (bf16*)(ws + (seg ? WS_AK : WS_AQ));
            f32x4 gv[2][2];
#pragma unroll
            for (int bj = 0; bj < 2; ++bj)
#pragma unroll
                for (int n = 0; n < 2; ++n) gv[bj][n] = *(const f32x4*)(gs + 32 * bj + 8 * fq + 4 * n) * sc;
#pragma unroll
            for (int ai = 0; ai < 2; ++ai)
#pragma unroll
                for (int m = 0; m < 4; ++m) { float ss = 0.f;
#pragma unroll
                    for (int bj = 0; bj < 2; ++bj)
#pragma unroll
                        for (int n = 0; n < 2; ++n) { const pg8::f32x4 v = acc[ai][bj][m][n]; ss += (v[0] * v[0] + v[1] * v[1]) + (v[2] * v[2] + v[3] * v[3]); }
                    ss += __shfl_xor(ss, 16); ss += __shfl_xor(ss, 32);
                    const float ri = frsq(ss * (1.f / 64.f) + EPS);
                    bf16* rowp = dst + (size_t)(row0 + ai * 128 + m * 16) * 512 + head * 64 + 8 * fq;
#pragma unroll
                    for (int bj = 0; bj < 2; ++bj) { const f32x4 v0 = acc[ai][bj][m][0] * ri * gv[bj][0], v1 = acc[ai][bj][m][1] * ri * gv[bj][1];
                        v4u w; w.x = cvtpk(v0[0], v0[1]); w.y = cvtpk(v0[2], v0[3]); w.z = cvtpk(v1[0], v1[1]); w.w = cvtpk(v1[2], v1[3]);
                        *(GAS v4u*)(rowp + bj * 32) = w; } }
        } else {
            if (wc == 0) {
                bf16* dst = (bf16*)(ws + WS_IK); f32x4 gv[2][2], bv[2][2];
#pragma unroll
                for (int bj = 0; bj < 2; ++bj)
#pragma unroll
                    for (int n = 0; n < 2; ++n) { gv[bj][n] = *(const f32x4*)(ikg + 32 * bj + 8 * fq + 4 * n); bv[bj][n] = *(const f32x4*)(ikb + 32 * bj + 8 * fq + 4 * n); }
#pragma unroll
                for (int ai = 0; ai < 2; ++ai)
#pragma unroll
                    for (int m = 0; m < 4; ++m) { float s = 0.f;
#pragma unroll
                        for (int bj = 0; bj < 2; ++bj)
#pragma unroll
                            for (int n = 0; n < 2; ++n) { const pg8::f32x4 v = acc[ai][bj][m][n]; s += (v[0] + v[1]) + (v[2] + v[3]); }
                        s += __shfl_xor(s, 16); s += __shfl_xor(s, 32);
                        const float mu = s * (1.f / 64.f); float q = 0.f;
#pragma unroll
                        for (int bj = 0; bj < 2; ++bj)
#pragma unroll
                            for (int n = 0; n < 2; ++n) { const pg8::f32x4 d = acc[ai][bj][m][n] - mu; q += (d[0] * d[0] + d[1] * d[1]) + (d[2] * d[2] + d[3] * d[3]); }
                        q += __shfl_xor(q, 16); q += __shfl_xor(q, 32);
                        const float rs = frsq(q * (1.f / 64.f) + EPS);
                        bf16* rowp = dst + (size_t)(row0 + ai * 128 + m * 16) * 64 + 8 * fq;
#pragma unroll
                        for (int bj = 0; bj < 2; ++bj) { const f32x4 v0 = (acc[ai][bj][m][0] - mu) * rs * gv[bj][0] + bv[bj][0], v1 = (acc[ai][bj][m][1] - mu) * rs * gv[bj][1] + bv[bj][1];
                            v4u w; w.x = cvtpk(v0[0], v0[1]); w.y = cvtpk(v0[2], v0[3]); w.z = cvtpk(v1[0], v1[1]); w.w = cvtpk(v1[2], v1[3]);
                            *(GAS v4u*)(rowp + bj * 32) = w; } }
            } else if (wc == 1 && fq == 0) {
                float* dst = (float*)(ws + WS_IW);
#pragma unroll
                for (int ai = 0; ai < 2; ++ai)
#pragma unroll
                    for (int m = 0; m < 4; ++m) { float* rowp = dst + (size_t)(row0 + ai * 128 + m * 16) * 8;
                        *(GAS f32x4*)(rowp) = acc[ai][0][m][0] * 0.35355339059327373f; *(GAS f32x4*)(rowp + 4) = acc[ai][0][m][1] * 0.35355339059327373f; }
            }
        }
    }
};

constexpr int IDX_CAP = 768, IDX_KT_STRIDE = 144, IDX_STG = 128, IDX_KT_BYTES = IDX_STG * IDX_KT_STRIDE;
constexpr int IDX_CAND_OFF = 0, IDX_KT_OFF = NWAVES * 4 * IDX_CAP * 4, IDX_HIST_OFF = IDX_KT_OFF + 2 * IDX_KT_BYTES, IDX_DUM_OFF = IDX_HIST_OFF + NWAVES * 1024, IDX_FLAG_OFF = IDX_DUM_OFF + NWAVES * 256;
constexpr int IDX_PRMIN = 448;
static_assert(IDX_FLAG_OFF + 16 <= MISC_OFF, "indexer LDS");

__device__ __forceinline__ unsigned mono_pack(float s, int kidx) {
    const unsigned u = __float_as_uint(s); const unsigned m = u ^ ((unsigned)((int)u >> 31) | 0x80000000u);
    return (m & 0xFFFFE000u) | (unsigned)(8191 - kidx);
}
__device__ __forceinline__ int lane_prefix(unsigned long long bal) { return __builtin_amdgcn_mbcnt_hi((unsigned)(bal >> 32), __builtin_amdgcn_mbcnt_lo((unsigned)bal, 0u)); }
#define DPP_STEP(v, ctrl, rm) __builtin_amdgcn_update_dpp(0, (int)(v), (ctrl), (rm), 0xf, false)
__device__ __forceinline__ int scan_add(int v) {
    v += DPP_STEP(v, 0x111, 0xf); v += DPP_STEP(v, 0x112, 0xf); v += DPP_STEP(v, 0x114, 0xf); v += DPP_STEP(v, 0x118, 0xf); v += DPP_STEP(v, 0x142, 0xa); v += DPP_STEP(v, 0x143, 0xc); return v;
}
__device__ __forceinline__ unsigned umax2(unsigned a, unsigned b) { return a > b ? a : b; }
__device__ __forceinline__ unsigned wave_max_u(unsigned v) {
    v = umax2(v, (unsigned)DPP_STEP(v, 0x111, 0xf)); v = umax2(v, (unsigned)DPP_STEP(v, 0x112, 0xf)); v = umax2(v, (unsigned)DPP_STEP(v, 0x114, 0xf)); v = umax2(v, (unsigned)DPP_STEP(v, 0x118, 0xf));
    v = umax2(v, (unsigned)DPP_STEP(v, 0x142, 0xa)); v = umax2(v, (unsigned)DPP_STEP(v, 0x143, 0xc)); return (unsigned)__builtin_amdgcn_readlane((int)v, 63);
}

__device__ __forceinline__ unsigned idx_prune(LAS unsigned* buf, int cnt, LAS unsigned* hist, int lane) {
    constexpr int NV = IDX_CAP / 64; unsigned v[NV]; unsigned mx = 0u, mnc = 0u;
#pragma unroll
    for (int j = 0; j < NV; ++j) { const int idx = j * 64 + lane; const bool ok = idx < cnt; v[j] = ok ? buf[idx] : 0u; mx = umax2(mx, v[j]); mnc = umax2(mnc, ok ? ~v[j] : 0u); }
    mx = wave_max_u(mx); const unsigned mn = ~wave_max_u(mnc);
    unsigned lo = mn, wm1 = mx - mn;
    int sh = 24 - __clz((int)(wm1 | 1u)); sh = sh < 0 ? 0 : sh;
    int need = 256; unsigned T = 0u;
    for (int pass = 0; pass < 5; ++pass) {
        *(LAS v4u*)(hist + 4 * lane) = (v4u){0u, 0u, 0u, 0u};
        LDS_WAIT();
#pragma unroll
        for (int j = 0; j < NV; ++j) { const unsigned d = v[j] - lo; if ((j * 64 + lane) < cnt && d <= wm1) __hip_atomic_fetch_add(hist + (d >> sh), 1u, __ATOMIC_RELAXED, __HIP_MEMORY_SCOPE_WORKGROUP); }
        LDS_WAIT();
        const v4u h4 = *(const LAS v4u*)(hist + 4 * lane);
        const int s4 = (int)(h4.x + h4.y + h4.z + h4.w), P = scan_add(s4), tot = __builtin_amdgcn_readlane(P, 63);
        const int S = tot - P + s4;
        const unsigned long long bal = __ballot(S >= need);
        const int Ls = 63 - __clzll((long long)bal);
        const int Sab = __builtin_amdgcn_readlane(S - s4, Ls);
        const int h0 = __builtin_amdgcn_readlane((int)h4.x, Ls), h1 = __builtin_amdgcn_readlane((int)h4.y, Ls), h2 = __builtin_amdgcn_readlane((int)h4.z, Ls), h3 = __builtin_amdgcn_readlane((int)h4.w, Ls);
        int above = Sab, B = 3, nB = h3;
        if (above + h3 < need) { above += h3; B = 2; nB = h2; if (above + h2 < need) { above += h2; B = 1; nB = h1; if (above + h1 < need) { above += h1; B = 0; nB = h0; } } }
        const unsigned edge = lo + ((unsigned)(4 * Ls + B) << sh);
        need -= above;
        T = edge;
        if (nB == need || sh == 0) break;
        lo = edge; wm1 = (1u << sh) - 1u; sh = sh > 8 ? sh - 8 : 0;
    }
    int base = 0;
#pragma unroll
    for (int j = 0; j < NV; ++j) { const bool p = ((j * 64 + lane) < cnt) && v[j] >= T; const unsigned long long bal = __ballot(p); const int pre = lane_prefix(bal);
        if (p) buf[base + pre] = v[j]; base += __popcll(bal); }
    LDS_WAIT();
    return T;
}

template <bool DRY>
__device__ __forceinline__ void idx_item(const Args& a, LAS unsigned char* lds, int b, int qblk, int tid, int lane, int wave) {
    const bf16* IQ = (const bf16*)(a.ws + WS_IQ); const bf16* IK = (const bf16*)(a.ws + WS_IK); const float* IW = (const float*)(a.ws + WS_IW); unsigned* MASK = (unsigned*)(a.ws + WS_MASK);
    const int t0 = qblk * 32 + wave * 4, nkeys = ((qblk >> 1) + 1) * 64, nst = (nkeys + IDX_STG - 1) / IDX_STG;
    const int hi = lane >> 5, m = lane & 31;
    bf16x8 af[4];
    { const int qa = 2 * ((m >> 2) & 1) + ((m >> 4) & 1), ha = 4 * ((m >> 3) & 1) + (m & 3); const size_t tok = (size_t)b * SEQ + t0 + qa;
      const float wsc = IW[tok * 8 + ha] * 0.125f;
#pragma unroll
      for (int ks = 0; ks < 4; ++ks) { const v4u raw = *(const GAS v4u*)(IQ + tok * 512 + ha * 64 + 16 * ks + 8 * hi); v4u o;
          o.x = cvtpk_s(bflo(raw.x) * wsc, bfhi(raw.x) * wsc); o.y = cvtpk_s(bflo(raw.y) * wsc, bfhi(raw.y) * wsc); o.z = cvtpk_s(bflo(raw.z) * wsc, bfhi(raw.z) * wsc); o.w = cvtpk_s(bflo(raw.w) * wsc, bfhi(raw.w) * wsc);
          af[ks] = __builtin_bit_cast(bf16x8, o); } }
    float cinf[16];
#pragma unroll
    for (int i = 0; i < 16; ++i) { const float w = IW[((size_t)b * SEQ + t0 + 2 * hi + (i >> 3)) * 8 + (i & 7)]; cinf[i] = w >= 0.f ? __builtin_inff() : -__builtin_inff(); }
    LAS unsigned* cb = (LAS unsigned*)(lds + IDX_CAND_OFF) + wave * 4 * IDX_CAP;
    LAS unsigned* cb0 = cb + (2 * hi) * IDX_CAP; LAS unsigned* cb1 = cb0 + IDX_CAP;
    LAS unsigned* hist = (LAS unsigned*)(lds + IDX_HIST_OFF) + wave * 256;
    LAS unsigned* dum = (LAS unsigned*)(lds + IDX_DUM_OFF) + wave * 64 + lane;
    int cnt0 = 0, cnt1 = 0; unsigned thr0 = DRY ? 0xffffffffu : 0u, thr1 = thr0;
    const unsigned himask = hi ? 0xffffffffu : 0u;
    const int skey = tid >> 3, sch = tid & 7;
    const bf16* ksrc = IK + ((size_t)b * SEQ + skey) * 64 + sch * 8;
    LAS unsigned char* kt = lds + IDX_KT_OFF; const int kdst = skey * IDX_KT_STRIDE + sch * 16;
    v4u kreg0 = *(const GAS v4u*)ksrc, kreg1 = kreg0;
    if (nkeys > 64) kreg1 = *(const GAS v4u*)(ksrc + 64 * 64);
    *(LAS v4u*)(kt + kdst) = kreg0; *(LAS v4u*)(kt + kdst + 64 * IDX_KT_STRIDE) = kreg1;
    __syncthreads();
    LAS unsigned* pflag = (LAS unsigned*)(lds + IDX_FLAG_OFF);
    if (tid < 3) pflag[tid] = 0u;
    __syncthreads();
#define IDX_MMA(accv, sub) do { accv = (f32x16){0.f, 0.f, 0.f, 0.f, 0.f, 0.f, 0.f, 0.f, 0.f, 0.f, 0.f, 0.f, 0.f, 0.f, 0.f, 0.f}; \
        _Pragma("unroll") for (int ks = 0; ks < 4; ++ks) { const bf16x8 bfr = *(const LAS bf16x8*)(kcur + (sub) * 32 * IDX_KT_STRIDE + 32 * ks); accv = MFMA32(af[ks], bfr, accv); } } while (0)
#define IDX_VALU(accv, sub) do { float s0 = 0.f, s1 = 0.f; \
        _Pragma("unroll") for (int j = 0; j < 8; ++j) { s0 += __builtin_amdgcn_fmed3f(accv[j], 0.f, cinf[j]); s1 += __builtin_amdgcn_fmed3f(accv[8 + j], 0.f, cinf[8 + j]); } \
        const int kidx = kbase + (sub) * 32 + m; const unsigned p0 = mono_pack(s0, kidx), p1 = mono_pack(s1, kidx); \
        { const bool ps = p0 > thr0; const unsigned long long bal = __ballot(ps); const unsigned lo = (unsigned)bal, hh = (unsigned)(bal >> 32); \
          const int pre = (int)__builtin_amdgcn_mbcnt_hi(hh, __builtin_amdgcn_mbcnt_lo(lo, 0u)) - (int)((unsigned)__popc(lo) & himask); \
          LAS unsigned* dst = ps ? (cb0 + cnt0 + pre) : dum; *dst = p0; cnt0 += hi ? __popc(hh) : __popc(lo); } \
        { const bool ps = p1 > thr1; const unsigned long long bal = __ballot(ps); const unsigned lo = (unsigned)bal, hh = (unsigned)(bal >> 32); \
          const int pre = (int)__builtin_amdgcn_mbcnt_hi(hh, __builtin_amdgcn_mbcnt_lo(lo, 0u)) - (int)((unsigned)__popc(lo) & himask); \
          LAS unsigned* dst = ps ? (cb1 + cnt1 + pre) : dum; *dst = p1; cnt1 += hi ? __popc(hh) : __popc(lo); } } while (0)
    for (int st = 0; st < nst; ++st) {
        const int kbase = st * IDX_STG; const bool full = (nkeys - kbase) >= IDX_STG;
        if (st + 1 < nst) { kreg0 = *(const GAS v4u*)(ksrc + (size_t)(kbase + IDX_STG) * 64); if (nkeys - kbase - IDX_STG > 64) kreg1 = *(const GAS v4u*)(ksrc + (size_t)(kbase + IDX_STG + 64) * 64); }
        const LAS unsigned char* kcur = kt + (st & 1) * IDX_KT_BYTES + m * IDX_KT_STRIDE + 16 * hi;
        f32x16 accA, accB;
        IDX_MMA(accA, 0);
        IDX_MMA(accB, 1); __builtin_amdgcn_sched_barrier(0);
        IDX_VALU(accA, 0); __builtin_amdgcn_sched_barrier(0);
        if (full) {
            IDX_MMA(accA, 2); __builtin_amdgcn_sched_barrier(0);
            IDX_VALU(accB, 1); __builtin_amdgcn_sched_barrier(0);
            IDX_MMA(accB, 3); __builtin_amdgcn_sched_barrier(0);
            IDX_VALU(accA, 2); __builtin_amdgcn_sched_barrier(0);
            IDX_VALU(accB, 3);
        } else { IDX_VALU(accB, 1); }
        { const int c00 = __builtin_amdgcn_readlane(cnt0, 0), c01 = __builtin_amdgcn_readlane(cnt1, 0), c10 = __builtin_amdgcn_readlane(cnt0, 32), c11 = __builtin_amdgcn_readlane(cnt1, 32);
          constexpr int LIM = IDX_CAP - IDX_STG;
          if ((c00 > LIM || c01 > LIM || c10 > LIM || c11 > LIM) && lane == 0) pflag[st % 3] = 1u; }
        if (tid == 0) pflag[(st + 1) % 3] = 0u;
        if (st + 1 < nst) { LAS unsigned char* kn = kt + ((st + 1) & 1) * IDX_KT_BYTES + kdst; *(LAS v4u*)kn = kreg0; *(LAS v4u*)(kn + 64 * IDX_KT_STRIDE) = kreg1; }
        __syncthreads();
        if (pflag[st % 3] != 0u && st + 1 < nst) {
            const int c00 = __builtin_amdgcn_readlane(cnt0, 0), c01 = __builtin_amdgcn_readlane(cnt1, 0), c10 = __builtin_amdgcn_readlane(cnt0, 32), c11 = __builtin_amdgcn_readlane(cnt1, 32);
            if (c00 > IDX_PRMIN) { const unsigned T = idx_prune(cb, c00, hist, lane); if (!hi) { thr0 = T - 1u; cnt0 = 256; } }
            if (c01 > IDX_PRMIN) { const unsigned T = idx_prune(cb + IDX_CAP, c01, hist, lane); if (!hi) { thr1 = T - 1u; cnt1 = 256; } }
            if (c10 > IDX_PRMIN) { const unsigned T = idx_prune(cb + 2 * IDX_CAP, c10, hist, lane); if (hi) { thr0 = T - 1u; cnt0 = 256; } }
            if (c11 > IDX_PRMIN) { const unsigned T = idx_prune(cb + 3 * IDX_CAP, c11, hist, lane); if (hi) { thr1 = T - 1u; cnt1 = 256; } }
        }
    }
#undef IDX_MMA
#undef IDX_VALU
    LDS_WAIT();
    if (DRY) { __syncthreads(); return; }
#pragma unroll
    for (int q = 0; q < 4; ++q) {
        int cq = __builtin_amdgcn_readlane((q & 1) ? cnt1 : cnt0, (q >> 1) * 32);
        LAS unsigned* buf = cb + q * IDX_CAP;
        if (cq > 256) { (void)idx_prune(buf, cq, hist, lane); cq = 256; }
        LAS unsigned* mrow = buf + 256;
#pragma unroll
        for (int j = 0; j < 4; ++j) mrow[j * 64 + lane] = 0u;
        LDS_WAIT();
#pragma unroll
        for (int j = 0; j < 4; ++j) { const int idx = j * 64 + lane; if (idx < cq) { const unsigned v = buf[idx]; const unsigned key = 8191u - (v & 8191u);
            __hip_atomic_fetch_or(mrow + (key >> 5), 1u << (key & 31u), __ATOMIC_RELAXED, __HIP_MEMORY_SCOPE_WORKGROUP); } }
        LDS_WAIT();
        const v4u o = *(const LAS v4u*)(mrow + 4 * lane);
        *(GAS v4u*)(MASK + ((size_t)b * SEQ + t0 + q) * 256 + 4 * lane) = o;
    }
    __syncthreads();
}

constexpr int HL_STRIDE = 144;
__device__ __forceinline__ void hgrn_local_item(const Args& a, LAS unsigned char* lds, int item, int tid, int lane, int wave) {
    const int bh = item >> 7, c = item & 127, b = bh >> 2, h = bh & 3;
    const float* LF = (const float*)(a.ws + WS_LF); const bf16* VR = (const bf16*)(a.ws + WS_VR);
    unsigned* LS = (unsigned*)(a.ws + WS_LS); float* DEC = (float*)(a.ws + WS_DEC);
    LAS unsigned char* kct = lds; LAS unsigned char* vt = lds + 128 * HL_STRIDE; LAS float* seg = (LAS float*)(lds + 2 * 128 * HL_STRIDE);
    const int k = tid & 127, sg = tid >> 7;
    const size_t row0 = (size_t)b * SEQ + c * 64 + sg * 16;
    float lf[16], vv[16];
#pragma unroll
    for (int j = 0; j < 16; ++j) { lf[j] = LF[(row0 + j) * 512 + h * 128 + k]; vv[j] = bf2f(VR[(row0 + j) * 512 + h * 128 + k]); }
    float run = 0.f, bl[16];
#pragma unroll
    for (int j = 0; j < 16; ++j) { run += lf[j]; bl[j] = run; }
    seg[sg * 128 + k] = run;
    __syncthreads();
    float off = 0.f, tot = 0.f;
#pragma unroll
    for (int s = 0; s < 4; ++s) { const float x = seg[s * 128 + k]; tot += x; if (s < sg) off += x; }
    { unsigned pk[8], pv[8];
#pragma unroll
      for (int j = 0; j < 8; ++j) { const float k0 = (1.f - fexp(lf[2 * j])) * fexp(tot - off - bl[2 * j]), k1 = (1.f - fexp(lf[2 * j + 1])) * fexp(tot - off - bl[2 * j + 1]);
          pk[j] = cvtpk(k0, k1); pv[j] = cvtpk(vv[2 * j], vv[2 * j + 1]); }
      *(LAS v4u*)(kct + k * HL_STRIDE + sg * 32) = (v4u){pk[0], pk[1], pk[2], pk[3]}; *(LAS v4u*)(kct + k * HL_STRIDE + sg * 32 + 16) = (v4u){pk[4], pk[5], pk[6], pk[7]};
      *(LAS v4u*)(vt + k * HL_STRIDE + sg * 32) = (v4u){pv[0], pv[1], pv[2], pv[3]}; *(LAS v4u*)(vt + k * HL_STRIDE + sg * 32 + 16) = (v4u){pv[4], pv[5], pv[6], pv[7]}; }
    if (sg == 0) DEC[(size_t)item * 128 + k] = fexp(tot);
    __syncthreads();
    { const int hi = lane >> 5, m = lane & 31, mt = wave >> 1, np = wave & 1;
      f32x16 acc0 = {0.f, 0.f, 0.f, 0.f, 0.f, 0.f, 0.f, 0.f, 0.f, 0.f, 0.f, 0.f, 0.f, 0.f, 0.f, 0.f}, acc1 = acc0;
#pragma unroll
      for (int ks = 0; ks < 4; ++ks) { const bf16x8 av = *(const LAS bf16x8*)(vt + (32 * mt + m) * HL_STRIDE + (16 * ks + 8 * hi) * 2);
          const bf16x8 b0 = *(const LAS bf16x8*)(kct + (64 * np + 2 * m) * HL_STRIDE + (16 * ks + 8 * hi) * 2), b1 = *(const LAS bf16x8*)(kct + (64 * np + 2 * m + 1) * HL_STRIDE + (16 * ks + 8 * hi) * 2);
          acc0 = MFMA32(av, b0, acc0); acc1 = MFMA32(av, b1, acc1); }
#pragma unroll
      for (int i = 0; i < 16; ++i) { const int v = 32 * mt + crow(i, hi); LS[((size_t)item * 128 + v) * 64 + 32 * np + m] = cvtpk(acc0[i], acc1[i]); } }
    __syncthreads();
}

__device__ __forceinline__ void phase4(const Args& a, int tid, int G) {
    unsigned* LS = (unsigned*)(a.ws + WS_LS); const float* DEC = (const float*)(a.ws + WS_DEC);
    for (int gid = blockIdx.x * 512 + tid; gid < 65536; gid += G * 512) {
        const int bh = gid >> 13, v = (gid >> 6) & 127, kp = gid & 63;
        float s0 = 0.f, s1 = 0.f;
        unsigned* p = LS + ((size_t)bh * 128 * 128 + v) * 64 + kp; const float* dp = DEC + (size_t)bh * 128 * 128 + 2 * kp;
        for (int c0 = 0; c0 < 128; c0 += 16) {
            unsigned w[16]; f32x2 d[16];
#pragma unroll
            for (int i = 0; i < 16; ++i) { w[i] = __builtin_nontemporal_load(p + (size_t)(c0 + i) * 128 * 64); d[i] = *(const f32x2*)(dp + (size_t)(c0 + i) * 128); }
#pragma unroll
            for (int i = 0; i < 16; ++i) { s0 = d[i].x * s0 + bflo(w[i]); s1 = d[i].y * s1 + bfhi(w[i]); w[i] = cvtpk(s0, s1); }
#pragma unroll
            for (int i = 0; i < 16; ++i) p[(size_t)(c0 + i) * 128 * 64] = w[i];
        }
    }
}

constexpr int AT_KSTRIDE = 144, AT_STG = 128, AT_KBYTES = AT_STG * AT_KSTRIDE, AT_VBYTES = 2 * 8192, AT_SBYTES = AT_KBYTES + AT_VBYTES;
constexpr int AT_STG_OFF = 0, AT_TAB_OFF = 2 * AT_SBYTES, AT_L_OFF = AT_TAB_OFF + 1024, AT_OST_OFF = AT_L_OFF + NWAVES * 128, AT_OST_STRIDE = 68;
static_assert(AT_OST_OFF + NWAVES * 32 * AT_OST_STRIDE * 4 <= MISC_OFF, "attention LDS");

__device__ __forceinline__ int t5_bucket_neg(int n) {
    return n < 8 ? n : n < 12 ? 8 : n < 16 ? 9 : n < 23 ? 10 : n < 32 ? 11 : n < 46 ? 12 : n < 64 ? 13 : n < 91 ? 14 : 15;
}
__device__ __forceinline__ s16x4 vtr(const LAS unsigned char* p) { return __builtin_bit_cast(s16x4, __builtin_amdgcn_ds_read_tr16_b64_v4i16((LAS v4i16_t*)p)); }

__device__ __forceinline__ float msel(int w, int pos, unsigned xd) { int t; asm("v_bfe_i32 %0, %1, %2, 1" : "=v"(t) : "v"(w), "n"(pos));
    return __uint_as_float(0xff800000u ^ ((unsigned)t & xd)); }
template <int DRYM>
__device__ __forceinline__ void attn_item(const Args& a, LAS unsigned char* lds, int b, int h, int qb, int tid, int lane, int wave) {
    const bf16* AQ = (const bf16*)(a.ws + WS_AQ); const bf16* AK = (const bf16*)(a.ws + WS_AK); const bf16* AV = (const bf16*)(a.ws + WS_AV);
    const unsigned* MASK = (const unsigned*)(a.ws + WS_MASK); bf16* MIX = (bf16*)(a.ws + WS_H);
    const int hi = lane >> 5, r32 = lane & 31, q0 = qb * 256, qw = q0 + wave * 32, nst = (q0 + 256) >> 7, kend = (((qw + 31) >> 6) + 1) * 64;
    LAS float* tab = (LAS float*)(lds + AT_TAB_OFF);
    if (tid < 192) {
        const float* qg = a.in[IN_QG]; const float* kg = a.in[IN_KG]; const float* rb = a.in[IN_RELB];
        float mq = 0.f, mk = 0.f, mb = -3.0e38f;
        for (int i = 0; i < 64; ++i) { mq = fmaxf(mq, fabsf(qg[i])); mk = fmaxf(mk, fabsf(kg[i])); }
        for (int i = 0; i < 32; ++i) mb = fmaxf(mb, rb[i * 8 + h]);
        const float bound = 8.f * mq * mk + mb; const int rel = tid - 128, n = rel < 0 ? -rel : rel;
        const int bk = (rel > 0 ? 16 : 0) + t5_bucket_neg(n);
        tab[tid] = (rb[bk * 8 + h] - bound) * LOG2E;
    }
    bf16x8 qr[4];
    { const bf16* qp = AQ + ((size_t)b * SEQ + qw + r32) * 512 + h * 64 + 8 * hi;
#pragma unroll
      for (int d0 = 0; d0 < 4; ++d0) qr[d0] = *(const GAS bf16x8*)(qp + 16 * d0); }
    const int skey = tid >> 3, sch = tid & 7;
    const size_t srow = ((size_t)b * SEQ + skey) * 512 + h * 64 + sch * 8;
    const int kdst = skey * AT_KSTRIDE + sch * 16, vdst = AT_KBYTES + ((sch >> 2) * 4 + (skey >> 4)) * 1024 + (skey & 15) * 64 + (sch & 3) * 16;
    LAS unsigned char* sbuf = lds + AT_STG_OFF;
    v4u kr0 = *(const GAS v4u*)(AK + srow), kr1 = *(const GAS v4u*)(AK + srow + 64 * 512), vr0 = *(const GAS v4u*)(AV + srow), vr1 = *(const GAS v4u*)(AV + srow + 64 * 512);
    *(LAS v4u*)(sbuf + kdst) = kr0; *(LAS v4u*)(sbuf + kdst + 64 * AT_KSTRIDE) = kr1; *(LAS v4u*)(sbuf + vdst) = vr0; *(LAS v4u*)(sbuf + vdst + 8192) = vr1;
    const unsigned* mrow = MASK + ((size_t)b * SEQ + qw + r32) * 256;
    v4u mw = *(const GAS v4u*)(mrow);
    f32x16 o0 = {0.f, 0.f, 0.f, 0.f, 0.f, 0.f, 0.f, 0.f, 0.f, 0.f, 0.f, 0.f, 0.f, 0.f, 0.f, 0.f}, o1 = o0;
    float lsum = 0.f;
    __syncthreads();
    const float cfar = tab[0]; const unsigned cfard = __float_as_uint(cfar) ^ 0xff800000u;
    const int vb = ((lane >> 4) & 1) * 32 + (lane & 3) * 8 + (4 * hi + ((lane & 15) >> 2)) * 64;
#define AT_QK(sv, sub, wordv, FARST) do { if (DRYM == 4) { _Pragma("unroll") for (int r = 0; r < 16; ++r) sv[r] = cfar; break; } const int ks_ = kb0 + 32 * (sub); const int wsh_ = (int)((wordv) >> (4 * hi)); \
        if ((FARST) || ks_ + 31 - qw <= -91) { _Pragma("unroll") for (int r = 0; r < 16; ++r) sv[r] = msel(wsh_, (r & 3) + 8 * (r >> 2), cfard); } \
        else { const int base_ = ks_ + 4 * hi - qw - r32 + 128; _Pragma("unroll") for (int r = 0; r < 16; ++r) { int ix = base_ + (r & 3) + 8 * (r >> 2); ix = ix < 0 ? 0 : ix; sv[r] = msel(wsh_, (r & 3) + 8 * (r >> 2), __float_as_uint(tab[ix]) ^ 0xff800000u); } } \
        _Pragma("unroll") for (int d0 = 0; d0 < 4; ++d0) { const bf16x8 kf = *(const LAS bf16x8*)(kcur + ((sub) * 32 + r32) * AT_KSTRIDE + (16 * d0 + 8 * hi) * 2); sv = MFMA32(kf, qr[d0], sv); } } while (0)
#define AT_SOFT(sv, wordv, pa0, pa1) do { if (DRYM == 2) { pa0 = (v4u){__float_as_uint(sv[0]), __float_as_uint(sv[1]), __float_as_uint(sv[2]), __float_as_uint(sv[3])}; pa1 = (v4u){__float_as_uint(sv[4]) ^ (wordv), __float_as_uint(sv[5]), __float_as_uint(sv[6]), __float_as_uint(sv[7])}; break; } float p_[16]; \
        _Pragma("unroll") for (int r = 0; r < 16; ++r) { p_[r] = fexp2(sv[r]); lsum += p_[r]; } \
        pa0 = (v4u){cvtpk_s(p_[0], p_[1]), cvtpk_s(p_[2], p_[3]), cvtpk_s(p_[4], p_[5]), cvtpk_s(p_[6], p_[7])}; pa1 = (v4u){cvtpk_s(p_[8], p_[9]), cvtpk_s(p_[10], p_[11]), cvtpk_s(p_[12], p_[13]), cvtpk_s(p_[14], p_[15])}; } while (0)
#define AT_PV(pa0, pa1, sub) do { if (DRYM == 3) { o0[0] += __uint_as_float(pa0.x ^ pa1.y); break; } const LAS unsigned char* vs_ = vcur + ((sub) >> 1) * 8192; \
        _Pragma("unroll") for (int kk = 0; kk < 2; ++kk) { const int kg = 2 * ((sub) & 1) + kk; const bf16x8 pa = __builtin_bit_cast(bf16x8, kk ? pa1 : pa0); \
            _Pragma("unroll") for (int dh = 0; dh < 2; ++dh) { const s16x4 lo_ = vtr(vs_ + dh * 4096 + kg * 1024), hh_ = vtr(vs_ + dh * 4096 + kg * 1024 + 512); \
                const bf16x8 vf = {lo_[0], lo_[1], lo_[2], lo_[3], hh_[0], hh_[1], hh_[2], hh_[3]}; if (dh == 0) o0 = MFMA32(pa, vf, o0); else o1 = MFMA32(pa, vf, o1); } } } while (0)
#define AT_SB() __builtin_amdgcn_sched_barrier(0)
    for (int st = 0; st < nst; ++st) {
        const int kb0 = st * AT_STG; v4u mwn = mw;
        if (st + 1 < nst) { const size_t nx = srow + (size_t)(kb0 + AT_STG) * 512; kr0 = *(const GAS v4u*)(AK + nx); kr1 = *(const GAS v4u*)(AK + nx + 64 * 512); vr0 = *(const GAS v4u*)(AV + nx); vr1 = *(const GAS v4u*)(AV + nx + 64 * 512);
            mwn = *(const GAS v4u*)(mrow + 4 * (st + 1)); }
        const LAS unsigned char* kcur = sbuf + (st & 1) * AT_SBYTES; const LAS unsigned char* vcur = kcur + AT_KBYTES + vb;
        const int nsub = kend - kb0 >= AT_STG ? 4 : kend - kb0 > 0 ? (kend - kb0) >> 5 : 0;
        f32x16 sA, sB; v4u a0, a1, b0, b1;
        if (nsub == 4 && kb0 + 127 - qw <= -91) {
            AT_QK(sA, 0, mw.x, true); AT_QK(sB, 1, mw.y, true); AT_SB();
            AT_SOFT(sA, mw.x, a0, a1); AT_SB();
            AT_QK(sA, 2, mw.z, true); AT_PV(a0, a1, 0); AT_SB();
            AT_SOFT(sB, mw.y, b0, b1); AT_SB();
            AT_QK(sB, 3, mw.w, true); AT_PV(b0, b1, 1); AT_SB();
            AT_SOFT(sA, mw.z, a0, a1); AT_SB();
            AT_PV(a0, a1, 2); AT_SB();
            AT_SOFT(sB, mw.w, b0, b1); AT_SB();
            AT_PV(b0, b1, 3);
        } else if (nsub > 0) {
            AT_QK(sA, 0, mw.x, false); AT_QK(sB, 1, mw.y, false); AT_SB();
            AT_SOFT(sA, mw.x, a0, a1); AT_SB();
            if (nsub == 4) {
                AT_QK(sA, 2, mw.z, false); AT_PV(a0, a1, 0); AT_SB();
                AT_SOFT(sB, mw.y, b0, b1); AT_SB();
                AT_QK(sB, 3, mw.w, false); AT_PV(b0, b1, 1); AT_SB();
                AT_SOFT(sA, mw.z, a0, a1); AT_SB();
                AT_PV(a0, a1, 2); AT_SB();
                AT_SOFT(sB, mw.w, b0, b1); AT_SB();
                AT_PV(b0, b1, 3);
            } else {
                AT_PV(a0, a1, 0); AT_SB();
                AT_SOFT(sB, mw.y, b0, b1); AT_SB();
                AT_PV(b0, b1, 1);
            }
        }
        if (st + 1 < nst) { LAS unsigned char* sn = sbuf + ((st + 1) & 1) * AT_SBYTES; *(LAS v4u*)(sn + kdst) = kr0; *(LAS v4u*)(sn + kdst + 64 * AT_KSTRIDE) = kr1; *(LAS v4u*)(sn + vdst) = vr0; *(LAS v4u*)(sn + vdst + 8192) = vr1; }
        mw = mwn;
        __syncthreads();
    }
#undef AT_QK
#undef AT_SOFT
#undef AT_PV
#undef AT_SB
    if (DRYM != 0) { if (o0[0] + o1[3] + lsum == 1.2345e-30f) ((float*)(a.ws + WS_DEC))[tid] = 1.f; __syncthreads(); return; }
    lsum += __shfl_xor(lsum, 32);
    LAS float* lw = (LAS float*)(lds + AT_L_OFF) + wave * 32; LAS float* ost = (LAS float*)(lds + AT_OST_OFF) + wave * 32 * AT_OST_STRIDE;
    if (hi == 0) lw[r32] = lsum;
    LDS_WAIT();
#pragma unroll
    for (int r = 0; r < 16; ++r) { const int q = crow(r, hi); const float rl = frcp(lw[q]); ost[q * AT_OST_STRIDE + r32] = o0[r] * rl; ost[q * AT_OST_STRIDE + 32 + r32] = o1[r] * rl; }
    LDS_WAIT();
    { const int q = lane >> 1, hf = lane & 1; const LAS float* src = ost + q * AT_OST_STRIDE + hf * 32; const float* g = a.in[IN_ATTG] + h * 64 + hf * 32;
      float v[32], ss = 0.f;
#pragma unroll
      for (int i = 0; i < 8; ++i) { const f32x4 t = *(const LAS f32x4*)(src + 4 * i); v[4 * i] = t.x; v[4 * i + 1] = t.y; v[4 * i + 2] = t.z; v[4 * i + 3] = t.w; ss += (t.x * t.x + t.y * t.y) + (t.z * t.z + t.w * t.w); }
      ss += __shfl_xor(ss, 1);
      const float ri = frsq(ss * (1.f / 64.f) + EPS);
      bf16* dst = MIX + ((size_t)b * SEQ + qw + q) * 1024 + 512 + h * 64 + hf * 32;
#pragma unroll
      for (int i = 0; i < 4; ++i) { v4u w;
          w.x = cvtpk(v[8 * i] * ri * g[8 * i], v[8 * i + 1] * ri * g[8 * i + 1]); w.y = cvtpk(v[8 * i + 2] * ri * g[8 * i + 2], v[8 * i + 3] * ri * g[8 * i + 3]);
          w.z = cvtpk(v[8 * i + 4] * ri * g[8 * i + 4], v[8 * i + 5] * ri * g[8 * i + 5]); w.w = cvtpk(v[8 * i + 6] * ri * g[8 * i + 6], v[8 * i + 7] * ri * g[8 * i + 7]);
          *(GAS v4u*)(dst + 8 * i) = w; } }
    __syncthreads();
}

constexpr int HO_QSTRIDE = 272, HO_QBYTES = 64 * HO_QSTRIDE;
constexpr int HO_QD = 0, HO_KD = HO_QBYTES, HO_QE = 2 * HO_QBYTES, HO_VT = 3 * HO_QBYTES, HO_SEG = HO_VT + 128 * HL_STRIDE, HO_RB = HO_SEG + 2048, HO_OST = HO_RB + 512, HO_OSTRIDE = 132;
static_assert(HO_OST + 64 * HO_OSTRIDE * 4 <= RING_BYTES, "hgrn-out LDS");
__device__ __forceinline__ void hgrn_out_item(const Args& a, LAS unsigned char* lds, int item, int tid, int lane, int wave) {
    const int bh = item >> 7, c = item & 127, b = bh >> 2, h = bh & 3;
    const float* LF = (const float*)(a.ws + WS_LF); const bf16* VR = (const bf16*)(a.ws + WS_VR); const bf16* QR = (const bf16*)(a.ws + WS_QR); const bf16* GR = (const bf16*)(a.ws + WS_GR);
    const bf16* LSb = (const bf16*)(a.ws + WS_LS); bf16* MIX = (bf16*)(a.ws + WS_H);
    LAS unsigned short* qd = (LAS unsigned short*)(lds + HO_QD); LAS unsigned short* kd = (LAS unsigned short*)(lds + HO_KD); LAS unsigned short* qe = (LAS unsigned short*)(lds + HO_QE);
    LAS unsigned char* vt = lds + HO_VT; LAS float* seg = (LAS float*)(lds + HO_SEG); LAS float* rbuf = (LAS float*)(lds + HO_RB); LAS float* ost = (LAS float*)(lds + HO_OST);
    const int k = tid & 127, sg = tid >> 7;
    const size_t row0 = (size_t)b * SEQ + c * 64 + sg * 16;
    float lf[16], qq[16], vv[16];
#pragma unroll
    for (int j = 0; j < 16; ++j) { const size_t ix = (row0 + j) * 512 + h * 128 + k; lf[j] = LF[ix]; qq[j] = bf2f(QR[ix]); vv[j] = bf2f(VR[ix]); }
    float run = 0.f, bl[16];
#pragma unroll
    for (int j = 0; j < 16; ++j) { run += lf[j]; bl[j] = run; }
    seg[sg * 128 + k] = run;
    __syncthreads();
    float off = 0.f;
#pragma unroll
    for (int s = 0; s < 4; ++s) { const float x = seg[s * 128 + k]; if (s < sg) off += x; }
    if (sg == 1) rbuf[k] = off + bl[15];
    __syncthreads();
    const float rr = rbuf[k];
    { unsigned pv[8];
#pragma unroll
      for (int j = 0; j < 16; ++j) { const float bt = off + bl[j], e1 = fexp(bt - rr), e2 = fexp(rr - bt), kk = 1.f - fexp(lf[j]); const int t = sg * 16 + j;
          qd[t * (HO_QSTRIDE / 2) + k] = (unsigned short)(cvtpk(qq[j] * e1, 0.f) & 0xffffu); kd[t * (HO_QSTRIDE / 2) + k] = (unsigned short)(cvtpk(kk * e2, 0.f) & 0xffffu);
          qe[t * (HO_QSTRIDE / 2) + k] = (unsigned short)(cvtpk(qq[j] * fexp(bt), 0.f) & 0xffffu); }
#pragma unroll
      for (int j = 0; j < 8; ++j) pv[j] = cvtpk(vv[2 * j], vv[2 * j + 1]);
      *(LAS v4u*)(vt + k * HL_STRIDE + sg * 32) = (v4u){pv[0], pv[1], pv[2], pv[3]}; *(LAS v4u*)(vt + k * HL_STRIDE + sg * 32 + 16) = (v4u){pv[4], pv[5], pv[6], pv[7]}; }
    __syncthreads();
    { const int hi = lane >> 5, m = lane & 31, tt = wave >> 2, vti = wave & 3;
      f32x16 acc = {0.f, 0.f, 0.f, 0.f, 0.f, 0.f, 0.f, 0.f, 0.f, 0.f, 0.f, 0.f, 0.f, 0.f, 0.f, 0.f};
      const LAS unsigned char* qeb = lds + HO_QE + (32 * tt + m) * HO_QSTRIDE + 16 * hi;
      if (c > 0) {
          const bf16* sp = LSb + ((size_t)(item - 1) * 128 + 32 * vti + m) * 128 + 8 * hi;
#pragma unroll
          for (int ks = 0; ks < 8; ++ks) { const bf16x8 af = *(const LAS bf16x8*)(qeb + 32 * ks); const bf16x8 bfr = *(const GAS bf16x8*)(sp + 16 * ks); acc = MFMA32(af, bfr, acc); }
      }
      const LAS unsigned char* qdb = lds + HO_QD + (32 * tt + m) * HO_QSTRIDE + 16 * hi;
#pragma unroll
      for (int st = 0; st < 2; ++st) if (st <= tt) {
          f32x16 pt = {0.f, 0.f, 0.f, 0.f, 0.f, 0.f, 0.f, 0.f, 0.f, 0.f, 0.f, 0.f, 0.f, 0.f, 0.f, 0.f};
          const LAS unsigned char* kdb = lds + HO_KD + (32 * st + m) * HO_QSTRIDE + 16 * hi;
#pragma unroll
          for (int ks = 0; ks < 8; ++ks) { const bf16x8 af = *(const LAS bf16x8*)(kdb + 32 * ks); const bf16x8 bfr = *(const LAS bf16x8*)(qdb + 32 * ks); pt = MFMA32(af, bfr, pt); }
          float p[16];
#pragma unroll
          for (int r = 0; r < 16; ++r) { const int s = 32 * st + crow(r, hi), t = 32 * tt + m; p[r] = (s <= t) ? pt[r] : 0.f; }
          const v4u pa0 = {cvtpk_s(p[0], p[1]), cvtpk_s(p[2], p[3]), cvtpk_s(p[4], p[5]), cvtpk_s(p[6], p[7])}, pa1 = {cvtpk_s(p[8], p[9]), cvtpk_s(p[10], p[11]), cvtpk_s(p[12], p[13]), cvtpk_s(p[14], p[15])};
#pragma unroll
          for (int kk = 0; kk < 2; ++kk) { const LAS unsigned char* vp = vt + (32 * vti + m) * HL_STRIDE + (32 * st + 16 * kk + 4 * hi) * 2;
              const v2u lo = *(const LAS v2u*)(vp), hh = *(const LAS v2u*)(vp + 16);
              const v4u vw = {lo.x, lo.y, hh.x, hh.y};
              acc = MFMA32(__builtin_bit_cast(bf16x8, kk ? pa1 : pa0), __builtin_bit_cast(bf16x8, vw), acc); }
      }
#pragma unroll
      for (int r = 0; r < 16; ++r) ost[(32 * tt + crow(r, hi)) * HO_OSTRIDE + 32 * vti + m] = acc[r];
    }
    __syncthreads();
    { const int t = tid >> 3, s8 = tid & 7; const LAS float* src = ost + t * HO_OSTRIDE + s8 * 16; float v[16], ss = 0.f;
#pragma unroll
      for (int i = 0; i < 4; ++i) { const f32x4 x = *(const LAS f32x4*)(src + 4 * i); v[4 * i] = x.x; v[4 * i + 1] = x.y; v[4 * i + 2] = x.z; v[4 * i + 3] = x.w; ss += (x.x * x.x + x.y * x.y) + (x.z * x.z + x.w * x.w); }
      ss += __shfl_xor(ss, 1); ss += __shfl_xor(ss, 2); ss += __shfl_xor(ss, 4);
      const float ri = frsq(ss * (1.f / 128.f) + EPS);
      const size_t tok = (size_t)b * SEQ + c * 64 + t; const float* g = a.in[IN_RECG] + h * 128 + s8 * 16;
      const v4u g0 = *(const GAS v4u*)(GR + tok * 512 + h * 128 + s8 * 16), g1 = *(const GAS v4u*)(GR + tok * 512 + h * 128 + s8 * 16 + 8);
      const unsigned gw[8] = {g0.x, g0.y, g0.z, g0.w, g1.x, g1.y, g1.z, g1.w}; unsigned ow[8];
#pragma unroll
      for (int i = 0; i < 8; ++i) ow[i] = cvtpk(v[2 * i] * ri * g[2 * i] * bflo(gw[i]), v[2 * i + 1] * ri * g[2 * i + 1] * bfhi(gw[i]));
      bf16* dst = MIX + tok * 1024 + h * 128 + s8 * 16;
      *(GAS v4u*)dst = (v4u){ow[0], ow[1], ow[2], ow[3]}; *(GAS v4u*)(dst + 8) = (v4u){ow[4], ow[5], ow[6], ow[7]}; }
    __syncthreads();
}

struct EpiOutProj {
    static constexpr bool PERM = false, AFTER_DRAIN = false;
    const float* x; float* out; const float* modf;
    __device__ __forceinline__ void operator()(const pg8::f32x4 (&acc)[2][2][4][2], const pg8::Unit& u, int wr, int wc, int fr, int fq) const {
        const int row0 = u.pm * 256 + wr * 64 + fr, col0 = u.pn * 256 + wc * 32 + 4 * fq, b = u.pm >> 5;
        f32x4 gv[2][2];
#pragma unroll
        for (int bj = 0; bj < 2; ++bj)
#pragma unroll
            for (int n = 0; n < 2; ++n) gv[bj][n] = *(const f32x4*)(modf + b * 6144 + 2048 + col0 + bj * 128 + n * 16);
#pragma unroll
        for (int ai = 0; ai < 2; ++ai)
#pragma unroll
            for (int m = 0; m < 4; ++m) { const size_t off = (size_t)(row0 + ai * 128 + m * 16) * DM + col0;
#pragma unroll
                for (int bj = 0; bj < 2; ++bj)
#pragma unroll
                    for (int n = 0; n < 2; ++n) { const f32x4 xv = *(const GAS f32x4*)(x + off + bj * 128 + n * 16); *(GAS f32x4*)(out + off + bj * 128 + n * 16) = xv + gv[bj][n] * acc[ai][bj][m][n]; } }
    }
};

constexpr int RT_RW = 0, RT_A2 = 81920, RT_S2 = RT_A2 + 8192;
constexpr int CW_NBLK = 8192 + 128, CW_BLKMAP = 8192 + 256;
__device__ __forceinline__ float dpp_sum(float v) {
#define DPPF(x, ctrl, rm) __int_as_float(__builtin_amdgcn_update_dpp(0, __float_as_int(x), (ctrl), (rm), 0xf, false))
    v += DPPF(v, 0x111, 0xf); v += DPPF(v, 0x112, 0xf); v += DPPF(v, 0x114, 0xf); v += DPPF(v, 0x118, 0xf); v += DPPF(v, 0x142, 0xa); v += DPPF(v, 0x143, 0xc);
#undef DPPF
    return __int_as_float(__builtin_amdgcn_readlane(__float_as_int(v), 63));
}
__device__ __forceinline__ void load_mod2(const Args& a, LAS unsigned char* lds, int tid) {
    LAS float* A2 = (LAS float*)(lds + RT_A2); LAS float* S2 = (LAS float*)(lds + RT_S2);
    const float* modf = (const float*)(a.ws + WS_MODF); const float* g = a.in[IN_N2G];
    float gv[4], sc[4], sh[4];
#pragma unroll
    for (int q = 0; q < 4; ++q) { const int idx = tid + 512 * q, b = idx >> 10, i = idx & 1023; gv[q] = g[i]; sc[q] = modf[b * 6144 + 4096 + i]; sh[q] = modf[b * 6144 + 3072 + i]; }
#pragma unroll
    for (int q = 0; q < 4; ++q) { const int idx = tid + 512 * q; A2[idx] = gv[q] * (1.f + sc[q]); S2[idx] = sh[q]; }
}
__device__ __forceinline__ void phase7(const Args& a, LAS unsigned char* lds, int tid, int lane, int wave, int G) {
    LAS float* RW = (LAS float*)(lds + RT_RW); LAS float* A2 = (LAS float*)(lds + RT_A2); LAS float* S2 = (LAS float*)(lds + RT_S2);
    const float* wrg = a.in[IN_WRG]; const float* wre = a.in[IN_WRE];
    { f32x4 t[10];
#pragma unroll
      for (int q = 0; q < 10; ++q) { const int f = tid + 512 * q, i = f / 5, c = f % 5; t[q] = c == 0 ? *(const GAS f32x4*)(wrg + i * 4) : *(const GAS f32x4*)(wre + i * 16 + (c - 1) * 4); }
#pragma unroll
      for (int q = 0; q < 10; ++q) { const int f = tid + 512 * q; *(LAS f32x4*)(RW + f * 4) = t[q]; } }
    load_mod2(a, lds, tid);
    __syncthreads();
    const int gw = blockIdx.x * NWAVES + wave, NGW = G * NWAVES;
    const float* x1 = a.out; bf16* H2S = (bf16*)(a.ws + WS_H2S); int* stok = (int*)(a.ws + WS_STOK); f32x2* wsort = (f32x2*)(a.ws + WS_WSORT);
    unsigned* ctl = (unsigned*)(a.ws + WS_CTL); unsigned* gcnt = ctl + CW_CNT; unsigned* gnblk = ctl + CW_NBLK; unsigned* blkmap = ctl + CW_BLKMAP;
    float bias[20];
#pragma unroll
    for (int n = 0; n < 20; ++n) bias[n] = n < 4 ? a.in[IN_BRG][n] : a.in[IN_BRE][n - 4];
    constexpr int RPT = 4;
    for (int m0 = gw * RPT; m0 < MTOK; m0 += NGW * RPT) {
        unsigned hp[RPT][8];
        int mycombo = 0; float mywlo = 0.f, mywhi = 0.f;
        f32x2 xn[8];
#pragma unroll
        for (int q = 0; q < 8; ++q) xn[q] = *(const GAS f32x2*)(x1 + (size_t)m0 * DM + 128 * q + 2 * lane);
#pragma unroll
        for (int j = 0; j < RPT; ++j) {
            const int m = m0 + j, b = m >> 13; f32x2 xv[8]; float ss = 0.f;
#pragma unroll
            for (int q = 0; q < 8; ++q) { xv[q] = xn[q]; ss += xv[q].x * xv[q].x + xv[q].y * xv[q].y; }
            if (j < RPT - 1) {
#pragma unroll
                for (int q = 0; q < 8; ++q) xn[q] = *(const GAS f32x2*)(x1 + (size_t)(m + 1) * DM + 128 * q + 2 * lane); }
            const float ri = frsq(dpp_sum(ss) * (1.f / DM) + EPS);
            float lg[20];
#pragma unroll
            for (int n = 0; n < 20; ++n) lg[n] = 0.f;
#pragma unroll
            for (int q = 0; q < 8; ++q) { const int i = 128 * q + 2 * lane; const f32x2 aa = *(const LAS f32x2*)(A2 + b * 1024 + i), sv = *(const LAS f32x2*)(S2 + b * 1024 + i);
                const float h0 = xv[q].x * ri * aa.x + sv.x, h1 = xv[q].y * ri * aa.y + sv.y; hp[j][q] = cvtpk(h0, h1);
                const LAS f32x4* wr = (const LAS f32x4*)(RW + i * 20);
#pragma unroll
                for (int u = 0; u < 5; ++u) { const f32x4 w0 = wr[u], w1 = wr[5 + u];
                    lg[4 * u] += h0 * w0.x + h1 * w1.x; lg[4 * u + 1] += h0 * w0.y + h1 * w1.y; lg[4 * u + 2] += h0 * w0.z + h1 * w1.z; lg[4 * u + 3] += h0 * w0.w + h1 * w1.w; } }
#pragma unroll
            for (int n = 0; n < 20; ++n) lg[n] = dpp_sum(lg[n]) + bias[n];
            int gt = 0; float gm = lg[0];
#pragma unroll
            for (int n = 1; n < 4; ++n) if (lg[n] > gm) { gm = lg[n]; gt = n; }
            float gs = 0.f;
#pragma unroll
            for (int n = 0; n < 4; ++n) gs += fexp(lg[n] - gm);
            const float gate = 1.f / gs;
            float e[4];
#pragma unroll
            for (int n = 0; n < 4; ++n) e[n] = gt == 0 ? lg[4 + n] : gt == 1 ? lg[8 + n] : gt == 2 ? lg[12 + n] : lg[16 + n];
            int j0 = 0; float v0 = e[0];
#pragma unroll
            for (int n = 1; n < 4; ++n) if (e[n] > v0) { v0 = e[n]; j0 = n; }
            int j1 = -1; float v1 = -3.0e38f;
#pragma unroll
            for (int n = 0; n < 4; ++n) if (n != j0 && e[n] > v1) { v1 = e[n]; j1 = n; }
            const float w0 = gate / (1.f + fexp(v1 - v0)), w1 = gate - w0;
            const int lo = j0 < j1 ? j0 : j1, hh = j0 < j1 ? j1 : j0; const float wlo = j0 < j1 ? w0 : w1, whi = j0 < j1 ? w1 : w0;
            const int pidx = lo == 0 ? hh - 1 : lo == 1 ? hh + 1 : 5;
            if (lane == j) { mycombo = gt * 6 + pidx; mywlo = wlo; mywhi = whi; }
        }
        int posl = 0;
        if (lane < RPT) {
            const unsigned rank = __hip_atomic_fetch_add(gcnt + mycombo, 1u, __ATOMIC_RELAXED, __HIP_MEMORY_SCOPE_AGENT);
            unsigned* slot = blkmap + mycombo * 64 + (rank >> 8); unsigned pb;
            const bool first = (rank & 255u) == 0u; pb = 0u;
            if (first) { pb = __hip_atomic_fetch_add(gnblk, 1u, __ATOMIC_RELAXED, __HIP_MEMORY_SCOPE_AGENT) + 1u; __hip_atomic_store(slot, pb, __ATOMIC_RELAXED, __HIP_MEMORY_SCOPE_AGENT); }
            asm volatile("s_waitcnt vmcnt(0)" ::: "memory");
            if (!first) { for (unsigned sp = 0; sp < (1u << 20); ++sp) { pb = __hip_atomic_load(slot, __ATOMIC_RELAXED, __HIP_MEMORY_SCOPE_AGENT); if (pb) break; __builtin_amdgcn_s_sleep(1); } if (!pb) pb = 1u; }
            posl = (int)((pb - 1u) * 256u + (rank & 255u));
            stok[posl] = m0 + lane; wsort[posl] = (f32x2){mywlo, mywhi};
        }
#pragma unroll
        for (int j = 0; j < RPT; ++j) { const int pos = __builtin_amdgcn_readlane(posl, j); GAS unsigned* o = (GAS unsigned*)(H2S + (size_t)pos * DM) + lane;
#pragma unroll
            for (int q = 0; q < 8; ++q) o[64 * q] = hp[j][q]; }
    }
    __syncthreads();
    for (int rep_ = 0; rep_ < (PROBE_REP == 71 ? 2 : 1); ++rep_) moe_weight_items(a, (LAS float*)(lds + wave * 16384), gw, NGW, lane);
}

constexpr int MB_CNT = MISC_OFF + 1024, MB_NBLK = MB_CNT + 128, MB_BLK = MB_NBLK + 16, MB_BLKK = MB_BLK + 512;
__device__ __forceinline__ void build_buckets(const Args& a, LAS unsigned char* lds, int tid) {
    LAS int* cnt = (LAS int*)(lds + MB_CNT); LAS int* blk = (LAS int*)(lds + MB_BLK); LAS int* blkk = (LAS int*)(lds + MB_BLKK);
    const unsigned* ctl = (const unsigned*)(a.ws + WS_CTL);
    if (tid < NCOMBO) cnt[tid] = (int)__hip_atomic_load(ctl + CW_CNT + tid, __ATOMIC_RELAXED, __HIP_MEMORY_SCOPE_AGENT);
    if (tid == 32) { int nb = (int)__hip_atomic_load(ctl + CW_NBLK, __ATOMIC_RELAXED, __HIP_MEMORY_SCOPE_AGENT); *(LAS int*)(lds + MB_NBLK) = nb > NROWBLK ? NROWBLK : nb; }
    unsigned v[3];
#pragma unroll
    for (int q = 0; q < 3; ++q) v[q] = __hip_atomic_load(ctl + CW_BLKMAP + tid + 512 * q, __ATOMIC_RELAXED, __HIP_MEMORY_SCOPE_AGENT);
#pragma unroll
    for (int q = 0; q < 3; ++q) { const int e = tid + 512 * q; if (v[q] != 0u && v[q] <= (unsigned)NROWBLK) { blk[v[q] - 1] = e >> 6; blkk[v[q] - 1] = e & 63; } }
    __syncthreads();
}

__device__ __forceinline__ void pair_of(int pidx, int& lo, int& hh) { lo = pidx < 3 ? 0 : pidx < 5 ? 1 : 2; hh = pidx < 3 ? pidx + 1 : pidx < 5 ? pidx - 1 : 3; }
struct MoeSched1 {
    const LAS int* blk; int nblk, G, c;
    __device__ __forceinline__ bool next(int i, pg8::Unit& u) const {
        const int L = i * G + c; if (L >= nblk * 8) return false;
        const int rb = L >> 3, nt = L & 7, cmb = blk[rb]; int lo, hh; pair_of(cmb % 6, lo, hh);
        const int e = (cmb / 6) * 4 + (nt < 4 ? lo : hh);
        u.pm = rb; u.pn = e * 4 + (nt & 3); u.aux = nt; u.cont = 0; return true;
    }
    __device__ __forceinline__ void a_ready(const pg8::Unit&) const {}
    __device__ __forceinline__ void done(const pg8::Unit&) const {}
};
struct EpiMoe1 {
    static constexpr bool PERM = true, AFTER_DRAIN = false;
    bf16* he; const f32x2* wsort;
    __device__ __forceinline__ void operator()(const pg8::f32x4 (&acc)[2][2][4][2], const pg8::Unit& u, int wr, int wc, int fr, int fq) const {
        const int slot = u.aux >> 2, jt = u.aux & 3, row0 = u.pm * 256 + wr * 64 + fr, col0 = jt * 128 + wc * 32 + 8 * fq;
        bf16* dst = he + (size_t)slot * NSROWS * 512;
#pragma unroll
        for (int ai = 0; ai < 2; ++ai)
#pragma unroll
            for (int m = 0; m < 4; ++m) { const int pos = row0 + ai * 128 + m * 16; const f32x2 wv = wsort[pos]; const float ws = slot ? wv.y : wv.x;
                const pg8::f32x4 a0 = acc[ai][0][m][0], a1 = acc[ai][0][m][1], b0 = acc[ai][1][m][0], b1 = acc[ai][1][m][1];
                v4u w; w.x = cvtpk(ws * silu_f(a0[0]) * b0[0], ws * silu_f(a0[1]) * b0[1]); w.y = cvtpk(ws * silu_f(a0[2]) * b0[2], ws * silu_f(a0[3]) * b0[3]);
                w.z = cvtpk(ws * silu_f(a1[0]) * b1[0], ws * silu_f(a1[1]) * b1[1]); w.w = cvtpk(ws * silu_f(a1[2]) * b1[2], ws * silu_f(a1[3]) * b1[3]);
                *(GAS v4u*)(dst + (size_t)pos * 512 + col0) = w; }
    }
};
struct MoeSched2 {
    const LAS int* blk; int nblk, G, c;
    __device__ __forceinline__ bool next(int i, pg8::Unit& u) const {
        const int L = (i >> 1) * G + c, sg = i & 1; if (L >= nblk * 4) return false;
        const int rb = L >> 2, nt = L & 3, cmb = blk[rb]; int lo, hh; pair_of(cmb % 6, lo, hh);
        const int e = (cmb / 6) * 4 + (sg ? hh : lo);
        u.pm = sg * NROWBLK + rb; u.pn = e * 4 + nt; u.aux = rb * 4 + nt; u.cont = sg ? 0 : 1; return true;
    }
    __device__ __forceinline__ void a_ready(const pg8::Unit&) const {}
    __device__ __forceinline__ void done(const pg8::Unit&) const {}
};
struct EpiMoe2 {
    static constexpr bool PERM = false, AFTER_DRAIN = false;
    float* out; const float* modf; const int* stok; const LAS int* blk; const LAS int* blkk; const LAS int* cnt;
    __device__ __forceinline__ void operator()(const pg8::f32x4 (&acc)[2][2][4][2], const pg8::Unit& u, int wr, int wc, int fr, int fq) const {
        const int rb = u.aux >> 2, nt = u.aux & 3, cmb = blk[rb], nvalid = cnt[cmb] - 256 * blkk[rb];
        const int col0 = nt * 256 + wc * 32 + 4 * fq;
#pragma unroll
        for (int ai = 0; ai < 2; ++ai)
#pragma unroll
            for (int m = 0; m < 4; ++m) { const int lr = ai * 128 + wr * 64 + m * 16 + fr;
                if (lr < nvalid) { const int tok = stok[rb * 256 + lr]; const float* gp = modf + (tok >> 13) * 6144 + 5120 + col0; float* op = out + (size_t)tok * DM + col0;
#pragma unroll
                    for (int bj = 0; bj < 2; ++bj)
#pragma unroll
                        for (int n = 0; n < 2; ++n) { const f32x4 g = *(const f32x4*)(gp + bj * 128 + n * 16); const f32x4 xv = *(const GAS f32x4*)(op + bj * 128 + n * 16);
                            *(GAS f32x4*)(op + bj * 128 + n * 16) = xv + g * acc[ai][bj][m][n]; } } }
    }
};

#ifndef MK_N_LAUNCHES
#define MK_N_LAUNCHES 1
#endif
__global__ void __launch_bounds__(NWAVES * 64, 2) fwd(Args a) {
    extern __shared__ __attribute__((aligned(16))) unsigned char lds_raw[];
    LAS unsigned char* lds = (LAS unsigned char*)lds_raw;
    const int tid = threadIdx.x, lane = tid & 63, wave = __builtin_amdgcn_readfirstlane(tid >> 6), G = gridDim.x;
    volatile LAS unsigned* MISC = (volatile LAS unsigned*)(lds + MISC_OFF);
    for (int u = tid; u < (LDS_BYTES - MISC_OFF) / 4; u += NWAVES * 64) ((LAS unsigned*)(lds + MISC_OFF))[u] = 0u;
    __syncthreads();
    unsigned* ctl = (unsigned*)(a.ws + WS_CTL);
    XcdBarrier bar; bar.bar = ctl + CW_BAR; bar.x = 0; bar.st = nullptr;
    const int lo = a.ph_lo, hi = a.ph_hi;
    if (hi - lo > 1) bar = xcd_barrier_post(ctl + CW_BAR, MISC + 8);
#define IN(k) (lo <= (k) && (k) < hi)
#ifndef PROBE_REP
#define PROBE_REP -1
#endif
#define TWICE(id, call) do { call; if (PROBE_REP == (id)) { call; } } while (0)
#define REP(id) for (int rep_ = 0; rep_ < ((PROBE_REP == (id)) ? 2 : 1); ++rep_)
#define SEAM(k) do { if (IN(k) && IN((k) + 1)) xcd_barrier(bar); } while (0)

    const int xvcu = (G % 8 == 0) ? (int)(blockIdx.x % 8) * (G / 8) + (int)(blockIdx.x / 8) : (int)blockIdx.x;
    if (IN(0)) { REP(0) { phase0(a, lds, tid, lane, wave, G); __syncthreads(); } SEAM(0); }
    if (IN(1)) { REP(1) { phase1(a, lds, tid, lane, wave, G); __syncthreads(); } SEAM(1); }
    if (PROBE_REP == 90 && hi - lo > 1) { for (int i = 0; i < 10; ++i) xcd_barrier(bar); }
    if (IN(2)) {
        pg8::Gemm g{(const pg8::bf16_t*)(a.ws + WS_H), (const pg8::bf16_t*)(a.ws + WS_WIN), MTOK, NINP, DM}; pg8::StaticOrder S; S.init(MTOK, NINP, G, (int)blockIdx.x);
        EpiInProj E{a.ws, a.in[IN_LBL], a.in[IN_QG], a.in[IN_KG], a.in[IN_IKG], a.in[IN_IKB]};
        TWICE(2, (pg8::gemm_phase<EpiInProj, pg8::StaticOrder, true, true>(lds + RING_OFF, g, S, E)));
        SEAM(2);
    }
    if (IN(3)) {
        REP(30) for (int it = blockIdx.x; it < 256; it += G) { const int b = it >> 7, p = it & 127; idx_item<false>(a, lds, b, p, tid, lane, wave); idx_item<false>(a, lds, b, 255 - p, tid, lane, wave); }
        if (PROBE_REP == 33) for (int it = blockIdx.x; it < 256; it += G) { const int b = it >> 7, p = it & 127; idx_item<true>(a, lds, b, p, tid, lane, wave); idx_item<true>(a, lds, b, 255 - p, tid, lane, wave); }
        REP(31) for (int it = blockIdx.x; it < 1024; it += G) hgrn_local_item(a, lds, it, tid, lane, wave);
        SEAM(3);
    }
    if (IN(4)) { phase4(a, tid, G); SEAM(4); }
    if (IN(5)) {
        const int vcu = xvcu;
        REP(50) for (int it = vcu; it < 256; it += G) { const int bh = it >> 4, s = it & 15; attn_item<0>(a, lds, bh >> 3, bh & 7, s, tid, lane, wave); attn_item<0>(a, lds, bh >> 3, bh & 7, 31 - s, tid, lane, wave); }
        if (PROBE_REP >= 52 && PROBE_REP <= 55) for (int it = vcu; it < 256; it += G) { const int bh = it >> 4, s = it & 15; constexpr int DM_ = (PROBE_REP >= 52 && PROBE_REP <= 55) ? PROBE_REP - 51 : 1; attn_item<DM_>(a, lds, bh >> 3, bh & 7, s, tid, lane, wave); attn_item<DM_>(a, lds, bh >> 3, bh & 7, 31 - s, tid, lane, wave); }
        REP(51) for (int it = blockIdx.x; it < 1024; it += G) hgrn_out_item(a, lds, it, tid, lane, wave);
        SEAM(5);
    }
    if (IN(6)) {
        pg8::Gemm g{(const pg8::bf16_t*)(a.ws + WS_H), (const pg8::bf16_t*)(a.ws + WS_WOUT), MTOK, DM, DM}; pg8::StaticOrder S; S.init(MTOK, DM, G, (int)blockIdx.x);
        EpiOutProj E{a.in[IN_X], a.out, (const float*)(a.ws + WS_MODF)};
        TWICE(6, (pg8::gemm_phase<EpiOutProj, pg8::StaticOrder, false, true>(lds + RING_OFF, g, S, E)));
        SEAM(6);
    }
    if (IN(7)) { phase7(a, lds, tid, lane, wave, G); if (IN(7) && IN(9)) xcd_barrier(bar); }
    if (IN(9)) {
        build_buckets(a, lds, tid);
        pg8::Gemm g{(const pg8::bf16_t*)(a.ws + WS_H2S), (const pg8::bf16_t*)(a.ws + WS_W13), NSROWS, 16 * 1024, DM};
        MoeSched1 S{(const LAS int*)(lds + MB_BLK), *(const LAS int*)(lds + MB_NBLK), G, xvcu};
        EpiMoe1 E{(bf16*)(a.ws + WS_HE), (const f32x2*)(a.ws + WS_WSORT)};
        TWICE(9, (pg8::gemm_phase<EpiMoe1, MoeSched1, true, true>(lds + RING_OFF, g, S, E)));
        SEAM(9);
    }
    if (IN(10)) {
        build_buckets(a, lds, tid);
        pg8::Gemm g{(const pg8::bf16_t*)(a.ws + WS_HE), (const pg8::bf16_t*)(a.ws + WS_W2), 2 * NSROWS, 16 * 1024, 512};
        MoeSched2 S{(const LAS int*)(lds + MB_BLK), *(const LAS int*)(lds + MB_NBLK), G, xvcu};
        EpiMoe2 E{a.out, (const float*)(a.ws + WS_MODF), (const int*)(a.ws + WS_STOK), (const LAS int*)(lds + MB_BLK), (const LAS int*)(lds + MB_BLKK), (const LAS int*)(lds + MB_CNT)};
        pg8::gemm_phase<EpiMoe2, MoeSched2, false, true>(lds + RING_OFF, g, S, E);
    }
#undef IN
#undef SEAM
}

extern "C" void kernel_launch(void* const* d_in, const int* in_sizes, int n_in, void* d_out, int out_size, void* d_ws, size_t ws_size, hipStream_t stream) {
    static int grid = 0;
    if (grid == 0) {
        if (n_in != N_IN || in_sizes[0] != MTOK * DM || out_size != MTOK * DM || ws_size < WS_END) { fprintf(stderr, "kernel_launch: unexpected shapes (n_in %d, in0 %d, out %d, ws %zu); nothing launched\n", n_in, n_in > 0 ? in_sizes[0] : -1, out_size, ws_size); grid = -1; return; }
        int dev = 0, cus = 0, per_cu = 0;
        if (hipGetDevice(&dev) != hipSuccess || hipDeviceGetAttribute(&cus, hipDeviceAttributeMultiprocessorCount, dev) != hipSuccess) { grid = -1; return; }
        if (hipFuncSetAttribute((const void*)fwd, hipFuncAttributeMaxDynamicSharedMemorySize, LDS_BYTES) != hipSuccess) { fprintf(stderr, "kernel_launch: hipFuncSetAttribute failed\n"); grid = -1; return; }
        if (hipOccupancyMaxActiveBlocksPerMultiprocessor(&per_cu, (const void*)fwd, NWAVES * 64, LDS_BYTES) != hipSuccess || per_cu < 1) fprintf(stderr, "kernel_launch: occupancy query reports %d\n", per_cu);
        (void)hipGetLastError();
        grid = cus;
    }
    if (grid < 0) return;
    if (hipMemsetAsync((char*)d_ws + WS_CTL, 0, CTL_ZERO_BYTES, stream) != hipSuccess) return;
    Args a{};
    for (int i = 0; i < N_IN; ++i) a.in[i] = (const float*)d_in[i];
    a.out = (float*)d_out; a.ws = (unsigned char*)d_ws;
    constexpr int NL = MK_N_LAUNCHES;
    for (int li = 0; li < NL; ++li) {
        a.ph_lo = (NL == 1) ? 0 : li; a.ph_hi = (NL == 1) ? NPH : li + 1;
        hipLaunchKernelGGL(fwd, dim3(grid), dim3(NWAVES * 64), LDS_BYTES, stream, a);
        const hipError_t le = hipPeekAtLastError();
        if (le != hipSuccess) { fprintf(stderr, "kernel_launch: launch %d failed: %s\n", li, hipGetErrorName(le)); break; }
    }
}
```

```cpp
#include <hip/hip_runtime.h>
#include <cstdio>
#include <cstdint>
namespace pg8 {
#define PG8_LAS __attribute__((address_space(3)))
typedef unsigned short bf16_t;
typedef short bf16x8 __attribute__((ext_vector_type(8)));
typedef float f32x4 __attribute__((ext_vector_type(4)));
typedef unsigned u32x4 __attribute__((ext_vector_type(4)));
constexpr int BM = 256, BK = 64, HALF = 128, HTB = HALF * BK * 2  , STAGE_BYTES = 8 * HTB, NXCD = 8, WGM = 8;

__host__ __device__ __forceinline__ int lds_byte(int r, int c) { const int st = (r >> 4) * 2 + (c >> 5), rr = r & 15, cc = c & 31, ob = rr * 64 + cc * 2; return st * 1024 + (ob ^ (((ob >> 9) & 1) << 5)); }
__host__ __device__ __forceinline__ void stage_rc(int b, int& R, int& C) { const int st = b / 1024, sb = b % 1024, swz = sb ^ (((sb >> 9) & 1) << 5); R = (st >> 1) * 16 + swz / 64; C = (st & 1) * 32 + (swz % 64) / 2; }
__host__ __device__ __forceinline__ int perm32(int rho) { const int n = rho >> 4, i = rho & 15; return 8 * (i >> 2) + 4 * n + (i & 3); }

struct Unit { int pm, pn, aux, cont; };
struct Gemm { const bf16_t* A; const bf16_t* Bt; int M, N, K; };

struct StaticOrder {
    int nM, nN, nwg, G, c;
    __host__ __device__ void init(int M, int N, int G_, int c_) { nM = M / BM; nN = N / BM; nwg = nM * nN; G = G_; c = c_; }
    __host__ __device__ bool next(int i, Unit& u) const {
        const long L = (long)i * G + c; if (L >= nwg) return false;
        int wgid = (int)L; { const int q = nwg / NXCD, r = nwg % NXCD, xcd = wgid % NXCD, off = wgid / NXCD; wgid = (xcd < r ? xcd * (q + 1) : r * (q + 1) + (xcd - r) * q) + off; }
        const int nig = WGM * nN, gid = wgid / nig, fm = gid * WGM, gsz = (nM - fm) < WGM ? (nM - fm) : WGM;
        u.pm = fm + ((wgid % nig) % gsz); u.pn = (wgid % nig) / gsz; u.aux = 0; u.cont = 0; return true;
    }
    __device__ __forceinline__ void a_ready(const Unit&) const {}
    __device__ __forceinline__ void done(const Unit&) const {}
};

__device__ __forceinline__ unsigned cvt_pk_bf16(float lo, float hi) { unsigned r; asm volatile("v_cvt_pk_bf16_f32 %0, %1, %2" : "=v"(r) : "v"(lo), "v"(hi)); return r; }
typedef float f32x2 __attribute__((ext_vector_type(2)));

template <class Epi, class Sched, bool ALIGN_EPI = false, bool SP2 = false>
__device__ __forceinline__ void gemm_phase(PG8_LAS unsigned char* lds, const Gemm g, const Sched& S, const Epi& E) {
    const int tid = threadIdx.x, wid = __builtin_amdgcn_readfirstlane(tid >> 6), lane = tid & 63, wr = wid >> 2, wc = wid & 3, fr = lane & 15, fq = lane >> 4;
    const int K = g.K, nt = K / BK;
    unsigned voffA[2], voffB[2];
#pragma unroll
    for (int i = 0; i < 2; ++i) { int R, C; stage_rc(tid * 16 + i * 8192, R, C); const int Rb = Epi::PERM ? ((R & ~31) + perm32(R & 31)) : R;
        voffA[i] = (unsigned)(R * K + C) * 2u; voffB[i] = (unsigned)(Rb * K + C) * 2u; }
    const size_t kstep = (size_t)(BK * 2);
    const size_t hstep = (size_t)HALF * K * 2;
    const size_t tstep = 2 * hstep;
    const unsigned ldsw = (unsigned)wid * 1024u;
    const int aoff = lds_byte(wr * 64 + fr, fq * 8), boff = lds_byte(wc * 32 + fr, fq * 8);
#define PG8_SA(b, h) (((b) * 2 + (h)) * HTB)
#define PG8_SB(b, h) ((4 + (b) * 2 + (h)) * HTB)
#define PG8_STAGE(bufoff, gbase, voff) do { _Pragma("unroll") for (int _i = 0; _i < 2; ++_i) \
        __builtin_amdgcn_global_load_lds((const unsigned*)((const char*)(gbase) + (voff)[_i]), (PG8_LAS unsigned*)(lds + (bufoff) + ldsw + _i * 8192), 16, 0, 0); } while (0)
#define PG8_LDA(dst, b, h) do { _Pragma("unroll") for (int m = 0; m < 4; ++m) _Pragma("unroll") for (int k = 0; k < 2; ++k) dst[m][k] = *(const PG8_LAS bf16x8*)(lds + PG8_SA(b, h) + aoff + m * 2048 + k * 1024); } while (0)
#define PG8_LDB(dst, b, h) do { _Pragma("unroll") for (int n = 0; n < 2; ++n) _Pragma("unroll") for (int k = 0; k < 2; ++k) dst[n][k] = *(const PG8_LAS bf16x8*)(lds + PG8_SB(b, h) + boff + n * 2048 + k * 1024); } while (0)
#define PG8_MMA(ai, bj, At, Bt) do { __builtin_amdgcn_s_setprio(1); _Pragma("unroll") for (int m = 0; m < 4; ++m) _Pragma("unroll") for (int n = 0; n < 2; ++n) _Pragma("unroll") for (int k = 0; k < 2; ++k) \
        acc[ai][bj][m][n] = __builtin_amdgcn_mfma_f32_16x16x32_bf16(Bt[n][k], At[m][k], acc[ai][bj][m][n], 0, 0, 0); __builtin_amdgcn_s_setprio(0); } while (0)
#define PG8_WAIT_V(n) asm volatile("s_waitcnt vmcnt(" #n ")" ::: "memory")
#define PG8_WAIT_L(n) asm volatile("s_waitcnt lgkmcnt(" #n ")" ::: "memory")
#define PG8_BAR __builtin_amdgcn_s_barrier()
#define PG8_SCHED __builtin_amdgcn_sched_barrier(0)
    Unit cur, nxt; int ui = 0;
    if (!S.next(0, cur)) return;
    f32x4 acc[2][2][4][2];
#pragma unroll
    for (int a = 0; a < 2; ++a)
#pragma unroll
        for (int b = 0; b < 2; ++b)
#pragma unroll
            for (int m = 0; m < 4; ++m)
#pragma unroll
                for (int n = 0; n < 2; ++n) acc[a][b][m][n] = (f32x4){0.f, 0.f, 0.f, 0.f};
    bf16x8 At[4][2], B0[2][2], B1[2][2];
    const char* cA = (const char*)g.A + (size_t)cur.pm * tstep; const char* cB = (const char*)g.Bt + (size_t)cur.pn * tstep;
    S.a_ready(cur);
    if constexpr (SP2) {
        PG8_STAGE(PG8_SB(0, 0), cB, voffB); PG8_STAGE(PG8_SB(0, 1), cB + hstep, voffB); PG8_STAGE(PG8_SA(0, 0), cA, voffA); PG8_STAGE(PG8_SA(0, 1), cA + hstep, voffA);
        if (wr == 1) PG8_BAR;
        PG8_WAIT_V(2); PG8_BAR;
        PG8_STAGE(PG8_SB(1, 0), cB + kstep, voffB); PG8_STAGE(PG8_SA(1, 0), cA + kstep, voffA); PG8_STAGE(PG8_SB(1, 1), cB + hstep + kstep, voffB);
        PG8_WAIT_V(6); PG8_BAR;
    } else {
        PG8_STAGE(PG8_SB(0, 0), cB, voffB); PG8_STAGE(PG8_SA(0, 0), cA, voffA); PG8_STAGE(PG8_SB(0, 1), cB + hstep, voffB); PG8_STAGE(PG8_SA(0, 1), cA + hstep, voffA);
        if (wr == 1) PG8_BAR;
        PG8_WAIT_V(4); PG8_BAR;
        PG8_STAGE(PG8_SB(1, 0), cB + kstep, voffB); PG8_STAGE(PG8_SA(1, 0), cA + kstep, voffA); PG8_STAGE(PG8_SB(1, 1), cB + hstep + kstep, voffB);
        PG8_WAIT_V(6); PG8_BAR;
    }
    for (;;) {
        const bool has_next = S.next(ui + 1, nxt);
        const char* nA = has_next ? (const char*)g.A + (size_t)nxt.pm * tstep : cA; const char* nB = has_next ? (const char*)g.Bt + (size_t)nxt.pn * tstep : cB;
        for (int t = 0; t < nt; t += 2) {
            const bool last = (t == nt - 2);
            const char* a1 = cA + (size_t)(t + 1) * kstep;
            const char* a2 = last ? nA : cA + (size_t)(t + 2) * kstep; const char* b2 = last ? nB : cB + (size_t)(t + 2) * kstep;
            const char* a3 = a2 + kstep; const char* b3 = b2 + kstep;
            if (last && has_next) S.a_ready(nxt);
            if constexpr (SP2) {
            PG8_LDB(B0, 0, 0); PG8_LDB(B1, 0, 1); PG8_SCHED; PG8_LDA(At, 0, 0); PG8_STAGE(PG8_SA(1, 1), a1 + hstep, voffA);
            PG8_WAIT_V(8); PG8_WAIT_L(0); PG8_BAR; PG8_MMA(0, 0, At, B0); PG8_MMA(0, 1, At, B1); PG8_BAR; PG8_SCHED;
            PG8_LDA(At, 0, 1); PG8_STAGE(PG8_SB(0, 0), b2, voffB); PG8_STAGE(PG8_SB(0, 1), b2 + hstep, voffB); PG8_STAGE(PG8_SA(0, 0), a2, voffA);
            PG8_WAIT_V(8); PG8_WAIT_L(0); PG8_BAR; PG8_MMA(1, 0, At, B0); PG8_MMA(1, 1, At, B1); PG8_BAR; PG8_SCHED;
            PG8_LDB(B0, 1, 0); PG8_LDB(B1, 1, 1); PG8_SCHED; PG8_LDA(At, 1, 0); PG8_STAGE(PG8_SA(0, 1), a2 + hstep, voffA);
            PG8_WAIT_V(8); PG8_WAIT_L(0); PG8_BAR; PG8_MMA(0, 0, At, B0); PG8_MMA(0, 1, At, B1); PG8_BAR; PG8_SCHED;
            PG8_LDA(At, 1, 1); PG8_STAGE(PG8_SB(1, 0), b3, voffB); PG8_STAGE(PG8_SB(1, 1), b3 + hstep, voffB); PG8_STAGE(PG8_SA(1, 0), a3, voffA);
            PG8_WAIT_V(8); PG8_WAIT_L(0); PG8_BAR; PG8_MMA(1, 0, At, B0); PG8_MMA(1, 1, At, B1); PG8_BAR; PG8_SCHED;
            } else {
            PG8_LDB(B0, 0, 0); PG8_SCHED; PG8_LDA(At, 0, 0); PG8_STAGE(PG8_SA(1, 1), a1 + hstep, voffA);
            PG8_WAIT_L(8); PG8_BAR; PG8_WAIT_L(0); PG8_MMA(0, 0, At, B0); PG8_BAR; PG8_SCHED;
            PG8_LDB(B1, 0, 1); PG8_STAGE(PG8_SB(0, 0), b2, voffB);
            PG8_BAR; PG8_WAIT_L(0); PG8_MMA(0, 1, At, B1); PG8_BAR;
            PG8_LDA(At, 0, 1); PG8_STAGE(PG8_SA(0, 0), a2, voffA);
            PG8_BAR; PG8_WAIT_L(0); PG8_MMA(1, 0, At, B0); PG8_BAR; PG8_SCHED;
            PG8_STAGE(PG8_SB(0, 1), b2 + hstep, voffB);
            PG8_WAIT_V(6); PG8_BAR; PG8_MMA(1, 1, At, B1); PG8_BAR;
            PG8_LDB(B0, 1, 0); PG8_SCHED; PG8_LDA(At, 1, 0); PG8_STAGE(PG8_SA(0, 1), a2 + hstep, voffA);
            PG8_WAIT_L(8); PG8_BAR; PG8_WAIT_L(0); PG8_MMA(0, 0, At, B0); PG8_BAR; PG8_SCHED;
            PG8_LDB(B1, 1, 1); PG8_STAGE(PG8_SB(1, 0), b3, voffB);
            PG8_BAR; PG8_WAIT_L(0); PG8_MMA(0, 1, At, B1); PG8_BAR;
            PG8_LDA(At, 1, 1); PG8_STAGE(PG8_SA(1, 0), a3, voffA);
            PG8_BAR; PG8_WAIT_L(0); PG8_MMA(1, 0, At, B0); PG8_BAR; PG8_SCHED;
            PG8_STAGE(PG8_SB(1, 1), b3 + hstep, voffB);
            PG8_WAIT_V(6); PG8_BAR; PG8_MMA(1, 1, At, B1); PG8_BAR;
            }
        }
        if constexpr (ALIGN_EPI) { if (wr == 0) PG8_BAR; }
        if constexpr (!Epi::AFTER_DRAIN) { if (!cur.cont) E(acc, cur, wr, wc, fr, fq); S.done(cur); }
        if (!has_next) break;
        if (!cur.cont)
#pragma unroll
        for (int a = 0; a < 2; ++a)
#pragma unroll
            for (int b = 0; b < 2; ++b)
#pragma unroll
                for (int m = 0; m < 4; ++m)
#pragma unroll
                    for (int n = 0; n < 2; ++n) acc[a][b][m][n] = (f32x4){0.f, 0.f, 0.f, 0.f};
        cur = nxt; cA = nA; cB = nB; ++ui;
        if constexpr (ALIGN_EPI) { if (wr == 1) PG8_BAR; }
    }
    PG8_WAIT_V(0);
    if constexpr (!ALIGN_EPI) { if (wr == 0) PG8_BAR; }
    PG8_BAR;
    if constexpr (Epi::AFTER_DRAIN) { E.fused(acc, cur, wr, wc, fr, fq, lds, wid, lane); S.done(cur); }
#undef PG8_SA
#undef PG8_SB
#undef PG8_STAGE
#undef PG8_LDA
#undef PG8_LDB
#undef PG8_MMA
#undef PG8_WAIT_V
#undef PG8_WAIT_L
#undef PG8_BAR
#undef PG8_SCHED
}
}

#define GAS __attribute__((address_space(1)))
#define LAS __attribute__((address_space(3)))
typedef unsigned short bf16;
typedef unsigned v4u __attribute__((ext_vector_type(4)));
typedef float f32x4 __attribute__((ext_vector_type(4)));
typedef short bf16x8 __attribute__((ext_vector_type(8)));
typedef GAS unsigned gu32;
typedef GAS unsigned long long gu64;
#define RLX_AGENT __ATOMIC_RELAXED, __HIP_MEMORY_SCOPE_AGENT
#define LDS_WAIT() asm volatile("s_waitcnt lgkmcnt(0)" ::: "memory")
#define VM_WAIT() asm volatile("s_waitcnt vmcnt(0)" ::: "memory")
__device__ __forceinline__ unsigned long long rt() { return __builtin_amdgcn_s_memrealtime(); }
__device__ __forceinline__ unsigned f2bf(float f) { unsigned u = __builtin_bit_cast(unsigned, f); return (u + 0x7fffu + ((u >> 16) & 1u)) >> 16; }
__device__ __forceinline__ unsigned pk2(float lo, float hi) { return f2bf(lo) | (f2bf(hi) << 16); }

#define XB_TMO      128
#define XB_XCNT(j)  (256  + 64 * (j))
#define XB_XSUB(j)  (1280 + 64 * (j))
#define XB_XGEN(j)  (2304 + 64 * (j))
#define XB_TOP      3328
#define XB_TOPGEN   3392
#define XCD_BAR_WORDS 3456
#define XB_SPIN_CAP (1u << 18)

__device__ __forceinline__ unsigned xb_ld(unsigned* p)              { return __hip_atomic_load(p, __ATOMIC_RELAXED, __HIP_MEMORY_SCOPE_AGENT); }
__device__ __forceinline__ unsigned xb_add(unsigned* p, unsigned v) { return __hip_atomic_fetch_add(p, v, __ATOMIC_RELAXED, __HIP_MEMORY_SCOPE_AGENT); }
__device__ __forceinline__ unsigned xb_xcc_id() { return (unsigned)__builtin_amdgcn_s_getreg((3 << 11) | 20) & 0xFu; }
#define XB_SPIN(cond, bar) do { unsigned _sp = 0; while (cond) { __builtin_amdgcn_s_sleep(1); \
    if ((++_sp & 255u) == 0u) { if (xb_ld(&(bar)[XB_TMO])) break; if (_sp > XB_SPIN_CAP) { atomicAdd(&(bar)[XB_TMO], 1u); break; } } } } while (0)

struct XcdBarrier {
    unsigned* bar; unsigned x;
    volatile LAS unsigned* st;
};

__device__ __forceinline__ XcdBarrier xcd_barrier_post(unsigned* bar, volatile LAS unsigned* st) {
    XcdBarrier b; b.bar = bar; b.x = xb_xcc_id(); b.st = st;
    if (threadIdx.x == 0) (void)xb_add(&bar[XB_XCNT(b.x)], 1u);
    return b;
}
__device__ __forceinline__ void xcd_barrier_complete(unsigned* bar, unsigned x, unsigned& nloc, unsigned& nx) {
    const unsigned G = gridDim.x * gridDim.y * gridDim.z;
    unsigned sum, cnt, mine, sp = 0u;
    for (;;) {
        sum = 0u; cnt = 0u; mine = 0u;
#pragma unroll
        for (unsigned j = 0; j < 16; ++j) { const unsigned c = xb_ld(&bar[XB_XCNT(j)]); sum += c; cnt += (c > 0u) ? 1u : 0u; mine = (j == x) ? c : mine; }
        if (sum == G) break;
        __builtin_amdgcn_s_sleep(1);
        if ((++sp & 255u) == 0u) { if (xb_ld(&bar[XB_TMO])) break; if (sp > XB_SPIN_CAP) { atomicAdd(&bar[XB_TMO], 1u); break; } }
    }
    nloc = mine > 0u ? mine : 1u; nx = cnt > 0u ? cnt : 1u;
}

__device__ __forceinline__ void xcd_barrier(const XcdBarrier& b) {
    asm volatile("s_waitcnt vmcnt(0)" ::: "memory");
    __syncthreads();
    if (threadIdx.x == 0) {
        unsigned* bar = b.bar;
        __builtin_amdgcn_s_waitcnt(0);
        unsigned nloc = b.st[0], nx = b.st[1];
        if (nloc == 0u) { xcd_barrier_complete(bar, b.x, nloc, nx); b.st[0] = nloc; b.st[1] = nx; }
        const unsigned old = xb_add(&bar[XB_XSUB(b.x)], 1u);
        const unsigned gen = old / nloc;
        if (old + 1u == (gen + 1u) * nloc) {
            __builtin_amdgcn_fence(__ATOMIC_RELEASE, "agent");
            asm volatile("s_waitcnt vmcnt(0)" ::: "memory");
            const unsigned og = xb_add(&bar[XB_TOP], 1u);
            const unsigned tg = og / nx;
            if (og + 1u == (tg + 1u) * nx) xb_add(&bar[XB_TOPGEN], 1u);
            else XB_SPIN(xb_ld(&bar[XB_TOPGEN]) == tg, bar);
            __builtin_amdgcn_fence(__ATOMIC_ACQUIRE, "agent");
            xb_add(&bar[XB_XGEN(b.x)], 1u);
            asm volatile("s_waitcnt vmcnt(0)" ::: "memory");
        } else {
            XB_SPIN(xb_ld(&bar[XB_XGEN(b.x)]) == gen, bar);
            __builtin_amdgcn_fence(__ATOMIC_ACQUIRE, "agent");
            asm volatile("s_waitcnt vmcnt(0)" ::: "memory");
        }
    }
    __syncthreads();
}


#ifndef PROBE_REP
#define PROBE_REP -1
#endif
constexpr int NB = 2, SEQ = 8192, MTOK = NB * SEQ, DM = 1024, DIN = 4168, NINP = 4096;
constexpr int NCOMBO = 24, NROWBLK = 88, NSROWS = NROWBLK * 256;
constexpr float EPS = 1e-6f, LOG2E = 1.4426950408889634f, LN2 = 0.6931471805599453f, QSCALE = 0.125f * 1.4426950408889634f;
enum { IN_X = 0, IN_C, IN_WADA, IN_BADA, IN_N1G, IN_N2G, IN_WIN, IN_LBL, IN_RECG, IN_QG, IN_KG, IN_IKG, IN_IKB, IN_ATTG, IN_RELB, IN_WOUT, IN_WRG, IN_BRG, IN_WRE, IN_BRE, IN_W1, IN_W3, IN_W2, N_IN };

constexpr size_t MiB = 1u << 20;
constexpr size_t WS_CTL = 0, CTL_ZERO_BYTES = 1 * MiB;
constexpr size_t WS_MODP = 1 * MiB;
constexpr size_t WS_MODF = 1 * MiB + 512 * 1024;
constexpr size_t WS_WIN = 2 * MiB;
constexpr size_t WS_WSM = 10 * MiB + 512 * 1024;
constexpr size_t WS_WOUT = 11 * MiB;
constexpr size_t WS_W13 = 13 * MiB;
constexpr size_t WS_W2 = 45 * MiB;
constexpr size_t WS_LS = 13 * MiB;
constexpr size_t WS_MASK = 45 * MiB;
constexpr size_t WS_H = 61 * MiB;
constexpr size_t WS_QR = 93 * MiB, WS_LF = 109 * MiB, WS_VR = 141 * MiB, WS_GR = 157 * MiB, WS_AQ = 173 * MiB, WS_AK = 189 * MiB, WS_AV = 205 * MiB, WS_IQ = 221 * MiB;
constexpr size_t WS_IK = 237 * MiB, WS_IW = 239 * MiB, WS_DEC = 239 * MiB + 512 * 1024;
constexpr size_t WS_ROUTE = 240 * MiB;
constexpr size_t WS_STOK = 241 * MiB;
constexpr size_t WS_WSORT = 242 * MiB;
constexpr size_t WS_H2S = 93 * MiB;
constexpr size_t WS_HE = 141 * MiB;
constexpr size_t WS_END = 256 * MiB;
static_assert(WS_H2S + (size_t)NSROWS * 1024 * 2 <= WS_HE && WS_HE + (size_t)NSROWS * 1024 * 2 <= WS_ROUTE && WS_WSORT + NSROWS * 8 <= WS_END, "ws map");
constexpr int CW_FAIL = 16;
constexpr int CW_BAR = 4096;
constexpr int CW_CNT = 8192, CW_CUR = 8192 + 64;

constexpr int RING_OFF = 0, RING_BYTES = 131072, MISC_OFF = 147456, LDS_BYTES = 163840;
constexpr int NWAVES = 8, NPH = 11;

typedef float f32x16 __attribute__((ext_vector_type(16)));
typedef float f32x2 __attribute__((ext_vector_type(2)));
typedef unsigned v2u __attribute__((ext_vector_type(2)));
typedef short v4i16_t __attribute__((ext_vector_type(4)));
typedef short s16x4 __attribute__((ext_vector_type(4)));

struct Args { const float* in[N_IN]; float* out; unsigned char* ws; int ph_lo, ph_hi; };

__device__ __forceinline__ float wave_sum(float v) {
#pragma unroll
    for (int o = 1; o < 64; o <<= 1) v += __shfl_xor(v, o);
    return v;
}
__device__ __forceinline__ float bf2f(unsigned short h) { return __uint_as_float((unsigned)h << 16); }
__device__ __forceinline__ float bflo(unsigned w) { return __uint_as_float(w << 16); }
__device__ __forceinline__ float bfhi(unsigned w) { return __uint_as_float(w & 0xffff0000u); }
__device__ __forceinline__ unsigned cvtpk(float lo, float hi) { unsigned r; asm volatile("v_cvt_pk_bf16_f32 %0, %1, %2" : "=v"(r) : "v"(lo), "v"(hi)); return r; }
typedef float f32x2_t __attribute__((ext_vector_type(2))); typedef __bf16 bf16x2_t __attribute__((ext_vector_type(2)));
__device__ __forceinline__ unsigned cvtpk_s(float lo, float hi) { f32x2_t v = {lo, hi}; bf16x2_t b = __builtin_convertvector(v, bf16x2_t); return __builtin_bit_cast(unsigned, b); }
__device__ __forceinline__ float fexp2(float x) { return __builtin_amdgcn_exp2f(x); }
__device__ __forceinline__ float fexp(float x) { return __builtin_amdgcn_exp2f(x * LOG2E); }
__device__ __forceinline__ float flog(float x) { return __builtin_amdgcn_logf(x) * LN2; }
__device__ __forceinline__ float frcp(float x) { return __builtin_amdgcn_rcpf(x); }
__device__ __forceinline__ float frsq(float x) { return __builtin_amdgcn_rsqf(x); }
__device__ __forceinline__ float silu_f(float v) { return v * frcp(1.f + fexp(-v)); }
__device__ __forceinline__ float sigm_f(float v) { return frcp(1.f + fexp(-v)); }
__device__ __forceinline__ int crow(int r, int hi) { return (r & 3) + 8 * (r >> 2) + 4 * hi; }
#define MFMA32(a, b, c) __builtin_amdgcn_mfma_f32_32x32x16_bf16((a), (b), (c), 0, 0, 0)

struct WinMap { __device__ __forceinline__ int operator()(int n) const {
    if (n < 2048 || n >= 3072) return n;
    const int j = (n - 2048) & 511, seg = (n - 2048) >> 9, h = j >> 6, d = j & 63; return (8 + seg * 2 + (h >> 2)) * 256 + 128 * (d >> 5) + 32 * (h & 3) + (d & 31); } };
struct WsmMap { __device__ __forceinline__ int operator()(int n) const { return n; } };
struct OffMap { int off; __device__ __forceinline__ int operator()(int n) const { return off + n; } };
struct W13Map { int base; __device__ __forceinline__ int operator()(int n) const { return base + (n >> 7) * 256 + (n & 127); } };

template <class Map>
__device__ __forceinline__ void transpose_item(const float* W, int N, int ldw, bf16* WT, int ldt, const Map map, LAS float* scr, int item, int lane) {
    const int nblk = (N + 31) / 32, kb = item / nblk, nb = item % nblk, k0 = 64 * kb, n0 = 32 * nb;
    const bool inb = (n0 + (lane & 31)) < N;
    float tv[32];
#pragma unroll
    for (int i = 0; i < 32; ++i) { const int kk = 2 * i + (lane >> 5); tv[i] = inb ? __builtin_nontemporal_load(W + (size_t)(k0 + kk) * ldw + n0 + (lane & 31)) : 0.f; }
#pragma unroll
    for (int i = 0; i < 32; ++i) { const int kk = 2 * i + (lane >> 5); scr[kk * 33 + (lane & 31)] = tv[i]; }
    LDS_WAIT(); asm volatile("" ::: "memory");
    const int c = lane & 7;
#pragma unroll
    for (int j = 0; j < 4; ++j) { const int n = (lane >> 3) + 8 * j; const LAS float* s = scr + (8 * c) * 33 + n;
        v4u o; o.x = pk2(s[0 * 33], s[1 * 33]); o.y = pk2(s[2 * 33], s[3 * 33]); o.z = pk2(s[4 * 33], s[5 * 33]); o.w = pk2(s[6 * 33], s[7 * 33]);
        if (n0 + n < N) *(GAS v4u*)(WT + (size_t)map(n0 + n) * ldt + k0 + 8 * c) = o; }
    LDS_WAIT(); asm volatile("" ::: "memory");
}

__device__ __forceinline__ void phase0(const Args& a, LAS unsigned char* lds, int tid, int lane, int wave, int G) {
    const float* wada = a.in[IN_WADA]; const float* cvec = a.in[IN_C]; float* modp = (float*)(a.ws + WS_MODP);
    for (int it = blockIdx.x; it < 192; it += G) {
        const int ks = it / 24, cg = it % 24, k0 = ks * 128 + wave * 16, col = cg * 256 + 4 * lane;
        f32x4 a0 = {0.f, 0.f, 0.f, 0.f}, a1 = {0.f, 0.f, 0.f, 0.f};
#pragma unroll 4
        for (int r = 0; r < 16; ++r) { const int k = k0 + r; const float s0 = silu_f(cvec[k]), s1 = silu_f(cvec[1024 + k]);
            const f32x4 w = *(const GAS f32x4*)(wada + (size_t)k * 6144 + col); a0 += w * s0; a1 += w * s1; }
        LAS float* red = (LAS float*)lds;
        *(LAS f32x4*)(red + wave * 512 + 4 * lane) = a0; *(LAS f32x4*)(red + wave * 512 + 256 + 4 * lane) = a1;
        __syncthreads();
        { float s = 0.f;
#pragma unroll
          for (int w = 0; w < 8; ++w) s += red[w * 512 + tid];
          const int b = tid >> 8, cc = tid & 255; modp[(size_t)(ks * 2 + b) * 6144 + cg * 256 + cc] = s; }
        __syncthreads();
    }
    LAS float* scr = (LAS float*)(lds + wave * 16384);
    const int gw = blockIdx.x * NWAVES + wave, NGW = G * NWAVES;
    constexpr int I_IN = 16 * 128, I_SM = 16 * 3, I_OUT = 16 * 32, I_Z = 24;
    bf16* win = (bf16*)(a.ws + WS_WIN); bf16* wsm = (bf16*)(a.ws + WS_WSM); bf16* wout = (bf16*)(a.ws + WS_WOUT);
    for (int it = gw; it < I_IN + I_SM + I_OUT + I_Z; it += NGW) {
        int r = it;
        if (r < I_IN) { transpose_item(a.in[IN_WIN], 4096, DIN, win, 1024, WinMap{}, scr, r, lane); continue; } r -= I_IN;
        if (r < I_SM) { transpose_item(a.in[IN_WIN] + 4096, DIN - 4096, DIN, wsm, 1024, WsmMap{}, scr, r, lane); continue; } r -= I_SM;
        if (r < I_OUT) { transpose_item(a.in[IN_WOUT], 1024, 1024, wout, 1024, OffMap{0}, scr, r, lane); continue; } r -= I_OUT;
        { GAS v4u* p = (GAS v4u*)(wsm + (size_t)(72 + r) * 1024) + lane; const v4u z = {0u, 0u, 0u, 0u}; p[0] = z; p[64] = z; }
    }
}

__device__ __forceinline__ void moe_weight_items(const Args& a, LAS float* scr, int gw, int NGW, int lane) {
    bf16* w13 = (bf16*)(a.ws + WS_W13); bf16* w2t = (bf16*)(a.ws + WS_W2);
    constexpr int I_1 = 16 * 16, I_2 = 8 * 32;
    for (int it = gw; it < 16 * (2 * I_1 + I_2); it += NGW) {
        const int e = it / (2 * I_1 + I_2); int r = it % (2 * I_1 + I_2);
        if (r < I_1) { transpose_item(a.in[IN_W1] + (size_t)e * 1024 * 512, 512, 512, w13, 1024, W13Map{e * 1024}, scr, r, lane); continue; } r -= I_1;
        if (r < I_1) { transpose_item(a.in[IN_W3] + (size_t)e * 1024 * 512, 512, 512, w13, 1024, W13Map{e * 1024 + 128}, scr, r, lane); continue; } r -= I_1;
        transpose_item(a.in[IN_W2] + (size_t)e * 512 * 1024, 1024, 1024, w2t, 512, OffMap{e * 1024}, scr, r, lane);
    }
}

__device__ __forceinline__ void phase1(const Args& a, LAS unsigned char* lds, int tid, int lane, int wave, int G) {
    LAS float* A1 = (LAS float*)lds; LAS float* S1 = A1 + 2048;
    const float* modp = (const float*)(a.ws + WS_MODP); const float* bada = a.in[IN_BADA]; const float* g = a.in[IN_N1G];
    for (int idx = tid; idx < 2048; idx += 512) { const int b = idx >> 10, i = idx & 1023; float sh = bada[i], sc = bada[1024 + i];
#pragma unroll
        for (int ks = 0; ks < 8; ++ks) { sh += modp[(size_t)(ks * 2 + b) * 6144 + i]; sc += modp[(size_t)(ks * 2 + b) * 6144 + 1024 + i]; }
        A1[idx] = g[i] * (1.f + sc); S1[idx] = sh; }
    float* modf = (float*)(a.ws + WS_MODF);
    for (int idx = blockIdx.x * 512 + tid; idx < 12288; idx += G * 512) { const int b = idx / 6144, j = idx % 6144; float s = bada[j];
#pragma unroll
        for (int ks = 0; ks < 8; ++ks) s += modp[(size_t)(ks * 2 + b) * 6144 + j];
        modf[idx] = s; }
    __syncthreads();
    constexpr int HT_OFF = 16384, HT_STRIDE = 2064, RED_OFF = HT_OFF + 32 * HT_STRIDE;
    const float* x = a.in[IN_X]; bf16* H = (bf16*)(a.ws + WS_H); const bf16* wsm = (const bf16*)(a.ws + WS_WSM);
    bf16* IK = (bf16*)(a.ws + WS_IK); float* IW = (float*)(a.ws + WS_IW);
    LAS float* red = (LAS float*)(lds + RED_OFF);
    for (int ch = blockIdx.x; ch < MTOK / 32; ch += G) {
        const int r0 = ch * 32, b = r0 >> 13;
        { f32x4 v[4][4];
#pragma unroll
          for (int jr = 0; jr < 4; ++jr) { const GAS f32x4* xr = (const GAS f32x4*)(x + (size_t)(r0 + wave * 4 + jr) * DM) + lane;
#pragma unroll
              for (int j = 0; j < 4; ++j) v[jr][j] = __builtin_nontemporal_load(xr + 64 * j); }
#pragma unroll
          for (int jr = 0; jr < 4; ++jr) {
              const int rl = wave * 4 + jr, m = r0 + rl; float s = 0.f;
#pragma unroll
              for (int j = 0; j < 4; ++j) s += (v[jr][j].x * v[jr][j].x + v[jr][j].y * v[jr][j].y) + (v[jr][j].z * v[jr][j].z + v[jr][j].w * v[jr][j].w);
              const float r = frsq(wave_sum(s) * (1.f / DM) + EPS);
              GAS v2u* o8 = (GAS v2u*)(H + (size_t)m * DM) + lane; LAS v2u* l8 = (LAS v2u*)(lds + HT_OFF + rl * HT_STRIDE) + lane;
#pragma unroll
              for (int j = 0; j < 4; ++j) { const f32x4 aa = *(LAS f32x4*)(A1 + b * 1024 + 256 * j + 4 * lane), ss = *(LAS f32x4*)(S1 + b * 1024 + 256 * j + 4 * lane);
                  const f32x4 h = v[jr][j] * r * aa + ss; v2u w; w.x = cvtpk(h.x, h.y); w.y = cvtpk(h.z, h.w); o8[64 * j] = w; l8[64 * j] = w; } } }
        __syncthreads();
        {
          const int hi = lane >> 5, m32 = lane & 31, kq = wave & 3;
          const LAS unsigned char* hb = lds + HT_OFF + m32 * HT_STRIDE + 16 * hi + kq * 512;
          f32x16 acc0 = {0.f, 0.f, 0.f, 0.f, 0.f, 0.f, 0.f, 0.f, 0.f, 0.f, 0.f, 0.f, 0.f, 0.f, 0.f, 0.f}, acc1 = acc0;
          if (wave < 4) {
              const bf16* w0 = wsm + (size_t)m32 * 1024 + 8 * hi + kq * 256; const bf16* w1 = w0 + 32 * 1024;
              bf16x8 wa[16], wb[16];
#pragma unroll
              for (int ks = 0; ks < 16; ++ks) { wa[ks] = *(const GAS bf16x8*)(w0 + 16 * ks); wb[ks] = *(const GAS bf16x8*)(w1 + 16 * ks); }
#pragma unroll
              for (int ks = 0; ks < 16; ++ks) { const bf16x8 bfr = *(const LAS bf16x8*)(hb + 32 * ks); acc0 = MFMA32(wa[ks], bfr, acc0); acc1 = MFMA32(wb[ks], bfr, acc1); }
#pragma unroll
              for (int i = 0; i < 16; ++i) { red[((kq * 2 + 0) * 16 + i) * 64 + lane] = acc0[i]; red[((kq * 2 + 1) * 16 + i) * 64 + lane] = acc1[i]; }
          } else {
              const bf16* w2 = wsm + (size_t)(64 + m32) * 1024 + 8 * hi + kq * 256;
              bf16x8 wa[16];
#pragma unroll
              for (int ks = 0; ks < 16; ++ks) wa[ks] = *(const GAS bf16x8*)(w2 + 16 * ks);
#pragma unroll
              for (int ks = 0; ks < 16; ++ks) { const bf16x8 bfr = *(const LAS bf16x8*)(hb + 32 * ks); acc0 = MFMA32(wa[ks], bfr, acc0); }
#pragma unroll
              for (int i = 0; i < 4; ++i) red[(8 * 16 + kq * 4 + i) * 64 + lane] = acc0[i];
          }
          __syncthreads();
          if (wave == 0) {
              float v0[16], v1[16], sm = 0.f;
#pragma unroll
              for (int i = 0; i < 16; ++i) { v0[i] = (red[(0 * 16 + i) * 64 + lane] + red[(2 * 16 + i) * 64 + lane]) + (red[(4 * 16 + i) * 64 + lane] + red[(6 * 16 + i) * 64 + lane]);
                  v1[i] = (red[(1 * 16 + i) * 64 + lane] + red[(3 * 16 + i) * 64 + lane]) + (red[(5 * 16 + i) * 64 + lane] + red[(7 * 16 + i) * 64 + lane]); sm += v0[i] + v1[i]; }
              sm += __shfl_xor(sm, 32); const float mu = sm * (1.f / 64.f); float q = 0.f;
#pragma unroll
              for (int i = 0; i < 16; ++i) { const float d0 = v0[i] - mu, d1 = v1[i] - mu; q += d0 * d0 + d1 * d1; }
              q += __shfl_xor(q, 32); const float rs = frsq(q * (1.f / 64.f) + EPS);
              const float* gk = a.in[IN_IKG]; const float* bk = a.in[IN_IKB]; bf16* dst = IK + (size_t)(r0 + m32) * 64;
#pragma unroll
              for (int i = 0; i < 16; i += 2) { const int d = crow(i, hi);
                  *(GAS unsigned*)(dst + d) = cvtpk((v0[i] - mu) * rs * gk[d] + bk[d], (v0[i + 1] - mu) * rs * gk[d + 1] + bk[d + 1]);
                  *(GAS unsigned*)(dst + 32 + d) = cvtpk((v1[i] - mu) * rs * gk[32 + d] + bk[32 + d], (v1[i + 1] - mu) * rs * gk[33 + d] + bk[33 + d]); }
          } else if (wave == 4) {
              f32x4 o;
#pragma unroll
              for (int i = 0; i < 4; ++i) o[i] = (red[(8 * 16 + 0 + i) * 64 + lane] + red[(8 * 16 + 4 + i) * 64 + lane]) + (red[(8 * 16 + 8 + i) * 64 + lane] + red[(8 * 16 + 12 + i) * 64 + lane]);
              *(GAS f32x4*)(IW + (size_t)(r0 + m32) * 8 + 4 * hi) = o * 0.35355339059327373f;
          }
        }
        __syncthreads();
    }
}

struct EpiInProj {
    static constexpr bool PERM = true, AFTER_DRAIN = false;
    unsigned char* ws; const float *lbl, *qg, *kg, *ikg, *ikb;
    __device__ __forceinline__ void operator()(const pg8::f32x4 (&acc)[2][2][4][2], const pg8::Unit& u, int wr, int wc, int fr, int fq) const {
        const int pn = u.pn, row0 = u.pm * 256 + wr * 64 + fr;
        if (pn < 2 || (pn >= 4 && pn < 8) || (pn >= 12 && pn < 16)) {
            size_t off; int ct; bool act;
            if (pn < 2) { off = WS_QR; ct = pn; act = true; } else if (pn < 6) { off = WS_VR; ct = pn - 4; act = false; } else if (pn < 8) { off = WS_GR; ct = pn - 6; act = true; }
            else if (pn < 14) { off = WS_AV; ct = pn - 12; act = false; } else { off = WS_IQ; ct = pn - 14; act = false; }
            bf16* dst = (bf16*)(ws + off); const int col0 = ct * 256 + wc * 32 + 8 * fq;
#pragma unroll
            for (int ai = 0; ai < 2; ++ai)
#pragma unroll
                for (int m = 0; m < 4; ++m) { bf16* rowp = dst + (size_t)(row0 + ai * 128 + m * 16) * 512 + col0;
#pragma unroll
                    for (int bj = 0; bj < 2; ++bj) { pg8::f32x4 v0 = acc[ai][bj][m][0], v1 = acc[ai][bj][m][1];
                        if (act) { v0 = (pg8::f32x4){silu_f(v0[0]), silu_f(v0[1]), silu_f(v0[2]), silu_f(v0[3])}; v1 = (pg8::f32x4){silu_f(v1[0]), silu_f(v1[1]), silu_f(v1[2]), silu_f(v1[3])}; }
                        v4u w; w.x = cvtpk(v0[0], v0[1]); w.y = cvtpk(v0[2], v0[3]); w.z = cvtpk(v1[0], v1[1]); w.w = cvtpk(v1[2], v1[3]);
                        *(GAS v4u*)(rowp + bj * 128) = w; } }
        } else if (pn < 4) {
            float* dst = (float*)(ws + WS_LF); const int col0 = (pn - 2) * 256 + wc * 32 + 8 * fq;
            float lb[2][8];
#pragma unroll
            for (int bj = 0; bj < 2; ++bj)
#pragma unroll
                for (int j = 0; j < 8; ++j) { const int c = col0 + bj * 128 + j; lb[bj][j] = frcp(1.f + fexp(lbl[512 + c] - lbl[c])); }
#pragma unroll
            for (int ai = 0; ai < 2; ++ai)
#pragma unroll
                for (int m = 0; m < 4; ++m) { float* rowp = dst + (size_t)(row0 + ai * 128 + m * 16) * 512 + col0;
#pragma unroll
                    for (int bj = 0; bj < 2; ++bj) { f32x4 o0, o1;
#pragma unroll
                        for (int j = 0; j < 4; ++j) { const float l0 = lb[bj][j], l1 = lb[bj][4 + j];
                            o0[j] = flog(l0 + (1.f - l0) * sigm_f(acc[ai][bj][m][0][j])); o1[j] = flog(l1 + (1.f - l1) * sigm_f(acc[ai][bj][m][1][j])); }
                        *(GAS f32x4*)(rowp + bj * 128) = o0; *(GAS f32x4*)(rowp + bj * 128 + 4) = o1; } }
        } else if (pn < 12) {
            const int seg = (pn - 8) >> 1, head = ((pn - 8) & 1) * 4 + wc; const float* gs = seg ? kg : qg; const float sc = seg ? 1.f : QSCALE;
            bf16* dst = (bf16*)(ws + (seg ? WS_AK : WS_AQ));
            f32x4 gv[2][2];
#pragma unroll
            for (int bj = 0; bj < 2; ++bj)
#pragma unroll
                for (int n = 0; n < 2; ++n) gv[bj][n] = *(const f32x4*)(gs + 32 * bj + 8 * fq + 4 * n) * sc;
#pragma unroll
            for (int ai = 0; ai < 2; ++ai)
#pragma unroll
                for (int m = 0; m < 4; ++m) { float ss = 0.f;
#pragma unroll
                    for (int bj = 0; bj < 2; ++bj)
#pragma unroll
                        for (int n = 0; n < 2; ++n) { const pg8::f32x4 v = acc[ai][bj][m][n]; ss += (v[0] * v[0] + v[1] * v[1]) + (v[2] * v[2] + v[3] * v[3]); }
                    ss += __shfl_xor(ss, 16); ss += __shfl_xor(ss, 32);
                    const float ri = frsq(ss * (1.f / 64.f) + EPS);
                    bf16* rowp = dst + (size_t)(row0 + ai * 128 + m * 16) * 512 + head * 64 + 8 * fq;
#pragma unroll
                    for (int bj = 0; bj < 2; ++bj) { const f32x4 v0 = acc[ai][bj][m][0] * ri * gv[bj][0], v1 = acc[ai][bj][m][1] * ri * gv[bj][1];
                        v4u w; w.x = cvtpk(v0[0], v0[1]); w.y = cvtpk(v0[2], v0[3]); w.z = cvtpk(v1[0], v1[1]); w.w = cvtpk(v1[2], v1[3]);
                        *(GAS v4u*)(rowp + bj * 32) = w; } }
        }
    }
};

constexpr int IDX_CAP = 768, IDX_KT_STRIDE = 144, IDX_STG = 128, IDX_KT_BYTES = IDX_STG * IDX_KT_STRIDE;
constexpr int IDX_CAND_OFF = 0, IDX_KT_OFF = NWAVES * 4 * IDX_CAP * 4, IDX_HIST_OFF = IDX_KT_OFF + 2 * IDX_KT_BYTES, IDX_DUM_OFF = IDX_HIST_OFF + NWAVES * 1024, IDX_FLAG_OFF = IDX_DUM_OFF + NWAVES * 256;
constexpr int IDX_PRMIN = 448;
static_assert(IDX_FLAG_OFF + 16 <= MISC_OFF, "indexer LDS");

__device__ __forceinline__ unsigned mono_pack(float s, int kidx) {
    const unsigned u = __float_as_uint(s); const unsigned m = u ^ ((unsigned)((int)u >> 31) | 0x80000000u);
    return (m & 0xFFFFE000u) | (unsigned)(8191 - kidx);
}
__device__ __forceinline__ int lane_prefix(unsigned long long bal) { return __builtin_amdgcn_mbcnt_hi((unsigned)(bal >> 32), __builtin_amdgcn_mbcnt_lo((unsigned)bal, 0u)); }
#define DPP_STEP(v, ctrl, rm) __builtin_amdgcn_update_dpp(0, (int)(v), (ctrl), (rm), 0xf, false)
__device__ __forceinline__ int scan_add(int v) {
    v += DPP_STEP(v, 0x111, 0xf); v += DPP_STEP(v, 0x112, 0xf); v += DPP_STEP(v, 0x114, 0xf); v += DPP_STEP(v, 0x118, 0xf); v += DPP_STEP(v, 0x142, 0xa); v += DPP_STEP(v, 0x143, 0xc); return v;
}
__device__ __forceinline__ unsigned umax2(unsigned a, unsigned b) { return a > b ? a : b; }
__device__ __forceinline__ unsigned wave_max_u(unsigned v) {
    v = umax2(v, (unsigned)DPP_STEP(v, 0x111, 0xf)); v = umax2(v, (unsigned)DPP_STEP(v, 0x112, 0xf)); v = umax2(v, (unsigned)DPP_STEP(v, 0x114, 0xf)); v = umax2(v, (unsigned)DPP_STEP(v, 0x118, 0xf));
    v = umax2(v, (unsigned)DPP_STEP(v, 0x142, 0xa)); v = umax2(v, (unsigned)DPP_STEP(v, 0x143, 0xc)); return (unsigned)__builtin_amdgcn_readlane((int)v, 63);
}

__device__ __forceinline__ unsigned idx_prune(LAS unsigned* buf, int cnt, int keep, LAS unsigned* hist, int lane) {
    constexpr int NV = IDX_CAP / 64; unsigned v[NV]; unsigned mx = 0u, mnc = 0u;
#pragma unroll
    for (int j = 0; j < NV; ++j) { const int idx = j * 64 + lane; const bool ok = idx < cnt; v[j] = ok ? buf[idx] : 0u; mx = umax2(mx, v[j]); mnc = umax2(mnc, ok ? ~v[j] : 0u); }
    mx = wave_max_u(mx); const unsigned mn = ~wave_max_u(mnc);
    unsigned lo = mn, wm1 = mx - mn;
    int sh = 24 - __clz((int)(wm1 | 1u)); sh = sh < 0 ? 0 : sh;
    int need = keep; unsigned T = 0u;
    for (int pass = 0; pass < 5; ++pass) {
        *(LAS v4u*)(hist + 4 * lane) = (v4u){0u, 0u, 0u, 0u};
        LDS_WAIT();
#pragma unroll
        for (int j = 0; j < NV; ++j) { const unsigned d = v[j] - lo; if ((j * 64 + lane) < cnt && d <= wm1) __hip_atomic_fetch_add(hist + (d >> sh), 1u, __ATOMIC_RELAXED, __HIP_MEMORY_SCOPE_WORKGROUP); }
        LDS_WAIT();
        const v4u h4 = *(const LAS v4u*)(hist + 4 * lane);
        const int s4 = (int)(h4.x + h4.y + h4.z + h4.w), P = scan_add(s4), tot = __builtin_amdgcn_readlane(P, 63);
        const int S = tot - P + s4;
        const unsigned long long bal = __ballot(S >= need);
        const int Ls = 63 - __clzll((long long)bal);
        const int Sab = __builtin_amdgcn_readlane(S - s4, Ls);
        const int h0 = __builtin_amdgcn_readlane((int)h4.x, Ls), h1 = __builtin_amdgcn_readlane((int)h4.y, Ls), h2 = __builtin_amdgcn_readlane((int)h4.z, Ls), h3 = __builtin_amdgcn_readlane((int)h4.w, Ls);
        int above = Sab, B = 3, nB = h3;
        if (above + h3 < need) { above += h3; B = 2; nB = h2; if (above + h2 < need) { above += h2; B = 1; nB = h1; if (above + h1 < need) { above += h1; B = 0; nB = h0; } } }
        const unsigned edge = lo + ((unsigned)(4 * Ls + B) << sh);
        need -= above;
        T = edge;
        if (nB == need || sh == 0) break;
        lo = edge; wm1 = (1u << sh) - 1u; sh = sh > 8 ? sh - 8 : 0;
    }
    int base = 0;
#pragma unroll
    for (int j = 0; j < NV; ++j) { const bool p = ((j * 64 + lane) < cnt) && v[j] >= T; const unsigned long long bal = __ballot(p); const int pre = lane_prefix(bal);
        if (p) buf[base + pre] = v[j]; base += __popcll(bal); }
    LDS_WAIT();
    return T;
}

template <bool DRY>
__device__ __forceinline__ bool idx_item(const Args& a, LAS unsigned char* lds, int b, int qblk, int tid, int lane, int wave, bool aggr) {
    const bf16* IQ = (const bf16*)(a.ws + WS_IQ); const bf16* IK = (const bf16*)(a.ws + WS_IK); const float* IW = (const float*)(a.ws + WS_IW); unsigned* MASK = (unsigned*)(a.ws + WS_MASK);
    const int t0 = qblk * 32 + wave * 4, nkeys = ((qblk >> 1) + 1) * 64, nst = (nkeys + IDX_STG - 1) / IDX_STG;
    const int hi = lane >> 5, m = lane & 31;
    bf16x8 af[4];
    { const int qa = 2 * ((m >> 2) & 1) + ((m >> 4) & 1), ha = 4 * ((m >> 3) & 1) + (m & 3); const size_t tok = (size_t)b * SEQ + t0 + qa;
      const float wsc = IW[tok * 8 + ha] * 0.125f;
#pragma unroll
      for (int ks = 0; ks < 4; ++ks) { const v4u raw = *(const GAS v4u*)(IQ + tok * 512 + ha * 64 + 16 * ks + 8 * hi); v4u o;
          o.x = cvtpk_s(bflo(raw.x) * wsc, bfhi(raw.x) * wsc); o.y = cvtpk_s(bflo(raw.y) * wsc, bfhi(raw.y) * wsc); o.z = cvtpk_s(bflo(raw.z) * wsc, bfhi(raw.z) * wsc); o.w = cvtpk_s(bflo(raw.w) * wsc, bfhi(raw.w) * wsc);
          af[ks] = __builtin_bit_cast(bf16x8, o); } }
    float cinf[16];
#pragma unroll
    for (int i = 0; i < 16; ++i) { const float w = IW[((size_t)b * SEQ + t0 + 2 * hi + (i >> 3)) * 8 + (i & 7)]; cinf[i] = w >= 0.f ? __builtin_inff() : -__builtin_inff(); }
    LAS unsigned* cb = (LAS unsigned*)(lds + IDX_CAND_OFF) + wave * 4 * IDX_CAP;
    LAS unsigned* cb0 = cb + (2 * hi) * IDX_CAP; LAS unsigned* cb1 = cb0 + IDX_CAP;
    LAS unsigned* hist = (LAS unsigned*)(lds + IDX_HIST_OFF) + wave * 256;
    LAS unsigned* dum = (LAS unsigned*)(lds + IDX_DUM_OFF) + wave * 64 + lane;
    int cnt0 = 0, cnt1 = 0; unsigned thr0 = DRY ? 0xffffffffu : 0u, thr1 = thr0;
    const unsigned himask = hi ? 0xffffffffu : 0u;
    const int skey = tid >> 3, sch = tid & 7;
    const bf16* ksrc = IK + ((size_t)b * SEQ + skey) * 64 + sch * 8;
    LAS unsigned char* kt = lds + IDX_KT_OFF; const int kdst = skey * IDX_KT_STRIDE + sch * 16;
    v4u kreg0 = *(const GAS v4u*)ksrc, kreg1 = kreg0;
    if (nkeys > 64) kreg1 = *(const GAS v4u*)(ksrc + 64 * 64);
    *(LAS v4u*)(kt + kdst) = kreg0; *(LAS v4u*)(kt + kdst + 64 * IDX_KT_STRIDE) = kreg1;
    __syncthreads();
    LAS unsigned* pflag = (LAS unsigned*)(lds + IDX_FLAG_OFF);
    if (tid < 4) pflag[tid] = 0u;
    __syncthreads();
#define IDX_MMA(accv, sub) do { accv = (f32x16){0.f, 0.f, 0.f, 0.f, 0.f, 0.f, 0.f, 0.f, 0.f, 0.f, 0.f, 0.f, 0.f, 0.f, 0.f, 0.f}; \
        _Pragma("unroll") for (int ks = 0; ks < 4; ++ks) { const bf16x8 bfr = *(const LAS bf16x8*)(kcur + (sub) * 32 * IDX_KT_STRIDE + 32 * ks); accv = MFMA32(af[ks], bfr, accv); } } while (0)
#define IDX_VALU(accv, sub) do { float s0 = 0.f, s1 = 0.f; \
        _Pragma("unroll") for (int j = 0; j < 8; ++j) { s0 += __builtin_amdgcn_fmed3f(accv[j], 0.f, cinf[j]); s1 += __builtin_amdgcn_fmed3f(accv[8 + j], 0.f, cinf[8 + j]); } \
        const int kidx = kbase + (sub) * 32 + m; const unsigned p0 = mono_pack(s0, kidx), p1 = mono_pack(s1, kidx); \
        { const bool ps = p0 > thr0; const unsigned long long bal = __ballot(ps); const unsigned lo = (unsigned)bal, hh = (unsigned)(bal >> 32); \
          const int pre = (int)__builtin_amdgcn_mbcnt_hi(hh, __builtin_amdgcn_mbcnt_lo(lo, 0u)) - (int)((unsigned)__popc(lo) & himask); \
          LAS unsigned* dst = ps ? (cb0 + cnt0 + pre) : dum; *dst = p0; cnt0 += hi ? __popc(hh) : __popc(lo); } \
        { const bool ps = p1 > thr1; const unsigned long long bal = __ballot(ps); const unsigned lo = (unsigned)bal, hh = (unsigned)(bal >> 32); \
          const int pre = (int)__builtin_amdgcn_mbcnt_hi(hh, __builtin_amdgcn_mbcnt_lo(lo, 0u)) - (int)((unsigned)__popc(lo) & himask); \
          LAS unsigned* dst = ps ? (cb1 + cnt1 + pre) : dum; *dst = p1; cnt1 += hi ? __popc(hh) : __popc(lo); } } while (0)
    for (int st = 0; st < nst; ++st) {
        const int kbase = st * IDX_STG; const bool full = (nkeys - kbase) >= IDX_STG;
        if (st + 1 < nst) { kreg0 = *(const GAS v4u*)(ksrc + (size_t)(kbase + IDX_STG) * 64); if (nkeys - kbase - IDX_STG > 64) kreg1 = *(const GAS v4u*)(ksrc + (size_t)(kbase + IDX_STG + 64) * 64); }
        const LAS unsigned char* kcur = kt + (st & 1) * IDX_KT_BYTES + m * IDX_KT_STRIDE + 16 * hi;
        f32x16 accA, accB;
        IDX_MMA(accA, 0);
        IDX_MMA(accB, 1); __builtin_amdgcn_sched_barrier(0);
        IDX_VALU(accA, 0); __builtin_amdgcn_sched_barrier(0);
        if (full) {
            IDX_MMA(accA, 2); __builtin_amdgcn_sched_barrier(0);
            IDX_VALU(accB, 1); __builtin_amdgcn_sched_barrier(0);
            IDX_MMA(accB, 3); __builtin_amdgcn_sched_barrier(0);
            IDX_VALU(accA, 2); __builtin_amdgcn_sched_barrier(0);
            IDX_VALU(accB, 3);
        } else { IDX_VALU(accB, 1); }
        { const int c00 = __builtin_amdgcn_readlane(cnt0, 0), c01 = __builtin_amdgcn_readlane(cnt1, 0), c10 = __builtin_amdgcn_readlane(cnt0, 32), c11 = __builtin_amdgcn_readlane(cnt1, 32);
          constexpr int LIM = IDX_CAP - IDX_STG;
          if ((c00 > LIM || c01 > LIM || c10 > LIM || c11 > LIM) && lane == 0) pflag[st % 3] = 1u; }
        if (tid == 0) pflag[(st + 1) % 3] = 0u;
        if (st + 1 < nst) { LAS unsigned char* kn = kt + ((st + 1) & 1) * IDX_KT_BYTES + kdst; *(LAS v4u*)kn = kreg0; *(LAS v4u*)(kn + 64 * IDX_KT_STRIDE) = kreg1; }
        __syncthreads();
        if (pflag[st % 3] != 0u && st + 1 < nst) {
            int keep = 256;
            if (aggr) { const float pf = (float)(kbase + IDX_STG) / (float)nkeys, mu = 256.f * pf; const int r = (int)(mu + 6.5f * sqrtf(mu * (1.f - pf))) + 2; keep = r < 256 ? r : 256; }
            const int c00 = __builtin_amdgcn_readlane(cnt0, 0), c01 = __builtin_amdgcn_readlane(cnt1, 0), c10 = __builtin_amdgcn_readlane(cnt0, 32), c11 = __builtin_amdgcn_readlane(cnt1, 32);
            if (c00 > keep) { const unsigned T = idx_prune(cb, c00, keep, hist, lane); if (!hi) { thr0 = T - 1u; cnt0 = keep; } }
            if (c01 > keep) { const unsigned T = idx_prune(cb + IDX_CAP, c01, keep, hist, lane); if (!hi) { thr1 = T - 1u; cnt1 = keep; } }
            if (c10 > keep) { const unsigned T = idx_prune(cb + 2 * IDX_CAP, c10, keep, hist, lane); if (hi) { thr0 = T - 1u; cnt0 = keep; } }
            if (c11 > keep) { const unsigned T = idx_prune(cb + 3 * IDX_CAP, c11, keep, hist, lane); if (hi) { thr1 = T - 1u; cnt1 = keep; } }
        }
    }
#undef IDX_MMA
#undef IDX_VALU
    LDS_WAIT();
    if (DRY) { __syncthreads(); return false; }
#pragma unroll
    for (int q = 0; q < 4; ++q) {
        int cq = __builtin_amdgcn_readlane((q & 1) ? cnt1 : cnt0, (q >> 1) * 32);
        LAS unsigned* buf = cb + q * IDX_CAP;
        if (cq > 256) { (void)idx_prune(buf, cq, 256, hist, lane); cq = 256; }
        else if (cq < 256 && nkeys > 256 && lane == 0) pflag[3] = 1u;
        LAS unsigned* mrow = buf + 256;
#pragma unroll
        for (int j = 0; j < 4; ++j) mrow[j * 64 + lane] = 0u;
        LDS_WAIT();
#pragma unroll
        for (int j = 0; j < 4; ++j) { const int idx = j * 64 + lane; if (idx < cq) { const unsigned v = buf[idx]; const unsigned key = 8191u - (v & 8191u);
            __hip_atomic_fetch_or(mrow + (key >> 5), 1u << (key & 31u), __ATOMIC_RELAXED, __HIP_MEMORY_SCOPE_WORKGROUP); } }
        LDS_WAIT();
        const v4u o = *(const LAS v4u*)(mrow + 4 * lane);
        *(GAS v4u*)(MASK + ((size_t)b * SEQ + t0 + q) * 256 + 4 * lane) = o;
    }
    __syncthreads();
    const bool failed = pflag[3] != 0u;
    __syncthreads();
    return failed;
}

constexpr int HL_STRIDE = 144;
__device__ __forceinline__ void hgrn_local_item(const Args& a, LAS unsigned char* lds, int item, int tid, int lane, int wave) {
    const int bh = item >> 7, c = item & 127, b = bh >> 2, h = bh & 3;
    const float* LF = (const float*)(a.ws + WS_LF); const bf16* VR = (const bf16*)(a.ws + WS_VR);
    unsigned* LS = (unsigned*)(a.ws + WS_LS); float* DEC = (float*)(a.ws + WS_DEC);
    LAS unsigned char* kct = lds; LAS unsigned char* vt = lds + 128 * HL_STRIDE; LAS float* seg = (LAS float*)(lds + 2 * 128 * HL_STRIDE);
    const int k = tid & 127, sg = tid >> 7;
    const size_t row0 = (size_t)b * SEQ + c * 64 + sg * 16;
    float lf[16], vv[16];
#pragma unroll
    for (int j = 0; j < 16; ++j) { lf[j] = LF[(row0 + j) * 512 + h * 128 + k]; vv[j] = bf2f(VR[(row0 + j) * 512 + h * 128 + k]); }
    float run = 0.f, bl[16];
#pragma unroll
    for (int j = 0; j < 16; ++j) { run += lf[j]; bl[j] = run; }
    seg[sg * 128 + k] = run;
    __syncthreads();
    float off = 0.f, tot = 0.f;
#pragma unroll
    for (int s = 0; s < 4; ++s) { const float x = seg[s * 128 + k]; tot += x; if (s < sg) off += x; }
    { unsigned pk[8], pv[8];
#pragma unroll
      for (int j = 0; j < 8; ++j) { const float k0 = (1.f - fexp(lf[2 * j])) * fexp(tot - off - bl[2 * j]), k1 = (1.f - fexp(lf[2 * j + 1])) * fexp(tot - off - bl[2 * j + 1]);
          pk[j] = cvtpk(k0, k1); pv[j] = cvtpk(vv[2 * j], vv[2 * j + 1]); }
      *(LAS v4u*)(kct + k * HL_STRIDE + sg * 32) = (v4u){pk[0], pk[1], pk[2], pk[3]}; *(LAS v4u*)(kct + k * HL_STRIDE + sg * 32 + 16) = (v4u){pk[4], pk[5], pk[6], pk[7]};
      *(LAS v4u*)(vt + k * HL_STRIDE + sg * 32) = (v4u){pv[0], pv[1], pv[2], pv[3]}; *(LAS v4u*)(vt + k * HL_STRIDE + sg * 32 + 16) = (v4u){pv[4], pv[5], pv[6], pv[7]}; }
    if (sg == 0) DEC[(size_t)item * 128 + k] = fexp(tot);
    __syncthreads();
    { const int hi = lane >> 5, m = lane & 31, mt = wave >> 1, np = wave & 1;
      f32x16 acc0 = {0.f, 0.f, 0.f, 0.f, 0.f, 0.f, 0.f, 0.f, 0.f, 0.f, 0.f, 0.f, 0.f, 0.f, 0.f, 0.f}, acc1 = acc0;
#pragma unroll
      for (int ks = 0; ks < 4; ++ks) { const bf16x8 av = *(const LAS bf16x8*)(vt + (32 * mt + m) * HL_STRIDE + (16 * ks + 8 * hi) * 2);
          const bf16x8 b0 = *(const LAS bf16x8*)(kct + (64 * np + 2 * m) * HL_STRIDE + (16 * ks + 8 * hi) * 2), b1 = *(const LAS bf16x8*)(kct + (64 * np + 2 * m + 1) * HL_STRIDE + (16 * ks + 8 * hi) * 2);
          acc0 = MFMA32(av, b0, acc0); acc1 = MFMA32(av, b1, acc1); }
#pragma unroll
      for (int i = 0; i < 16; ++i) { const int v = 32 * mt + crow(i, hi); LS[((size_t)item * 128 + v) * 64 + 32 * np + m] = cvtpk(acc0[i], acc1[i]); } }
    __syncthreads();
}

__device__ __forceinline__ void phase4(const Args& a, int tid, int G) {
    unsigned* LS = (unsigned*)(a.ws + WS_LS); const float* DEC = (const float*)(a.ws + WS_DEC);
    for (int gid = blockIdx.x * 512 + tid; gid < 65536; gid += G * 512) {
        const int bh = gid >> 13, v = (gid >> 6) & 127, kp = gid & 63;
        float s0 = 0.f, s1 = 0.f;
        unsigned* p = LS + ((size_t)bh * 128 * 128 + v) * 64 + kp; const float* dp = DEC + (size_t)bh * 128 * 128 + 2 * kp;
        for (int c0 = 0; c0 < 128; c0 += 16) {
            unsigned w[16]; f32x2 d[16];
#pragma unroll
            for (int i = 0; i < 16; ++i) { w[i] = __builtin_nontemporal_load(p + (size_t)(c0 + i) * 128 * 64); d[i] = *(const f32x2*)(dp + (size_t)(c0 + i) * 128); }
#pragma unroll
            for (int i = 0; i < 16; ++i) { s0 = d[i].x * s0 + bflo(w[i]); s1 = d[i].y * s1 + bfhi(w[i]); w[i] = cvtpk(s0, s1); }
#pragma unroll
            for (int i = 0; i < 16; ++i) p[(size_t)(c0 + i) * 128 * 64] = w[i];
        }
    }
}

constexpr int AT_KSTRIDE = 144, AT_STG = 128, AT_KBYTES = AT_STG * AT_KSTRIDE, AT_VBYTES = 2 * 8192, AT_SBYTES = AT_KBYTES + AT_VBYTES;
constexpr int AT_STG_OFF = 0, AT_TAB_OFF = 2 * AT_SBYTES, AT_L_OFF = AT_TAB_OFF + 1024, AT_OST_OFF = AT_L_OFF + NWAVES * 128, AT_OST_STRIDE = 68;
static_assert(AT_OST_OFF + NWAVES * 32 * AT_OST_STRIDE * 4 <= MISC_OFF, "attention LDS");

__device__ __forceinline__ int t5_bucket_neg(int n) {
    return n < 8 ? n : n < 12 ? 8 : n < 16 ? 9 : n < 23 ? 10 : n < 32 ? 11 : n < 46 ? 12 : n < 64 ? 13 : n < 91 ? 14 : 15;
}
__device__ __forceinline__ s16x4 vtr(const LAS unsigned char* p) { return __builtin_bit_cast(s16x4, __builtin_amdgcn_ds_read_tr16_b64_v4i16((LAS v4i16_t*)p)); }

__device__ __forceinline__ float msel(int w, int pos, unsigned xd) { int t; asm("v_bfe_i32 %0, %1, %2, 1" : "=v"(t) : "v"(w), "n"(pos));
    return __uint_as_float(0xff800000u ^ ((unsigned)t & xd)); }
template <int DRYM>
__device__ __forceinline__ void attn_item(const Args& a, LAS unsigned char* lds, int b, int h, int qb, int tid, int lane, int wave) {
    const bf16* AQ = (const bf16*)(a.ws + WS_AQ); const bf16* AK = (const bf16*)(a.ws + WS_AK); const bf16* AV = (const bf16*)(a.ws + WS_AV);
    const unsigned* MASK = (const unsigned*)(a.ws + WS_MASK); bf16* MIX = (bf16*)(a.ws + WS_H);
    const int hi = lane >> 5, r32 = lane & 31, q0 = qb * 256, qw = q0 + wave * 32, nst = (q0 + 256) >> 7, kend = (((qw + 31) >> 6) + 1) * 64;
    LAS float* tab = (LAS float*)(lds + AT_TAB_OFF);
    if (tid < 192) {
        const float* qg = a.in[IN_QG]; const float* kg = a.in[IN_KG]; const float* rb = a.in[IN_RELB];
        float mq = 0.f, mk = 0.f, mb = -3.0e38f;
        for (int i = 0; i < 64; ++i) { mq = fmaxf(mq, fabsf(qg[i])); mk = fmaxf(mk, fabsf(kg[i])); }
        for (int i = 0; i < 32; ++i) mb = fmaxf(mb, rb[i * 8 + h]);
        const float bound = 8.f * mq * mk + mb; const int rel = tid - 128, n = rel < 0 ? -rel : rel;
        const int bk = (rel > 0 ? 16 : 0) + t5_bucket_neg(n);
        tab[tid] = (rb[bk * 8 + h] - bound) * LOG2E;
    }
    bf16x8 qr[4];
    { const bf16* qp = AQ + ((size_t)b * SEQ + qw + r32) * 512 + h * 64 + 8 * hi;
#pragma unroll
      for (int d0 = 0; d0 < 4; ++d0) qr[d0] = *(const GAS bf16x8*)(qp + 16 * d0); }
    const int skey = tid >> 3, sch = tid & 7;
    const size_t srow = ((size_t)b * SEQ + skey) * 512 + h * 64 + sch * 8;
    const int kdst = skey * AT_KSTRIDE + sch * 16, vdst = AT_KBYTES + ((sch >> 2) * 4 + (skey >> 4)) * 1024 + (skey & 15) * 64 + (sch & 3) * 16;
    LAS unsigned char* sbuf = lds + AT_STG_OFF;
    v4u kr0 = *(const GAS v4u*)(AK + srow), kr1 = *(const GAS v4u*)(AK + srow + 64 * 512), vr0 = *(const GAS v4u*)(AV + srow), vr1 = *(const GAS v4u*)(AV + srow + 64 * 512);
    *(LAS v4u*)(sbuf + kdst) = kr0; *(LAS v4u*)(sbuf + kdst + 64 * AT_KSTRIDE) = kr1; *(LAS v4u*)(sbuf + vdst) = vr0; *(LAS v4u*)(sbuf + vdst + 8192) = vr1;
    const unsigned* mrow = MASK + ((size_t)b * SEQ + qw + r32) * 256;
    v4u mw = *(const GAS v4u*)(mrow);
    f32x16 o0 = {0.f, 0.f, 0.f, 0.f, 0.f, 0.f, 0.f, 0.f, 0.f, 0.f, 0.f, 0.f, 0.f, 0.f, 0.f, 0.f}, o1 = o0;
    float lsum = 0.f;
    __syncthreads();
    const float cfar = tab[0]; const unsigned cfard = __float_as_uint(cfar) ^ 0xff800000u;
    const int vb = ((lane >> 4) & 1) * 32 + (lane & 3) * 8 + (4 * hi + ((lane & 15) >> 2)) * 64;
#define AT_QK(sv, sub, wordv, FARST) do { if (DRYM == 4) { _Pragma("unroll") for (int r = 0; r < 16; ++r) sv[r] = cfar; break; } const int ks_ = kb0 + 32 * (sub); const int wsh_ = (int)((wordv) >> (4 * hi)); \
        if ((FARST) || ks_ + 31 - qw <= -91) { _Pragma("unroll") for (int r = 0; r < 16; ++r) sv[r] = msel(wsh_, (r & 3) + 8 * (r >> 2), cfard); } \
        else { const int base_ = ks_ + 4 * hi - qw - r32 + 128; _Pragma("unroll") for (int r = 0; r < 16; ++r) { int ix = base_ + (r & 3) + 8 * (r >> 2); ix = ix < 0 ? 0 : ix; sv[r] = msel(wsh_, (r & 3) + 8 * (r >> 2), __float_as_uint(tab[ix]) ^ 0xff800000u); } } \
        _Pragma("unroll") for (int d0 = 0; d0 < 4; ++d0) { const bf16x8 kf = *(const LAS bf16x8*)(kcur + ((sub) * 32 + r32) * AT_KSTRIDE + (16 * d0 + 8 * hi) * 2); sv = MFMA32(kf, qr[d0], sv); } } while (0)
#define AT_SOFT(sv, wordv, pa0, pa1) do { if (DRYM == 2) { pa0 = (v4u){__float_as_uint(sv[0]), __float_as_uint(sv[1]), __float_as_uint(sv[2]), __float_as_uint(sv[3])}; pa1 = (v4u){__float_as_uint(sv[4]) ^ (wordv), __float_as_uint(sv[5]), __float_as_uint(sv[6]), __float_as_uint(sv[7])}; break; } float p_[16]; \
        _Pragma("unroll") for (int r = 0; r < 16; ++r) { p_[r] = fexp2(sv[r]); lsum += p_[r]; } \
        pa0 = (v4u){cvtpk_s(p_[0], p_[1]), cvtpk_s(p_[2], p_[3]), cvtpk_s(p_[4], p_[5]), cvtpk_s(p_[6], p_[7])}; pa1 = (v4u){cvtpk_s(p_[8], p_[9]), cvtpk_s(p_[10], p_[11]), cvtpk_s(p_[12], p_[13]), cvtpk_s(p_[14], p_[15])}; } while (0)
#define AT_PV(pa0, pa1, sub) do { if (DRYM == 3) { o0[0] += __uint_as_float(pa0.x ^ pa1.y); break; } const LAS unsigned char* vs_ = vcur + ((sub) >> 1) * 8192; \
        _Pragma("unroll") for (int kk = 0; kk < 2; ++kk) { const int kg = 2 * ((sub) & 1) + kk; const bf16x8 pa = __builtin_bit_cast(bf16x8, kk ? pa1 : pa0); \
            _Pragma("unroll") for (int dh = 0; dh < 2; ++dh) { const s16x4 lo_ = vtr(vs_ + dh * 4096 + kg * 1024), hh_ = vtr(vs_ + dh * 4096 + kg * 1024 + 512); \
                const bf16x8 vf = {lo_[0], lo_[1], lo_[2], lo_[3], hh_[0], hh_[1], hh_[2], hh_[3]}; if (dh == 0) o0 = MFMA32(pa, vf, o0); else o1 = MFMA32(pa, vf, o1); } } } while (0)
#define AT_SB() __builtin_amdgcn_sched_barrier(0)
    for (int st = 0; st < nst; ++st) {
        const int kb0 = st * AT_STG; v4u mwn = mw;
        if (st + 1 < nst) { const size_t nx = srow + (size_t)(kb0 + AT_STG) * 512; kr0 = *(const GAS v4u*)(AK + nx); kr1 = *(const GAS v4u*)(AK + nx + 64 * 512); vr0 = *(const GAS v4u*)(AV + nx); vr1 = *(const GAS v4u*)(AV + nx + 64 * 512);
            mwn = *(const GAS v4u*)(mrow + 4 * (st + 1)); }
        const LAS unsigned char* kcur = sbuf + (st & 1) * AT_SBYTES; const LAS unsigned char* vcur = kcur + AT_KBYTES + vb;
        const int nsub = kend - kb0 >= AT_STG ? 4 : kend - kb0 > 0 ? (kend - kb0) >> 5 : 0;
        f32x16 sA, sB; v4u a0, a1, b0, b1;
        if (nsub == 4 && kb0 + 127 - qw <= -91) {
            AT_QK(sA, 0, mw.x, true); AT_QK(sB, 1, mw.y, true); AT_SB();
            AT_SOFT(sA, mw.x, a0, a1); AT_SB();
            AT_QK(sA, 2, mw.z, true); AT_PV(a0, a1, 0); AT_SB();
            AT_SOFT(sB, mw.y, b0, b1); AT_SB();
            AT_QK(sB, 3, mw.w, true); AT_PV(b0, b1, 1); AT_SB();
            AT_SOFT(sA, mw.z, a0, a1); AT_SB();
            AT_PV(a0, a1, 2); AT_SB();
            AT_SOFT(sB, mw.w, b0, b1); AT_SB();
            AT_PV(b0, b1, 3);
        } else if (nsub > 0) {
            AT_QK(sA, 0, mw.x, false); AT_QK(sB, 1, mw.y, false); AT_SB();
            AT_SOFT(sA, mw.x, a0, a1); AT_SB();
            if (nsub == 4) {
                AT_QK(sA, 2, mw.z, false); AT_PV(a0, a1, 0); AT_SB();
                AT_SOFT(sB, mw.y, b0, b1); AT_SB();
                AT_QK(sB, 3, mw.w, false); AT_PV(b0, b1, 1); AT_SB();
                AT_SOFT(sA, mw.z, a0, a1); AT_SB();
                AT_PV(a0, a1, 2); AT_SB();
                AT_SOFT(sB, mw.w, b0, b1); AT_SB();
                AT_PV(b0, b1, 3);
            } else {
                AT_PV(a0, a1, 0); AT_SB();
                AT_SOFT(sB, mw.y, b0, b1); AT_SB();
                AT_PV(b0, b1, 1);
            }
        }
        if (st + 1 < nst) { LAS unsigned char* sn = sbuf + ((st + 1) & 1) * AT_SBYTES; *(LAS v4u*)(sn + kdst) = kr0; *(LAS v4u*)(sn + kdst + 64 * AT_KSTRIDE) = kr1; *(LAS v4u*)(sn + vdst) = vr0; *(LAS v4u*)(sn + vdst + 8192) = vr1; }
        mw = mwn;
        __syncthreads();
    }
#undef AT_QK
#undef AT_SOFT
#undef AT_PV
#undef AT_SB
    if (DRYM != 0) { if (o0[0] + o1[3] + lsum == 1.2345e-30f) ((float*)(a.ws + WS_DEC))[tid] = 1.f; __syncthreads(); return; }
    lsum += __shfl_xor(lsum, 32);
    LAS float* lw = (LAS float*)(lds + AT_L_OFF) + wave * 32; LAS float* ost = (LAS float*)(lds + AT_OST_OFF) + wave * 32 * AT_OST_STRIDE;
    if (hi == 0) lw[r32] = lsum;
    LDS_WAIT();
#pragma unroll
    for (int r = 0; r < 16; ++r) { const int q = crow(r, hi); const float rl = frcp(lw[q]); ost[q * AT_OST_STRIDE + r32] = o0[r] * rl; ost[q * AT_OST_STRIDE + 32 + r32] = o1[r] * rl; }
    LDS_WAIT();
    { const int q = lane >> 1, hf = lane & 1; const LAS float* src = ost + q * AT_OST_STRIDE + hf * 32; const float* g = a.in[IN_ATTG] + h * 64 + hf * 32;
      float v[32], ss = 0.f;
#pragma unroll
      for (int i = 0; i < 8; ++i) { const f32x4 t = *(const LAS f32x4*)(src + 4 * i); v[4 * i] = t.x; v[4 * i + 1] = t.y; v[4 * i + 2] = t.z; v[4 * i + 3] = t.w; ss += (t.x * t.x + t.y * t.y) + (t.z * t.z + t.w * t.w); }
      ss += __shfl_xor(ss, 1);
      const float ri = frsq(ss * (1.f / 64.f) + EPS);
      bf16* dst = MIX + ((size_t)b * SEQ + qw + q) * 1024 + 512 + h * 64 + hf * 32;
#pragma unroll
      for (int i = 0; i < 4; ++i) { v4u w;
          w.x = cvtpk(v[8 * i] * ri * g[8 * i], v[8 * i + 1] * ri * g[8 * i + 1]); w.y = cvtpk(v[8 * i + 2] * ri * g[8 * i + 2], v[8 * i + 3] * ri * g[8 * i + 3]);
          w.z = cvtpk(v[8 * i + 4] * ri * g[8 * i + 4], v[8 * i + 5] * ri * g[8 * i + 5]); w.w = cvtpk(v[8 * i + 6] * ri * g[8 * i + 6], v[8 * i + 7] * ri * g[8 * i + 7]);
          *(GAS v4u*)(dst + 8 * i) = w; } }
    __syncthreads();
}

constexpr int HO_QSTRIDE = 272, HO_QBYTES = 64 * HO_QSTRIDE;
constexpr int HO_QD = 0, HO_KD = HO_QBYTES, HO_QE = 2 * HO_QBYTES, HO_VT = 3 * HO_QBYTES, HO_SEG = HO_VT + 128 * HL_STRIDE, HO_RB = HO_SEG + 2048, HO_OST = HO_RB + 512, HO_OSTRIDE = 132;
static_assert(HO_OST + 64 * HO_OSTRIDE * 4 <= RING_BYTES, "hgrn-out LDS");
__device__ __forceinline__ void hgrn_out_item(const Args& a, LAS unsigned char* lds, int item, int tid, int lane, int wave) {
    const int bh = item >> 7, c = item & 127, b = bh >> 2, h = bh & 3;
    const float* LF = (const float*)(a.ws + WS_LF); const bf16* VR = (const bf16*)(a.ws + WS_VR); const bf16* QR = (const bf16*)(a.ws + WS_QR); const bf16* GR = (const bf16*)(a.ws + WS_GR);
    const bf16* LSb = (const bf16*)(a.ws + WS_LS); bf16* MIX = (bf16*)(a.ws + WS_H);
    LAS unsigned short* qd = (LAS unsigned short*)(lds + HO_QD); LAS unsigned short* kd = (LAS unsigned short*)(lds + HO_KD); LAS unsigned short* qe = (LAS unsigned short*)(lds + HO_QE);
    LAS unsigned char* vt = lds + HO_VT; LAS float* seg = (LAS float*)(lds + HO_SEG); LAS float* rbuf = (LAS float*)(lds + HO_RB); LAS float* ost = (LAS float*)(lds + HO_OST);
    const int k = tid & 127, sg = tid >> 7;
    const size_t row0 = (size_t)b * SEQ + c * 64 + sg * 16;
    float lf[16], qq[16], vv[16];
#pragma unroll
    for (int j = 0; j < 16; ++j) { const size_t ix = (row0 + j) * 512 + h * 128 + k; lf[j] = LF[ix]; qq[j] = bf2f(QR[ix]); vv[j] = bf2f(VR[ix]); }
    float run = 0.f, bl[16];
#pragma unroll
    for (int j = 0; j < 16; ++j) { run += lf[j]; bl[j] = run; }
    seg[sg * 128 + k] = run;
    __syncthreads();
    float off = 0.f;
#pragma unroll
    for (int s = 0; s < 4; ++s) { const float x = seg[s * 128 + k]; if (s < sg) off += x; }
    if (sg == 1) rbuf[k] = off + bl[15];
    __syncthreads();
    const float rr = rbuf[k];
    { unsigned pv[8];
#pragma unroll
      for (int j = 0; j < 16; ++j) { const float bt = off + bl[j], e1 = fexp(bt - rr), e2 = fexp(rr - bt), kk = 1.f - fexp(lf[j]); const int t = sg * 16 + j;
          qd[t * (HO_QSTRIDE / 2) + k] = (unsigned short)(cvtpk(qq[j] * e1, 0.f) & 0xffffu); kd[t * (HO_QSTRIDE / 2) + k] = (unsigned short)(cvtpk(kk * e2, 0.f) & 0xffffu);
          qe[t * (HO_QSTRIDE / 2) + k] = (unsigned short)(cvtpk(qq[j] * fexp(bt), 0.f) & 0xffffu); }
#pragma unroll
      for (int j = 0; j < 8; ++j) pv[j] = cvtpk(vv[2 * j], vv[2 * j + 1]);
      *(LAS v4u*)(vt + k * HL_STRIDE + sg * 32) = (v4u){pv[0], pv[1], pv[2], pv[3]}; *(LAS v4u*)(vt + k * HL_STRIDE + sg * 32 + 16) = (v4u){pv[4], pv[5], pv[6], pv[7]}; }
    __syncthreads();
    { const int hi = lane >> 5, m = lane & 31, tt = wave >> 2, vti = wave & 3;
      f32x16 acc = {0.f, 0.f, 0.f, 0.f, 0.f, 0.f, 0.f, 0.f, 0.f, 0.f, 0.f, 0.f, 0.f, 0.f, 0.f, 0.f};
      const LAS unsigned char* qeb = lds + HO_QE + (32 * tt + m) * HO_QSTRIDE + 16 * hi;
      if (c > 0) {
          const bf16* sp = LSb + ((size_t)(item - 1) * 128 + 32 * vti + m) * 128 + 8 * hi;
#pragma unroll
          for (int ks = 0; ks < 8; ++ks) { const bf16x8 af = *(const LAS bf16x8*)(qeb + 32 * ks); const bf16x8 bfr = *(const GAS bf16x8*)(sp + 16 * ks); acc = MFMA32(af, bfr, acc); }
      }
      const LAS unsigned char* qdb = lds + HO_QD + (32 * tt + m) * HO_QSTRIDE + 16 * hi;
#pragma unroll
      for (int st = 0; st < 2; ++st) if (st <= tt) {
          f32x16 pt = {0.f, 0.f, 0.f, 0.f, 0.f, 0.f, 0.f, 0.f, 0.f, 0.f, 0.f, 0.f, 0.f, 0.f, 0.f, 0.f};
          const LAS unsigned char* kdb = lds + HO_KD + (32 * st + m) * HO_QSTRIDE + 16 * hi;
#pragma unroll
          for (int ks = 0; ks < 8; ++ks) { const bf16x8 af = *(const LAS bf16x8*)(kdb + 32 * ks); const bf16x8 bfr = *(const LAS bf16x8*)(qdb + 32 * ks); pt = MFMA32(af, bfr, pt); }
          float p[16];
#pragma unroll
          for (int r = 0; r < 16; ++r) { const int s = 32 * st + crow(r, hi), t = 32 * tt + m; p[r] = (s <= t) ? pt[r] : 0.f; }
          const v4u pa0 = {cvtpk_s(p[0], p[1]), cvtpk_s(p[2], p[3]), cvtpk_s(p[4], p[5]), cvtpk_s(p[6], p[7])}, pa1 = {cvtpk_s(p[8], p[9]), cvtpk_s(p[10], p[11]), cvtpk_s(p[12], p[13]), cvtpk_s(p[14], p[15])};
#pragma unroll
          for (int kk = 0; kk < 2; ++kk) { const LAS unsigned char* vp = vt + (32 * vti + m) * HL_STRIDE + (32 * st + 16 * kk + 4 * hi) * 2;
              const v2u lo = *(const LAS v2u*)(vp), hh = *(const LAS v2u*)(vp + 16);
              const v4u vw = {lo.x, lo.y, hh.x, hh.y};
              acc = MFMA32(__builtin_bit_cast(bf16x8, kk ? pa1 : pa0), __builtin_bit_cast(bf16x8, vw), acc); }
      }
#pragma unroll
      for (int r = 0; r < 16; ++r) ost[(32 * tt + crow(r, hi)) * HO_OSTRIDE + 32 * vti + m] = acc[r];
    }
    __syncthreads();
    { const int t = tid >> 3, s8 = tid & 7; const LAS float* src = ost + t * HO_OSTRIDE + s8 * 16; float v[16], ss = 0.f;
#pragma unroll
      for (int i = 0; i < 4; ++i) { const f32x4 x = *(const LAS f32x4*)(src + 4 * i); v[4 * i] = x.x; v[4 * i + 1] = x.y; v[4 * i + 2] = x.z; v[4 * i + 3] = x.w; ss += (x.x * x.x + x.y * x.y) + (x.z * x.z + x.w * x.w); }
      ss += __shfl_xor(ss, 1); ss += __shfl_xor(ss, 2); ss += __shfl_xor(ss, 4);
      const float ri = frsq(ss * (1.f / 128.f) + EPS);
      const size_t tok = (size_t)b * SEQ + c * 64 + t; const float* g = a.in[IN_RECG] + h * 128 + s8 * 16;
      const v4u g0 = *(const GAS v4u*)(GR + tok * 512 + h * 128 + s8 * 16), g1 = *(const GAS v4u*)(GR + tok * 512 + h * 128 + s8 * 16 + 8);
      const unsigned gw[8] = {g0.x, g0.y, g0.z, g0.w, g1.x, g1.y, g1.z, g1.w}; unsigned ow[8];
#pragma unroll
      for (int i = 0; i < 8; ++i) ow[i] = cvtpk(v[2 * i] * ri * g[2 * i] * bflo(gw[i]), v[2 * i + 1] * ri * g[2 * i + 1] * bfhi(gw[i]));
      bf16* dst = MIX + tok * 1024 + h * 128 + s8 * 16;
      *(GAS v4u*)dst = (v4u){ow[0], ow[1], ow[2], ow[3]}; *(GAS v4u*)(dst + 8) = (v4u){ow[4], ow[5], ow[6], ow[7]}; }
    __syncthreads();
}

struct EpiOutProj {
    static constexpr bool PERM = false, AFTER_DRAIN = false;
    const float* x; float* out; const float* modf;
    __device__ __forceinline__ void operator()(const pg8::f32x4 (&acc)[2][2][4][2], const pg8::Unit& u, int wr, int wc, int fr, int fq) const {
        const int row0 = u.pm * 256 + wr * 64 + fr, col0 = u.pn * 256 + wc * 32 + 4 * fq, b = u.pm >> 5;
        f32x4 gv[2][2];
#pragma unroll
        for (int bj = 0; bj < 2; ++bj)
#pragma unroll
            for (int n = 0; n < 2; ++n) gv[bj][n] = *(const f32x4*)(modf + b * 6144 + 2048 + col0 + bj * 128 + n * 16);
#pragma unroll
        for (int ai = 0; ai < 2; ++ai)
#pragma unroll
            for (int m = 0; m < 4; ++m) { const size_t off = (size_t)(row0 + ai * 128 + m * 16) * DM + col0;
#pragma unroll
                for (int bj = 0; bj < 2; ++bj)
#pragma unroll
                    for (int n = 0; n < 2; ++n) { const f32x4 xv = *(const GAS f32x4*)(x + off + bj * 128 + n * 16); *(GAS f32x4*)(out + off + bj * 128 + n * 16) = xv + gv[bj][n] * acc[ai][bj][m][n]; } }
    }
};

constexpr int RT_RW = 0, RT_A2 = 81920, RT_S2 = RT_A2 + 8192;
constexpr int CW_NBLK = 8192 + 128, CW_BLKMAP = 8192 + 256;
__device__ __forceinline__ float dpp_sum(float v) {
#define DPPF(x, ctrl, rm) __int_as_float(__builtin_amdgcn_update_dpp(0, __float_as_int(x), (ctrl), (rm), 0xf, false))
    v += DPPF(v, 0x111, 0xf); v += DPPF(v, 0x112, 0xf); v += DPPF(v, 0x114, 0xf); v += DPPF(v, 0x118, 0xf); v += DPPF(v, 0x142, 0xa); v += DPPF(v, 0x143, 0xc);
#undef DPPF
    return __int_as_float(__builtin_amdgcn_readlane(__float_as_int(v), 63));
}
__device__ __forceinline__ void load_mod2(const Args& a, LAS unsigned char* lds, int tid) {
    LAS float* A2 = (LAS float*)(lds + RT_A2); LAS float* S2 = (LAS float*)(lds + RT_S2);
    const float* modf = (const float*)(a.ws + WS_MODF); const float* g = a.in[IN_N2G];
    float gv[4], sc[4], sh[4];
#pragma unroll
    for (int q = 0; q < 4; ++q) { const int idx = tid + 512 * q, b = idx >> 10, i = idx & 1023; gv[q] = g[i]; sc[q] = modf[b * 6144 + 4096 + i]; sh[q] = modf[b * 6144 + 3072 + i]; }
#pragma unroll
    for (int q = 0; q < 4; ++q) { const int idx = tid + 512 * q; A2[idx] = gv[q] * (1.f + sc[q]); S2[idx] = sh[q]; }
}
__device__ __forceinline__ void phase7(const Args& a, LAS unsigned char* lds, int tid, int lane, int wave, int G) {
    LAS float* RW = (LAS float*)(lds + RT_RW); LAS float* A2 = (LAS float*)(lds + RT_A2); LAS float* S2 = (LAS float*)(lds + RT_S2);
    const float* wrg = a.in[IN_WRG]; const float* wre = a.in[IN_WRE];
    { f32x4 t[10];
#pragma unroll
      for (int q = 0; q < 10; ++q) { const int f = tid + 512 * q, i = f / 5, c = f % 5; t[q] = c == 0 ? *(const GAS f32x4*)(wrg + i * 4) : *(const GAS f32x4*)(wre + i * 16 + (c - 1) * 4); }
#pragma unroll
      for (int q = 0; q < 10; ++q) { const int f = tid + 512 * q; *(LAS f32x4*)(RW + f * 4) = t[q]; } }
    load_mod2(a, lds, tid);
    __syncthreads();
    const int gw = blockIdx.x * NWAVES + wave, NGW = G * NWAVES;
    const float* x1 = a.out; bf16* H2S = (bf16*)(a.ws + WS_H2S); int* stok = (int*)(a.ws + WS_STOK); f32x2* wsort = (f32x2*)(a.ws + WS_WSORT);
    unsigned* ctl = (unsigned*)(a.ws + WS_CTL); unsigned* gcnt = ctl + CW_CNT; unsigned* gnblk = ctl + CW_NBLK; unsigned* blkmap = ctl + CW_BLKMAP;
    float bias[20];
#pragma unroll
    for (int n = 0; n < 20; ++n) bias[n] = n < 4 ? a.in[IN_BRG][n] : a.in[IN_BRE][n - 4];
    constexpr int RPT = 4;
    for (int m0 = gw * RPT; m0 < MTOK; m0 += NGW * RPT) {
        unsigned hp[RPT][8];
        int mycombo = 0; float mywlo = 0.f, mywhi = 0.f;
        f32x2 xn[8];
#pragma unroll
        for (int q = 0; q < 8; ++q) xn[q] = *(const GAS f32x2*)(x1 + (size_t)m0 * DM + 128 * q + 2 * lane);
#pragma unroll
        for (int j = 0; j < RPT; ++j) {
            const int m = m0 + j, b = m >> 13; f32x2 xv[8]; float ss = 0.f;
#pragma unroll
            for (int q = 0; q < 8; ++q) { xv[q] = xn[q]; ss += xv[q].x * xv[q].x + xv[q].y * xv[q].y; }
            if (j < RPT - 1) {
#pragma unroll
                for (int q = 0; q < 8; ++q) xn[q] = *(const GAS f32x2*)(x1 + (size_t)(m + 1) * DM + 128 * q + 2 * lane); }
            const float ri = frsq(dpp_sum(ss) * (1.f / DM) + EPS);
            float lg[20];
#pragma unroll
            for (int n = 0; n < 20; ++n) lg[n] = 0.f;
#pragma unroll
            for (int q = 0; q < 8; ++q) { const int i = 128 * q + 2 * lane; const f32x2 aa = *(const LAS f32x2*)(A2 + b * 1024 + i), sv = *(const LAS f32x2*)(S2 + b * 1024 + i);
                const float h0 = xv[q].x * ri * aa.x + sv.x, h1 = xv[q].y * ri * aa.y + sv.y; hp[j][q] = cvtpk(h0, h1);
                const LAS f32x4* wr = (const LAS f32x4*)(RW + i * 20);
#pragma unroll
                for (int u = 0; u < 5; ++u) { const f32x4 w0 = wr[u], w1 = wr[5 + u];
                    lg[4 * u] += h0 * w0.x + h1 * w1.x; lg[4 * u + 1] += h0 * w0.y + h1 * w1.y; lg[4 * u + 2] += h0 * w0.z + h1 * w1.z; lg[4 * u + 3] += h0 * w0.w + h1 * w1.w; } }
#pragma unroll
            for (int n = 0; n < 20; ++n) lg[n] = dpp_sum(lg[n]) + bias[n];
            int gt = 0; float gm = lg[0];
#pragma unroll
            for (int n = 1; n < 4; ++n) if (lg[n] > gm) { gm = lg[n]; gt = n; }
            float gs = 0.f;
#pragma unroll
            for (int n = 0; n < 4; ++n) gs += fexp(lg[n] - gm);
            const float gate = 1.f / gs;
            float e[4];
#pragma unroll
            for (int n = 0; n < 4; ++n) e[n] = gt == 0 ? lg[4 + n] : gt == 1 ? lg[8 + n] : gt == 2 ? lg[12 + n] : lg[16 + n];
            int j0 = 0; float v0 = e[0];
#pragma unroll
            for (int n = 1; n < 4; ++n) if (e[n] > v0) { v0 = e[n]; j0 = n; }
            int j1 = -1; float v1 = -3.0e38f;
#pragma unroll
            for (int n = 0; n < 4; ++n) if (n != j0 && e[n] > v1) { v1 = e[n]; j1 = n; }
            const float w0 = gate / (1.f + fexp(v1 - v0)), w1 = gate - w0;
            const int lo = j0 < j1 ? j0 : j1, hh = j0 < j1 ? j1 : j0; const float wlo = j0 < j1 ? w0 : w1, whi = j0 < j1 ? w1 : w0;
            const int pidx = lo == 0 ? hh - 1 : lo == 1 ? hh + 1 : 5;
            if (lane == j) { mycombo = gt * 6 + pidx; mywlo = wlo; mywhi = whi; }
        }
        int posl = 0;
        if (lane < RPT) {
            const unsigned rank = __hip_atomic_fetch_add(gcnt + mycombo, 1u, __ATOMIC_RELAXED, __HIP_MEMORY_SCOPE_AGENT);
            unsigned* slot = blkmap + mycombo * 64 + (rank >> 8); unsigned pb;
            const bool first = (rank & 255u) == 0u; pb = 0u;
            if (first) { pb = __hip_atomic_fetch_add(gnblk, 1u, __ATOMIC_RELAXED, __HIP_MEMORY_SCOPE_AGENT) + 1u; __hip_atomic_store(slot, pb, __ATOMIC_RELAXED, __HIP_MEMORY_SCOPE_AGENT); }
            asm volatile("s_waitcnt vmcnt(0)" ::: "memory");
            if (!first) { for (unsigned sp = 0; sp < (1u << 20); ++sp) { pb = __hip_atomic_load(slot, __ATOMIC_RELAXED, __HIP_MEMORY_SCOPE_AGENT); if (pb) break; __builtin_amdgcn_s_sleep(1); } if (!pb) pb = 1u; }
            posl = (int)((pb - 1u) * 256u + (rank & 255u));
            stok[posl] = m0 + lane; wsort[posl] = (f32x2){mywlo, mywhi};
        }
#pragma unroll
        for (int j = 0; j < RPT; ++j) { const int pos = __builtin_amdgcn_readlane(posl, j); GAS unsigned* o = (GAS unsigned*)(H2S + (size_t)pos * DM) + lane;
#pragma unroll
            for (int q = 0; q < 8; ++q) o[64 * q] = hp[j][q]; }
    }
    __syncthreads();
    for (int rep_ = 0; rep_ < (PROBE_REP == 71 ? 2 : 1); ++rep_) moe_weight_items(a, (LAS float*)(lds + wave * 16384), gw, NGW, lane);
}

constexpr int MB_CNT = MISC_OFF + 1024, MB_NBLK = MB_CNT + 128, MB_BLK = MB_NBLK + 16, MB_BLKK = MB_BLK + 512;
__device__ __forceinline__ void build_buckets(const Args& a, LAS unsigned char* lds, int tid) {
    LAS int* cnt = (LAS int*)(lds + MB_CNT); LAS int* blk = (LAS int*)(lds + MB_BLK); LAS int* blkk = (LAS int*)(lds + MB_BLKK);
    const unsigned* ctl = (const unsigned*)(a.ws + WS_CTL);
    if (tid < NCOMBO) cnt[tid] = (int)__hip_atomic_load(ctl + CW_CNT + tid, __ATOMIC_RELAXED, __HIP_MEMORY_SCOPE_AGENT);
    if (tid == 32) { int nb = (int)__hip_atomic_load(ctl + CW_NBLK, __ATOMIC_RELAXED, __HIP_MEMORY_SCOPE_AGENT); *(LAS int*)(lds + MB_NBLK) = nb > NROWBLK ? NROWBLK : nb; }
    unsigned v[3];
#pragma unroll
    for (int q = 0; q < 3; ++q) v[q] = __hip_atomic_load(ctl + CW_BLKMAP + tid + 512 * q, __ATOMIC_RELAXED, __HIP_MEMORY_SCOPE_AGENT);
#pragma unroll
    for (int q = 0; q < 3; ++q) { const int e = tid + 512 * q; if (v[q] != 0u && v[q] <= (unsigned)NROWBLK) { blk[v[q] - 1] = e >> 6; blkk[v[q] - 1] = e & 63; } }
    __syncthreads();
}

__device__ __forceinline__ void pair_of(int pidx, int& lo, int& hh) { lo = pidx < 3 ? 0 : pidx < 5 ? 1 : 2; hh = pidx < 3 ? pidx + 1 : pidx < 5 ? pidx - 1 : 3; }
struct MoeSched1 {
    const LAS int* blk; int nblk, G, c;
    __device__ __forceinline__ bool next(int i, pg8::Unit& u) const {
        const int L = i * G + c; if (L >= nblk * 8) return false;
        const int rb = L >> 3, nt = L & 7, cmb = blk[rb]; int lo, hh; pair_of(cmb % 6, lo, hh);
        const int e = (cmb / 6) * 4 + (nt < 4 ? lo : hh);
        u.pm = rb; u.pn = e * 4 + (nt & 3); u.aux = nt; u.cont = 0; return true;
    }
    __device__ __forceinline__ void a_ready(const pg8::Unit&) const {}
    __device__ __forceinline__ void done(const pg8::Unit&) const {}
};
struct EpiMoe1 {
    static constexpr bool PERM = true, AFTER_DRAIN = false;
    bf16* he; const f32x2* wsort;
    __device__ __forceinline__ void operator()(const pg8::f32x4 (&acc)[2][2][4][2], const pg8::Unit& u, int wr, int wc, int fr, int fq) const {
        const int slot = u.aux >> 2, jt = u.aux & 3, row0 = u.pm * 256 + wr * 64 + fr, col0 = jt * 128 + wc * 32 + 8 * fq;
        bf16* dst = he + (size_t)slot * NSROWS * 512;
#pragma unroll
        for (int ai = 0; ai < 2; ++ai)
#pragma unroll
            for (int m = 0; m < 4; ++m) { const int pos = row0 + ai * 128 + m * 16; const f32x2 wv = wsort[pos]; const float ws = slot ? wv.y : wv.x;
                const pg8::f32x4 a0 = acc[ai][0][m][0], a1 = acc[ai][0][m][1], b0 = acc[ai][1][m][0], b1 = acc[ai][1][m][1];
                v4u w; w.x = cvtpk(ws * silu_f(a0[0]) * b0[0], ws * silu_f(a0[1]) * b0[1]); w.y = cvtpk(ws * silu_f(a0[2]) * b0[2], ws * silu_f(a0[3]) * b0[3]);
                w.z = cvtpk(ws * silu_f(a1[0]) * b1[0], ws * silu_f(a1[1]) * b1[1]); w.w = cvtpk(ws * silu_f(a1[2]) * b1[2], ws * silu_f(a1[3]) * b1[3]);
                *(GAS v4u*)(dst + (size_t)pos * 512 + col0) = w; }
    }
};
struct MoeSched2 {
    const LAS int* blk; int nblk, G, c;
    __device__ __forceinline__ bool next(int i, pg8::Unit& u) const {
        const int L = (i >> 1) * G + c, sg = i & 1; if (L >= nblk * 4) return false;
        const int rb = L >> 2, nt = L & 3, cmb = blk[rb]; int lo, hh; pair_of(cmb % 6, lo, hh);
        const int e = (cmb / 6) * 4 + (sg ? hh : lo);
        u.pm = sg * NROWBLK + rb; u.pn = e * 4 + nt; u.aux = rb * 4 + nt; u.cont = sg ? 0 : 1; return true;
    }
    __device__ __forceinline__ void a_ready(const pg8::Unit&) const {}
    __device__ __forceinline__ void done(const pg8::Unit&) const {}
};
struct EpiMoe2 {
    static constexpr bool PERM = false, AFTER_DRAIN = false;
    float* out; const float* modf; const int* stok; const LAS int* blk; const LAS int* blkk; const LAS int* cnt;
    __device__ __forceinline__ void operator()(const pg8::f32x4 (&acc)[2][2][4][2], const pg8::Unit& u, int wr, int wc, int fr, int fq) const {
        const int rb = u.aux >> 2, nt = u.aux & 3, cmb = blk[rb], nvalid = cnt[cmb] - 256 * blkk[rb];
        const int col0 = nt * 256 + wc * 32 + 4 * fq;
#pragma unroll
        for (int ai = 0; ai < 2; ++ai)
#pragma unroll
            for (int m = 0; m < 4; ++m) { const int lr = ai * 128 + wr * 64 + m * 16 + fr;
                if (lr < nvalid) { const int tok = stok[rb * 256 + lr]; const float* gp = modf + (tok >> 13) * 6144 + 5120 + col0; float* op = out + (size_t)tok * DM + col0;
#pragma unroll
                    for (int bj = 0; bj < 2; ++bj)
#pragma unroll
                        for (int n = 0; n < 2; ++n) { const f32x4 g = *(const f32x4*)(gp + bj * 128 + n * 16); const f32x4 xv = *(const GAS f32x4*)(op + bj * 128 + n * 16);
                            *(GAS f32x4*)(op + bj * 128 + n * 16) = xv + g * acc[ai][bj][m][n]; } } }
    }
};

#ifndef MK_N_LAUNCHES
#define MK_N_LAUNCHES 1
#endif
__global__ void __launch_bounds__(NWAVES * 64, 2) fwd(Args a) {
    extern __shared__ __attribute__((aligned(16))) unsigned char lds_raw[];
    LAS unsigned char* lds = (LAS unsigned char*)lds_raw;
    const int tid = threadIdx.x, lane = tid & 63, wave = __builtin_amdgcn_readfirstlane(tid >> 6), G = gridDim.x;
    volatile LAS unsigned* MISC = (volatile LAS unsigned*)(lds + MISC_OFF);
    for (int u = tid; u < (LDS_BYTES - MISC_OFF) / 4; u += NWAVES * 64) ((LAS unsigned*)(lds + MISC_OFF))[u] = 0u;
    __syncthreads();
    unsigned* ctl = (unsigned*)(a.ws + WS_CTL);
    XcdBarrier bar; bar.bar = ctl + CW_BAR; bar.x = 0; bar.st = nullptr;
    const int lo = a.ph_lo, hi = a.ph_hi;
    if (hi - lo > 1) bar = xcd_barrier_post(ctl + CW_BAR, MISC + 8);
#define IN(k) (lo <= (k) && (k) < hi)
#ifndef PROBE_REP
#define PROBE_REP -1
#endif
#define TWICE(id, call) do { call; if (PROBE_REP == (id)) { call; } } while (0)
#define REP(id) for (int rep_ = 0; rep_ < ((PROBE_REP == (id)) ? 2 : 1); ++rep_)
#define SEAM(k) do { if (IN(k) && IN((k) + 1)) xcd_barrier(bar); } while (0)

    const int xvcu = (G % 8 == 0) ? (int)(blockIdx.x % 8) * (G / 8) + (int)(blockIdx.x / 8) : (int)blockIdx.x;
    if (IN(0)) { REP(0) { phase0(a, lds, tid, lane, wave, G); __syncthreads(); } SEAM(0); }
    if (IN(1)) { REP(1) { phase1(a, lds, tid, lane, wave, G); __syncthreads(); } SEAM(1); }
    if (PROBE_REP == 90 && hi - lo > 1) { for (int i = 0; i < 10; ++i) xcd_barrier(bar); }
    if (IN(2)) {
        pg8::Gemm g{(const pg8::bf16_t*)(a.ws + WS_H), (const pg8::bf16_t*)(a.ws + WS_WIN), MTOK, NINP, DM}; pg8::StaticOrder S; S.init(MTOK, NINP, G, (int)blockIdx.x);
        EpiInProj E{a.ws, a.in[IN_LBL], a.in[IN_QG], a.in[IN_KG], a.in[IN_IKG], a.in[IN_IKB]};
        TWICE(2, (pg8::gemm_phase<EpiInProj, pg8::StaticOrder, true, true>(lds + RING_OFF, g, S, E)));
        SEAM(2);
    }
    if (IN(3)) {
        REP(30) for (int it = blockIdx.x; it < 256; it += G) { const int b = it >> 7, p = it & 127; for (int half = 0; half < 2; ++half) { const int qb_ = half ? 255 - p : p; bool aggr = true; while (idx_item<false>(a, lds, b, qb_, tid, lane, wave, aggr)) aggr = false; } }
        if (PROBE_REP == 33) for (int it = blockIdx.x; it < 256; it += G) { const int b = it >> 7, p = it & 127; (void)idx_item<true>(a, lds, b, p, tid, lane, wave, true); (void)idx_item<true>(a, lds, b, 255 - p, tid, lane, wave, true); }
        REP(31) for (int it = blockIdx.x; it < 1024; it += G) hgrn_local_item(a, lds, it, tid, lane, wave);
        SEAM(3);
    }
    if (IN(4)) { phase4(a, tid, G); SEAM(4); }
    if (IN(5)) {
        const int vcu = xvcu;
        REP(50) for (int it = vcu; it < 256; it += G) { const int bh = it >> 4, s = it & 15; attn_item<0>(a, lds, bh >> 3, bh & 7, s, tid, lane, wave); attn_item<0>(a, lds, bh >> 3, bh & 7, 31 - s, tid, lane, wave); }
        if (PROBE_REP >= 52 && PROBE_REP <= 55) for (int it = vcu; it < 256; it += G) { const int bh = it >> 4, s = it & 15; constexpr int DM_ = (PROBE_REP >= 52 && PROBE_REP <= 55) ? PROBE_REP - 51 : 1; attn_item<DM_>(a, lds, bh >> 3, bh & 7, s, tid, lane, wave); attn_item<DM_>(a, lds, bh >> 3, bh & 7, 31 - s, tid, lane, wave); }
        REP(51) for (int it = blockIdx.x; it < 1024; it += G) hgrn_out_item(a, lds, it, tid, lane, wave);
        SEAM(5);
    }
    if (IN(6)) {
        pg8::Gemm g{(const pg8::bf16_t*)(a.ws + WS_H), (const pg8::bf16_t*)(a.ws + WS_WOUT), MTOK, DM, DM}; pg8::StaticOrder S; S.init(MTOK, DM, G, (int)blockIdx.x);
        EpiOutProj E{a.in[IN_X], a.out, (const float*)(a.ws + WS_MODF)};
        TWICE(6, (pg8::gemm_phase<EpiOutProj, pg8::StaticOrder, false, true>(lds + RING_OFF, g, S, E)));
        SEAM(6);
    }
    if (IN(7)) { phase7(a, lds, tid, lane, wave, G); if (IN(7) && IN(9)) xcd_barrier(bar); }
    if (IN(9)) {
        build_buckets(a, lds, tid);
        pg8::Gemm g{(const pg8::bf16_t*)(a.ws + WS_H2S), (const pg8::bf16_t*)(a.ws + WS_W13), NSROWS, 16 * 1024, DM};
        MoeSched1 S{(const LAS int*)(lds + MB_BLK), *(const LAS int*)(lds + MB_NBLK), G, xvcu};
        EpiMoe1 E{(bf16*)(a.ws + WS_HE), (const f32x2*)(a.ws + WS_WSORT)};
        TWICE(9, (pg8::gemm_phase<EpiMoe1, MoeSched1, true, true>(lds + RING_OFF, g, S, E)));
        SEAM(9);
    }
    if (IN(10)) {
        build_buckets(a, lds, tid);
        pg8::Gemm g{(const pg8::bf16_t*)(a.ws + WS_HE), (const pg8::bf16_t*)(a.ws + WS_W2), 2 * NSROWS, 16 * 1024, 512};
        MoeSched2 S{(const LAS int*)(lds + MB_BLK), *(const LAS int*)(lds + MB_NBLK), G, xvcu};
        EpiMoe2 E{a.out, (const float*)(a.ws + WS_MODF), (const int*)(a.ws + WS_STOK), (const LAS int*)(lds + MB_BLK), (const LAS int*)(lds + MB_BLKK), (const LAS int*)(lds + MB_CNT)};
        pg8::gemm_phase<EpiMoe2, MoeSched2, false, true>(lds + RING_OFF, g, S, E);
    }
#undef IN
#undef SEAM
}

extern "C" void kernel_launch(void* const* d_in, const int* in_sizes, int n_in, void* d_out, int out_size, void* d_ws, size_t ws_size, hipStream_t stream) {
    static int grid = 0;
    if (grid == 0) {
        if (n_in != N_IN || in_sizes[0] != MTOK * DM || out_size != MTOK * DM || ws_size < WS_END) { fprintf(stderr, "kernel_launch: unexpected shapes (n_in %d, in0 %d, out %d, ws %zu); nothing launched\n", n_in, n_in > 0 ? in_sizes[0] : -1, out_size, ws_size); grid = -1; return; }
        int dev = 0, cus = 0, per_cu = 0;
        if (hipGetDevice(&dev) != hipSuccess || hipDeviceGetAttribute(&cus, hipDeviceAttributeMultiprocessorCount, dev) != hipSuccess) { grid = -1; return; }
        if (hipFuncSetAttribute((const void*)fwd, hipFuncAttributeMaxDynamicSharedMemorySize, LDS_BYTES) != hipSuccess) { fprintf(stderr, "kernel_launch: hipFuncSetAttribute failed\n"); grid = -1; return; }
        if (hipOccupancyMaxActiveBlocksPerMultiprocessor(&per_cu, (const void*)fwd, NWAVES * 64, LDS_BYTES) != hipSuccess || per_cu < 1) fprintf(stderr, "kernel_launch: occupancy query reports %d\n", per_cu);
        (void)hipGetLastError();
        grid = cus;
    }
    if (grid < 0) return;
    if (hipMemsetAsync((char*)d_ws + WS_CTL, 0, CTL_ZERO_BYTES, stream) != hipSuccess) return;
    Args a{};
    for (int i = 0; i < N_IN; ++i) a.in[i] = (const float*)d_in[i];
    a.out = (float*)d_out; a.ws = (unsigned char*)d_ws;
    constexpr int NL = MK_N_LAUNCHES;
    for (int li = 0; li < NL; ++li) {
        a.ph_lo = (NL == 1) ? 0 : li; a.ph_hi = (NL == 1) ? NPH : li + 1;
        hipLaunchKernelGGL(fwd, dim3(grid), dim3(NWAVES * 64), LDS_BYTES, stream, a);
        const hipError_t le = hipPeekAtLastError();
        if (le != hipSuccess) { fprintf(stderr, "kernel_launch: launch %d failed: %s\n", li, hipGetErrorName(le)); break; }
    }
}
```
